# Optimizing an MI355X kernel written in HIP

```python
import jax, jax.numpy as jnp
from jax import lax
import numpy as np

D_MODEL = 1024
BATCH = 4
SEQ = 8192
DEPTH = 1

HEAD_DIM = 64
A_HEADS = 8
A_KV = 2
WINDOW = 128
BLOCK = 128
B_HEADS = 8
IDX_HEADS = 8
IDX_DIM = 64
TOPK_MAX = 256
D_FF = 2816
D_PLE = 256
EPS = 1e-6
NEG = -1e30

A_Q = A_HEADS * HEAD_DIM
A_KVW = A_KV * HEAD_DIM
B_Q = B_HEADS * HEAD_DIM
B_KVW = HEAD_DIM
I_Q = IDX_HEADS * IDX_DIM
I_K = IDX_DIM
I_W = IDX_HEADS
D_IN = A_Q + 2 * A_KVW + B_Q + 2 * B_KVW + I_Q + I_K + I_W + 2 * D_MODEL

kernel_name = "hybrid_swa_sink_dsa_macaron_ple"


def _split_points():
    sizes = [A_Q, A_KVW, A_KVW, B_Q, B_KVW, B_KVW, I_Q, I_K, I_W, D_MODEL, D_MODEL]
    pts, acc = [], 0
    for s in sizes[:-1]:
        acc += s
        pts.append(acc)
    return pts


def rms_norm(x, g):
    xf = x.astype(jnp.float32)
    y = xf * lax.rsqrt(jnp.mean(xf * xf, axis=-1, keepdims=True) + EPS)
    return (y * g.astype(jnp.float32)).astype(x.dtype)


def swiglu(x, w_in, w_out):
    a, b = jnp.split(x @ w_in, 2, axis=-1)
    return (jax.nn.silu(a) * b) @ w_out


def alibi_slopes():
    n = A_HEADS + B_HEADS
    return 2.0 ** (-8.0 * jnp.arange(1, n + 1, dtype=jnp.float32) / n)


def sliding_window_sink_attention(q, k, v, sink, slopes):
    bsz, t = q.shape[:2]
    nb = t // BLOCK
    r = A_HEADS // A_KV
    qb = q.reshape(bsz, nb, BLOCK, A_KV, r, HEAD_DIM)
    kb = k.reshape(bsz, nb, BLOCK, A_KV, HEAD_DIM)
    vb = v.reshape(bsz, nb, BLOCK, A_KV, HEAD_DIM)
    pad = ((0, 0), (1, 0), (0, 0), (0, 0), (0, 0))
    kc = jnp.concatenate([jnp.pad(kb, pad)[:, :-1], kb], axis=2)
    vc = jnp.concatenate([jnp.pad(vb, pad)[:, :-1], vb], axis=2)
    logits = jnp.einsum('bnqgrd,bnkgd->bngrqk', qb, kc).astype(jnp.float32) * (HEAD_DIM ** -0.5)
    qi = jnp.arange(BLOCK)
    kj = jnp.arange(2 * BLOCK)
    dist = BLOCK + qi[:, None] - kj[None, :]
    s_pos = (jnp.arange(nb)[:, None] - 1) * BLOCK + kj[None, :]
    valid = ((dist >= 0) & (dist < WINDOW))[None] & (s_pos >= 0)[:, None, :]
    sl = slopes.reshape(A_KV, r)[None, None, :, :, None, None]
    logits = logits - sl * dist.astype(jnp.float32)
    logits = jnp.where(valid[None, :, None, None], logits, NEG)
    sink_f = sink.astype(jnp.float32).reshape(A_KV, r)[None, None, :, :, None, None]
    m = jnp.maximum(jnp.max(logits, axis=-1, keepdims=True), sink_f)
    e = jnp.exp(logits - m)
    probs = e / (jnp.sum(e, axis=-1, keepdims=True) + jnp.exp(sink_f - m))
    out = jnp.einsum('bngrqk,bnkgd->bnqgrd', probs.astype(v.dtype), vc)
    return out.reshape(bsz, t, A_HEADS * HEAD_DIM)


def indexed_sparse_attention(q, k, v, qi, ki, wi, slopes):
    bsz, t = q.shape[:2]
    nb = t // BLOCK
    topk = min(TOPK_MAX, t // 4)
    key_pos = jnp.arange(t)
    gather = jax.vmap(lambda tab, idx: tab[idx])

    def to_blocks(a):
        return jnp.moveaxis(a.reshape((bsz, nb, BLOCK) + a.shape[2:]), 1, 0)

    def block(args):
        n, qb, qib, wib = args
        tq = n * BLOCK + jnp.arange(BLOCK)
        rel = jax.nn.relu(jnp.einsum('bqhd,bsd->bqhs', qib, ki).astype(jnp.float32) * (IDX_DIM ** -0.5))
        score = jnp.einsum('bqhs,bqh->bqs', rel, wib.astype(jnp.float32) * (IDX_HEADS ** -0.5))
        causal = key_pos[None, :] <= tq[:, None]
        score = jnp.where(causal[None], score, NEG)
        _, idx = lax.top_k(score, topk)
        kg = gather(k, idx)
        vg = gather(v, idx)
        dist = tq[None, :, None] - idx
        logits = jnp.einsum('bqhd,bqkd->bqhk', qb, kg).astype(jnp.float32) * (HEAD_DIM ** -0.5)
        logits = logits - slopes[None, None, :, None] * dist[:, :, None, :].astype(jnp.float32)
        logits = jnp.where((dist >= 0)[:, :, None, :], logits, NEG)
        probs = jax.nn.softmax(logits, axis=-1)
        return jnp.einsum('bqhk,bqkd->bqhd', probs.astype(v.dtype), vg)

    out = lax.map(block, (jnp.arange(nb), to_blocks(q), to_blocks(qi), to_blocks(wi)))
    return jnp.moveaxis(out, 0, 1).reshape(bsz, t, B_HEADS * HEAD_DIM)


def setup_inputs(seed: int = 0) -> dict:
    key = jax.random.key(seed)
    ks = jax.random.split(key, 20)
    f32 = jnp.float32

    def w(k, shape, fan_in):
        return jax.random.normal(k, shape, f32) * (fan_in ** -0.5)

    def gain(k, shape):
        return 1.0 + 0.05 * jax.random.normal(k, shape, f32)

    return {
        "x": jax.random.normal(ks[0], (BATCH, SEQ, D_MODEL), f32),
        "p": jax.random.normal(ks[1], (DEPTH, BATCH, SEQ, D_PLE), f32),
        "ln_ffn1": gain(ks[2], (DEPTH, D_MODEL)),
        "w_ffn1_in": w(ks[3], (DEPTH, D_MODEL, 2 * D_FF), D_MODEL),
        "w_ffn1_out": w(ks[4], (DEPTH, D_FF, D_MODEL), D_FF),
        "ln_mix": gain(ks[5], (DEPTH, D_MODEL)),
        "w_in": w(ks[6], (DEPTH, D_MODEL, D_IN), D_MODEL),
        "a_sink": 0.5 * jax.random.normal(ks[7], (DEPTH, A_HEADS), f32),
        "w_br_a": w(ks[8], (DEPTH, A_Q, D_MODEL), A_Q),
        "w_br_b": w(ks[9], (DEPTH, B_Q, D_MODEL), B_Q),
        "w_out": w(ks[10], (DEPTH, D_MODEL, D_MODEL), D_MODEL),
        "ln_ffn2": gain(ks[11], (DEPTH, D_MODEL)),
        "w_ffn2_in": w(ks[12], (DEPTH, D_MODEL, 2 * D_FF), D_MODEL),
        "w_ffn2_out": w(ks[13], (DEPTH, D_FF, D_MODEL), D_FF),
        "ln_ple": gain(ks[14], (DEPTH, D_MODEL)),
        "w_ple_gate": w(ks[15], (DEPTH, D_MODEL, D_MODEL), D_MODEL),
        "w_ple_proj": w(ks[16], (DEPTH, D_PLE, D_MODEL), D_PLE),
        "ln_final": gain(ks[17], (D_MODEL,)),
    }


def reference(x, p, ln_ffn1, w_ffn1_in, w_ffn1_out, ln_mix, w_in, a_sink, w_br_a, w_br_b,
              w_out, ln_ffn2, w_ffn2_in, w_ffn2_out, ln_ple, w_ple_gate, w_ple_proj, ln_final):
    bsz, t, _ = x.shape
    slopes = alibi_slopes()
    slopes_a = slopes[:A_HEADS].astype(jnp.float32)
    slopes_b = slopes[A_HEADS:].astype(jnp.float32)
    split_pts = _split_points()
    h = x
    for i in range(DEPTH):
        h = h + 0.5 * swiglu(rms_norm(h, ln_ffn1[i]), w_ffn1_in[i], w_ffn1_out[i])
        u = rms_norm(h, ln_mix[i])
        aq, ak, av, bq, bk, bv, iq, ik, iw, ga, gb = jnp.split(u @ w_in[i], split_pts, axis=-1)
        ya = sliding_window_sink_attention(
            aq.reshape(bsz, t, A_HEADS, HEAD_DIM),
            ak.reshape(bsz, t, A_KV, HEAD_DIM),
            av.reshape(bsz, t, A_KV, HEAD_DIM),
            a_sink[i], slopes_a)
        yb = indexed_sparse_attention(
            bq.reshape(bsz, t, B_HEADS, HEAD_DIM), bk, bv,
            iq.reshape(bsz, t, IDX_HEADS, IDX_DIM), ik, iw, slopes_b)
        mix = jax.nn.sigmoid(ga) * (ya @ w_br_a[i]) + jax.nn.sigmoid(gb) * (yb @ w_br_b[i])
        h = h + mix @ w_out[i]
        h = h + 0.5 * swiglu(rms_norm(h, ln_ffn2[i]), w_ffn2_in[i], w_ffn2_out[i])
        gate = jax.nn.sigmoid(rms_norm(h, ln_ple[i]) @ w_ple_gate[i])
        h = h + gate * (p[i] @ w_ple_proj[i])
    return rms_norm(h, ln_final)
```

```cpp
#include <hip/hip_runtime.h>
#include <cstdio>
#include <cstdint>

namespace pg8 {
#define PG8_LAS __attribute__((address_space(3)))
typedef unsigned short bf16_t;
typedef short bf16x8 __attribute__((ext_vector_type(8)));
typedef float f32x4 __attribute__((ext_vector_type(4)));
typedef unsigned u32x4 __attribute__((ext_vector_type(4)));
typedef unsigned u32x2 __attribute__((ext_vector_type(2)));
constexpr int BM = 256, BK = 64, HALF = 128, HTB = HALF * BK * 2, STAGE_BYTES = 8 * HTB, NXCD = 8, WGM = 8;

__host__ __device__ __forceinline__ int lds_byte(int r, int c) { const int st = (r >> 4) * 2 + (c >> 5), rr = r & 15, cc = c & 31, ob = rr * 64 + cc * 2; return st * 1024 + (ob ^ (((ob >> 9) & 1) << 5)); }
__host__ __device__ __forceinline__ void stage_rc(int b, int& R, int& C) { const int st = b / 1024, sb = b % 1024, swz = sb ^ (((sb >> 9) & 1) << 5); R = (st >> 1) * 16 + swz / 64; C = (st & 1) * 32 + (swz % 64) / 2; }
__host__ __device__ __forceinline__ int perm32(int rho) { const int n = rho >> 4, i = rho & 15; return 8 * (i >> 2) + 4 * n + (i & 3); }

struct Unit { int pm, pn, ord; };
struct Gemm { const bf16_t* A; const bf16_t* Bt; int M, N, K; };

struct StaticOrder {
    int nM, nN, nwg, G, c;
    __host__ __device__ void init(int M, int N, int G_, int c_) { nM = M / BM; nN = N / BM; nwg = nM * nN; G = G_; c = c_; }
    __host__ __device__ bool next(int i, Unit& u) const {
        const long L = (long)i * G + c; if (L >= nwg) return false;
        int wgid = (int)L; { const int q = nwg / NXCD, r = nwg % NXCD, xcd = wgid % NXCD, off = wgid / NXCD; wgid = (xcd < r ? xcd * (q + 1) : r * (q + 1) + (xcd - r) * q) + off; }
        const int nig = WGM * nN, gid = wgid / nig, fm = gid * WGM, gsz = (nM - fm) < WGM ? (nM - fm) : WGM;
        u.pm = fm + ((wgid % nig) % gsz); u.pn = (wgid % nig) / gsz; return true;
    }
    __device__ __forceinline__ void a_ready(const Unit&) const {}
    __device__ __forceinline__ void done(const Unit&) const {}
};

__device__ __forceinline__ unsigned cvt_pk_bf16(float lo, float hi) { unsigned r; asm volatile("v_cvt_pk_bf16_f32 %0, %1, %2" : "=v"(r) : "v"(lo), "v"(hi)); return r; }
__device__ __forceinline__ float bf_lo(unsigned w) { return __uint_as_float(w << 16); }
__device__ __forceinline__ float bf_hi(unsigned w) { return __uint_as_float(w & 0xffff0000u); }
__device__ __forceinline__ float fsigmoid(float x) { return __builtin_amdgcn_rcpf(1.0f + __builtin_amdgcn_exp2f(-1.4426950408889634f * x)); }
__device__ __forceinline__ float rs_of(const float* rsq, int row) {
    const f32x4* p = (const f32x4*)(rsq + (size_t)row * 16);
    const f32x4 a = p[0], b = p[1], c = p[2], d = p[3];
    const float s = ((a[0] + a[1]) + (a[2] + a[3])) + ((b[0] + b[1]) + (b[2] + b[3])) + ((c[0] + c[1]) + (c[2] + c[3])) + ((d[0] + d[1]) + (d[2] + d[3]));
    return __builtin_amdgcn_rsqf(s * (1.0f / 1024.0f) + 1e-6f);
}
__device__ __forceinline__ void rs8_of(const float* rsq, int row0, int fq, float (&rs)[2][4]) {
    f32x4 p[2][4];
#pragma unroll
    for (int ai = 0; ai < 2; ++ai)
#pragma unroll
        for (int m = 0; m < 4; ++m) p[ai][m] = *(const f32x4*)(rsq + (size_t)(row0 + ai * HALF + m * 16) * 16 + 4 * fq);
#pragma unroll
    for (int ai = 0; ai < 2; ++ai)
#pragma unroll
        for (int m = 0; m < 4; ++m) { float s = (p[ai][m][0] + p[ai][m][1]) + (p[ai][m][2] + p[ai][m][3]); s += __shfl_xor(s, 16); s += __shfl_xor(s, 32); rs[ai][m] = __builtin_amdgcn_rsqf(s * (1.0f / 1024.0f) + 1e-6f); }
}
constexpr int RS_LDS_OFF = 131072, RS_LDS_MAXU = 12;
template <class Sched> __device__ __forceinline__ void stage_rs(PG8_LAS unsigned char* lds0, const Sched& S, const float* rsq, int tid, float mul) {
    PG8_LAS float* tab = (PG8_LAS float*)(lds0 + RS_LDS_OFF);
    Unit u;
    for (int i = 0; i < RS_LDS_MAXU && S.next(i, u); ++i) if (tid < 256) tab[i * 256 + tid] = rs_of(rsq, u.pm * BM + tid) * mul;
    asm volatile("s_waitcnt lgkmcnt(0)" ::: "memory"); __builtin_amdgcn_s_barrier(); asm volatile("" ::: "memory");
}
__device__ __forceinline__ void rs8_lds(PG8_LAS unsigned char* lds0, int ord, int wr, int fr, float (&rs)[2][4]) {
    const PG8_LAS float* tab = (const PG8_LAS float*)(lds0 + RS_LDS_OFF) + ord * 256 + wr * 64 + fr;
#pragma unroll
    for (int ai = 0; ai < 2; ++ai)
#pragma unroll
        for (int m = 0; m < 4; ++m) rs[ai][m] = tab[ai * HALF + m * 16];
}
__device__ __forceinline__ u32x4 pack8(const f32x4 v0, const f32x4 v1) { u32x4 w; w.x = cvt_pk_bf16(v0[0], v0[1]); w.y = cvt_pk_bf16(v0[2], v0[3]); w.z = cvt_pk_bf16(v1[0], v1[1]); w.w = cvt_pk_bf16(v1[2], v1[3]); return w; }
__device__ __forceinline__ void unpack8(const u32x4 w, f32x4& v0, f32x4& v1) { v0 = (f32x4){bf_lo(w.x), bf_hi(w.x), bf_lo(w.y), bf_hi(w.y)}; v1 = (f32x4){bf_lo(w.z), bf_hi(w.z), bf_lo(w.w), bf_hi(w.w)}; }
__device__ __forceinline__ float sq8(const f32x4 a, const f32x4 b) { return ((a[0] * a[0] + a[1] * a[1]) + (a[2] * a[2] + a[3] * a[3])) + ((b[0] * b[0] + b[1] * b[1]) + (b[2] * b[2] + b[3] * b[3])); }

typedef float f32x2_ __attribute__((ext_vector_type(2)));
__device__ __forceinline__ void unpack8_f8(const u32x2 w, f32x4& v0, f32x4& v1) {
    const f32x2_ a = __builtin_amdgcn_cvt_pk_f32_fp8((int)w.x, false), b = __builtin_amdgcn_cvt_pk_f32_fp8((int)w.x, true), c = __builtin_amdgcn_cvt_pk_f32_fp8((int)w.y, false), d = __builtin_amdgcn_cvt_pk_f32_fp8((int)w.y, true);
    v0 = (f32x4){a[0], a[1], b[0], b[1]}; v1 = (f32x4){c[0], c[1], d[0], d[1]};
}
constexpr float F8_WSCALE = 64.0f;
__device__ __forceinline__ unsigned pack4_fp8(float a, float b, float c, float d) { int p = __builtin_amdgcn_cvt_pk_fp8_f32(a, b, 0, false); p = __builtin_amdgcn_cvt_pk_fp8_f32(c, d, p, true); return (unsigned)p; }
template <bool HAS_RS, bool F8, bool F8OUT = F8> struct EpiSwiglu {
    static constexpr bool PERM = true, AFTER_DRAIN = false;
    bf16_t* O; PG8_LAS unsigned char* lds0;
    __device__ __forceinline__ void operator()(const f32x4 (&acc)[2][2][4][2], const Unit& u, int wr, int wc, int fr, int fq) const {
        const int row0 = u.pm * BM + wr * 64 + fr, oc = u.pn * 128 + wc * 32 + 8 * fq;
        float rs8[2][4]; if (HAS_RS) rs8_lds(lds0, u.ord, wr, fr, rs8);
#pragma unroll
        for (int ai = 0; ai < 2; ++ai)
#pragma unroll
            for (int m = 0; m < 4; ++m) {
                const int row = row0 + ai * HALF + m * 16;
                float rs = F8 ? (1.0f / F8_WSCALE) : 1.f; if (HAS_RS) rs *= rs8[ai][m];
                const float rsl = -1.4426950408889634f * rs, rs2 = rs * rs;
                f32x4 o0, o1;
#pragma unroll
                for (int j = 0; j < 4; ++j) {
                    const float A0 = acc[ai][0][m][0][j], A1 = acc[ai][0][m][1][j];
                    const float r0 = __builtin_amdgcn_rcpf(1.0f + __builtin_amdgcn_exp2f(A0 * rsl)), r1 = __builtin_amdgcn_rcpf(1.0f + __builtin_amdgcn_exp2f(A1 * rsl));
                    o0[j] = (A0 * acc[ai][1][m][0][j]) * (r0 * rs2); o1[j] = (A1 * acc[ai][1][m][1][j]) * (r1 * rs2);
                }
                if (F8OUT) { u32x2 w; w.x = pack4_fp8(o0[0], o0[1], o0[2], o0[3]); w.y = pack4_fp8(o1[0], o1[1], o1[2], o1[3]); *(u32x2*)((unsigned char*)O + (size_t)row * 2816 + oc) = w; }
                else *(u32x4*)(O + (size_t)row * 2816 + oc) = pack8(o0, o1);
            }
    }
};
template <bool SRC_F32, bool HALF_ALPHA, bool F8IN, bool F8COPY> struct EpiResid {
    static constexpr bool PERM = true, AFTER_DRAIN = false;
    const float* X; bf16_t* H; float* rsq_out; unsigned char* H8;
    __device__ __forceinline__ void operator()(const f32x4 (&acc)[2][2][4][2], const Unit& u, int wr, int wc, int fr, int fq) const {
        const int row0 = u.pm * BM + wr * 64 + fr, c0 = u.pn * BM + wc * 32 + 8 * fq;
        const float alpha = (HALF_ALPHA ? 0.5f : 1.0f) * (F8IN ? (1.0f / F8_WSCALE) : 1.0f);
#pragma unroll
        for (int ai = 0; ai < 2; ++ai) {
            u32x4 rb[4][2]; f32x4 rf[SRC_F32 ? 4 : 1][2][2];
            if (!SRC_F32) {
#pragma unroll
                for (int m = 0; m < 4; ++m)
#pragma unroll
                    for (int bj = 0; bj < 2; ++bj) rb[m][bj] = *(const u32x4*)(H + (size_t)(row0 + ai * HALF + m * 16) * 1024 + c0 + bj * HALF);
            }
#pragma unroll
            for (int mh = 0; mh < 2; ++mh) {
                if (SRC_F32) {
#pragma unroll
                    for (int m2 = 0; m2 < 2; ++m2)
#pragma unroll
                        for (int bj = 0; bj < 2; ++bj) { const float* xp = X + (size_t)(row0 + ai * HALF + (2 * mh + m2) * 16) * 1024 + c0 + bj * HALF; rf[2 * mh + m2][bj][0] = *(const f32x4*)xp; rf[2 * mh + m2][bj][1] = *(const f32x4*)(xp + 4); }
                }
#pragma unroll
                for (int m2 = 0; m2 < 2; ++m2) {
                    const int m = 2 * mh + m2, row = row0 + ai * HALF + m * 16; float sq = 0.f;
#pragma unroll
                    for (int bj = 0; bj < 2; ++bj) {
                        const size_t off = (size_t)row * 1024 + c0 + bj * HALF; f32x4 r0, r1;
                        if (SRC_F32) { r0 = rf[m][bj][0]; r1 = rf[m][bj][1]; } else unpack8(rb[m][bj], r0, r1);
                        const f32x4 v0 = r0 + alpha * acc[ai][bj][m][0], v1 = r1 + alpha * acc[ai][bj][m][1];
                        sq += sq8(v0, v1);
                        *(u32x4*)(H + off) = pack8(v0, v1);
                        if (F8COPY) { u32x2 w8; w8.x = pack4_fp8(v0[0], v0[1], v0[2], v0[3]); w8.y = pack4_fp8(v1[0], v1[1], v1[2], v1[3]); *(u32x2*)(H8 + off) = w8; }
                    }
                    sq += __shfl_xor(sq, 16); sq += __shfl_xor(sq, 32);
                    if (fq == 0) rsq_out[(size_t)row * 16 + u.pn * 4 + wc] = sq;
                }
                asm volatile("" ::: "memory");
            }
        }
    }
};
constexpr size_t PJ_MiB = 1u << 20, PJ_AQ = 336 * PJ_MiB, PJ_BQ = 368 * PJ_MiB, PJ_IQ = 400 * PJ_MiB, PJ_AK = 432 * PJ_MiB, PJ_AVT = 440 * PJ_MiB, PJ_BK = 448 * PJ_MiB, PJ_BV = 452 * PJ_MiB, PJ_IK = 456 * PJ_MiB, PJ_IW = 9 * PJ_MiB;
struct EpiProj {
    static constexpr bool PERM = true, AFTER_DRAIN = false;
    PG8_LAS unsigned char* lds0; unsigned char* wsb; bf16_t* SG;
    __device__ __forceinline__ void dest(int pn, int cw, bf16_t*& base, int& stride, int& col0, int& kind) const {
        kind = 0; base = SG; stride = 2048; col0 = 0;
        if (pn < 2) { base = (bf16_t*)(wsb + PJ_AQ); stride = 512; col0 = pn * 256 + cw; }
        else if (pn == 2) { if (cw < 128) { base = (bf16_t*)(wsb + PJ_AK); stride = 128; col0 = cw; } else { kind = 2; base = (bf16_t*)(wsb + PJ_AVT); col0 = cw - 128; } }
        else if (pn < 5) { base = (bf16_t*)(wsb + PJ_BQ); stride = 512; col0 = (pn - 3) * 256 + cw; }
        else if (pn == 5) { stride = 64;
            if (cw < 64) { base = (bf16_t*)(wsb + PJ_BK); col0 = cw; } else if (cw < 128) { base = (bf16_t*)(wsb + PJ_BV); col0 = cw - 64; } else if (cw < 192) { base = (bf16_t*)(wsb + PJ_IK); col0 = cw - 128; }
            else if (cw == 192) { kind = 3; base = (bf16_t*)(wsb + PJ_IW); } else kind = 4; }
        else if (pn < 8) { base = (bf16_t*)(wsb + PJ_IQ); stride = 512; col0 = (pn - 6) * 256 + cw; }
        else { kind = 1; col0 = (pn - 8) * 256 + cw; }
    }
    __device__ __forceinline__ void operator()(const f32x4 (&acc)[2][2][4][2], const Unit& u, int wr, int wc, int fr, int fq) const {
        const int row0 = u.pm * BM + wr * 64 + fr;
        bf16_t *base0, *base1; int st0, st1, c00, c01, k0, k1;
        dest(u.pn, wc * 32, base0, st0, c00, k0); dest(u.pn, HALF + wc * 32, base1, st1, c01, k1);
        float rs8[2][4]; rs8_lds(lds0, u.ord, wr, fr, rs8);
#pragma unroll
        for (int ai = 0; ai < 2; ++ai)
#pragma unroll
            for (int m = 0; m < 4; ++m) {
                const int row = row0 + ai * HALF + m * 16; const float rs = rs8[ai][m];
#pragma unroll
                for (int bj = 0; bj < 2; ++bj) {
                    bf16_t* base = bj ? base1 : base0; const int stride = bj ? st1 : st0, col0 = bj ? c01 : c00, kind = bj ? k1 : k0;
                    f32x4 v0 = acc[ai][bj][m][0] * rs, v1 = acc[ai][bj][m][1] * rs;
                    if (kind == 1) {
#pragma unroll
                        for (int j = 0; j < 4; ++j) { v0[j] = fsigmoid(v0[j]); v1[j] = fsigmoid(v1[j]); }
                    }
                    if (kind <= 1) { *(u32x4*)(base + (size_t)row * stride + col0 + 8 * fq) = pack8(v0, v1); }
                    else if (kind == 2) { const int i = col0 + 8 * fq, g = i >> 6, d = i & 63, b = row >> 13, t = row & 8191; bf16_t* p = base + ((size_t)((b * 2 + g) * 64 + d)) * 8192 + t; const u32x4 w = pack8(v0, v1);
                        p[0] = (bf16_t)(w.x & 0xffffu); p[8192] = (bf16_t)(w.x >> 16); p[2 * 8192] = (bf16_t)(w.y & 0xffffu); p[3 * 8192] = (bf16_t)(w.y >> 16);
                        p[4 * 8192] = (bf16_t)(w.z & 0xffffu); p[5 * 8192] = (bf16_t)(w.z >> 16); p[6 * 8192] = (bf16_t)(w.w & 0xffffu); p[7 * 8192] = (bf16_t)(w.w >> 16); }
                    else if (kind == 3) { if (fq == 0) { float* iw = (float*)base + (size_t)row * 8; *(f32x4*)iw = v0; *(f32x4*)(iw + 4) = v1; } }
                }
                asm volatile("" ::: "memory");
            }
    }
};
struct EpiSig {
    static constexpr bool PERM = true, AFTER_DRAIN = false;
    PG8_LAS unsigned char* lds0; bf16_t* SG;
    __device__ __forceinline__ void operator()(const f32x4 (&acc)[2][2][4][2], const Unit& u, int wr, int wc, int fr, int fq) const {
        const int row0 = u.pm * BM + wr * 64 + fr, c0 = u.pn * BM + wc * 32 + 8 * fq;
        float rs8[2][4]; rs8_lds(lds0, u.ord, wr, fr, rs8);
#pragma unroll
        for (int ai = 0; ai < 2; ++ai)
#pragma unroll
            for (int m = 0; m < 4; ++m) {
                const int row = row0 + ai * HALF + m * 16; const float rs = rs8[ai][m] * (1.0f / F8_WSCALE);
#pragma unroll
                for (int bj = 0; bj < 2; ++bj) {
                    f32x4 v0 = acc[ai][bj][m][0] * rs, v1 = acc[ai][bj][m][1] * rs;
#pragma unroll
                    for (int j = 0; j < 4; ++j) { v0[j] = fsigmoid(v0[j]); v1[j] = fsigmoid(v1[j]); }
                    { u32x2 w8; w8.x = pack4_fp8(v0[0], v0[1], v0[2], v0[3]); w8.y = pack4_fp8(v1[0], v1[1], v1[2], v1[3]); *(u32x2*)((unsigned char*)SG + (size_t)row * 2048 + c0 + bj * HALF) = w8; }
                }
            }
    }
};
template <int MODE, bool F8OUT = false, bool F8IN = false> struct EpiGate {
    static constexpr bool PERM = true, AFTER_DRAIN = false;
    bf16_t* O; const bf16_t* G; int gofs; const bf16_t* P;
    __device__ __forceinline__ void operator()(const f32x4 (&acc)[2][2][4][2], const Unit& u, int wr, int wc, int fr, int fq) const {
        const int row0 = u.pm * BM + wr * 64 + fr, c0 = u.pn * BM + wc * 32 + 8 * fq;
#pragma unroll
        for (int ai = 0; ai < 2; ++ai) {
            u32x2 gv[4][2], pv[4][2];
            if (MODE >= 1) {
#pragma unroll
                for (int m = 0; m < 4; ++m)
#pragma unroll
                    for (int bj = 0; bj < 2; ++bj) gv[m][bj] = *(const u32x2*)((const unsigned char*)G + (size_t)(row0 + ai * HALF + m * 16) * 2048 + gofs + c0 + bj * HALF);
            }
            if (MODE == 2) {
#pragma unroll
                for (int m = 0; m < 4; ++m)
#pragma unroll
                    for (int bj = 0; bj < 2; ++bj) pv[m][bj] = *(const u32x2*)((const unsigned char*)P + (size_t)(row0 + ai * HALF + m * 16) * 1024 + c0 + bj * HALF);
            }
#pragma unroll
            for (int m = 0; m < 4; ++m) {
                const int row = row0 + ai * HALF + m * 16;
#pragma unroll
                for (int bj = 0; bj < 2; ++bj) {
                    const int col = c0 + bj * HALF; f32x4 v0 = acc[ai][bj][m][0], v1 = acc[ai][bj][m][1];
                    if (F8IN) { v0 = v0 * (1.0f / F8_WSCALE); v1 = v1 * (1.0f / F8_WSCALE); }
                    if (MODE >= 1) { f32x4 g0, g1; unpack8_f8(gv[m][bj], g0, g1); v0 = v0 * g0; v1 = v1 * g1; }
                    if (MODE == 2) { f32x4 p0, p1; unpack8_f8(pv[m][bj], p0, p1); v0 = v0 + p0; v1 = v1 + p1; }
                    if (F8OUT) { u32x2 w8; w8.x = pack4_fp8(v0[0], v0[1], v0[2], v0[3]); w8.y = pack4_fp8(v1[0], v1[1], v1[2], v1[3]); *(u32x2*)((unsigned char*)O + (size_t)row * 1024 + col) = w8; }
                    else *(u32x4*)(O + (size_t)row * 1024 + col) = pack8(v0, v1);
                }
            }
            asm volatile("" ::: "memory");
        }
    }
};
template <bool F8IN> struct EpiPle {
    static constexpr bool PERM = true, AFTER_DRAIN = false;
    PG8_LAS unsigned char* lds0; const bf16_t* H; const bf16_t* PP; float* out; float* rsq_out; unsigned* cnt; const float* gfin;
    __device__ __forceinline__ void operator()(f32x4 (&acc)[2][2][4][2], const Unit& u, int wr, int wc, int fr, int fq) const {
        const int row0 = u.pm * BM + wr * 64 + fr, c0 = u.pn * BM + wc * 32 + 8 * fq;
        float rs8[2][4]; rs8_lds(lds0, u.ord, wr, fr, rs8);
#pragma unroll
        for (int aim = 0; aim < 4; ++aim) {
            const int ai = aim >> 1;
            u32x4 hv[2][2]; u32x2 qv[2][2];
#pragma unroll
            for (int m2 = 0; m2 < 2; ++m2)
#pragma unroll
                for (int bj = 0; bj < 2; ++bj) { const size_t off = (size_t)(row0 + ai * HALF + (2 * (aim & 1) + m2) * 16) * 1024 + c0 + bj * HALF; hv[m2][bj] = *(const u32x4*)(H + off); qv[m2][bj] = *(const u32x2*)((const unsigned char*)PP + off); }
#pragma unroll
            for (int m2 = 0; m2 < 2; ++m2) {
                const int m = 2 * (aim & 1) + m2;
                const int row = row0 + ai * HALF + m * 16; const float rs = rs8[ai][m] * (F8IN ? (1.0f / F8_WSCALE) : 1.0f); float sq = 0.f;
#pragma unroll
                for (int bj = 0; bj < 2; ++bj) {
                    f32x4 h0, h1, p0, p1; unpack8(hv[m2][bj], h0, h1); unpack8_f8(qv[m2][bj], p0, p1);
                    f32x4 v0 = acc[ai][bj][m][0] * rs, v1 = acc[ai][bj][m][1] * rs;
#pragma unroll
                    for (int j = 0; j < 4; ++j) { v0[j] = h0[j] + fsigmoid(v0[j]) * p0[j]; v1[j] = h1[j] + fsigmoid(v1[j]) * p1[j]; }
                    sq += sq8(v0, v1);
                    acc[ai][bj][m][0] = v0; acc[ai][bj][m][1] = v1;
                }
                sq += __shfl_xor(sq, 16); sq += __shfl_xor(sq, 32);
                if (fq == 0) __hip_atomic_store((unsigned*)(rsq_out + (size_t)row * 16 + u.pn * 4 + wc), __float_as_uint(sq), __ATOMIC_RELAXED, __HIP_MEMORY_SCOPE_AGENT);
            }
            asm volatile("" ::: "memory");
        }
        asm volatile("s_waitcnt vmcnt(0)" ::: "memory");
        unsigned* pc = cnt + 64 * u.pm;
        if ((fr | fq) == 0) __hip_atomic_fetch_add(pc, 1u, __ATOMIC_RELAXED, __HIP_MEMORY_SCOPE_AGENT);
        { unsigned spins = 0;
          while ((unsigned)__builtin_amdgcn_readfirstlane(__hip_atomic_load(pc, __ATOMIC_RELAXED, __HIP_MEMORY_SCOPE_AGENT)) < 32u) { __builtin_amdgcn_s_sleep(2); if (++spins > (1u << 22)) break; } }
        __builtin_amdgcn_fence(__ATOMIC_ACQUIRE, "agent");
        asm volatile("s_waitcnt vmcnt(0)" ::: "memory");
        f32x4 g00 = *(const f32x4*)(gfin + c0), g01 = *(const f32x4*)(gfin + c0 + 4), g10 = *(const f32x4*)(gfin + c0 + HALF), g11 = *(const f32x4*)(gfin + c0 + HALF + 4);
        float rf8[2][4]; rs8_of(rsq_out, row0, fq, rf8);
#pragma unroll
        for (int ai = 0; ai < 2; ++ai)
#pragma unroll
            for (int m = 0; m < 4; ++m) {
                const int row = row0 + ai * HALF + m * 16; const float rs = rf8[ai][m];
                const size_t off = (size_t)row * 1024 + c0;
                *(f32x4*)(out + off) = acc[ai][0][m][0] * rs * g00; *(f32x4*)(out + off + 4) = acc[ai][0][m][1] * rs * g01;
                *(f32x4*)(out + off + HALF) = acc[ai][1][m][0] * rs * g10; *(f32x4*)(out + off + HALF + 4) = acc[ai][1][m][1] * rs * g11;
                asm volatile("" ::: "memory");
            }
    }
};

template <class Epi, class Sched, bool ALIGN_EPI = false, bool SP2 = false, bool F8 = false>
__device__ __forceinline__ void gemm_phase(PG8_LAS unsigned char* lds, const Gemm g, const Sched& S, const Epi& E, int wid_s) {
    int lane_o; asm volatile("v_mbcnt_lo_u32_b32 %0, -1, 0\n\tv_mbcnt_hi_u32_b32 %0, -1, %0" : "=v"(lane_o)); const int tid = wid_s * 64 + lane_o;
    const int wid = __builtin_amdgcn_readfirstlane(tid >> 6), lane = tid & 63, wr = wid >> 2, wc = wid & 3, fr = lane & 15, fq = lane >> 4;
    int f8scale_ = 0x7f7f7f7f; if constexpr (F8) asm volatile("" : "+v"(f8scale_));     (void)f8scale_;
    const int K = g.K, nt = K / BK;
    unsigned voffA[2], voffB[2];
#pragma unroll
    for (int i = 0; i < 2; ++i) { int R, C; stage_rc(tid * 16 + i * 8192, R, C); const int Rb = Epi::PERM ? ((R & ~31) + perm32(R & 31)) : R;
        voffA[i] = (unsigned)(R * K + C) * 2u; voffB[i] = (unsigned)(Rb * K + C) * 2u; }
    const size_t kstep = (size_t)(BK * 2);
    const size_t hstep = (size_t)HALF * K * 2;
    const size_t tstep = 2 * hstep;
    const unsigned ldsw = (unsigned)wid * 1024u;
    const int aoff = lds_byte(wr * 64 + fr, fq * 8), boff = lds_byte(wc * 32 + fr, fq * 8);
#define PG8_SA(b, h) (((b) * 2 + (h)) * HTB)
#define PG8_SB(b, h) ((4 + (b) * 2 + (h)) * HTB)
#define PG8_STAGE(bufoff, gbase, voff) do { _Pragma("unroll") for (int _i = 0; _i < 2; ++_i) \
        __builtin_amdgcn_global_load_lds((const unsigned*)((const char*)(gbase) + (voff)[_i]), (PG8_LAS unsigned*)(lds + (bufoff) + ldsw + _i * 8192), 16, 0, 0); } while (0)
#define PG8_LDA(dst, b, h) do { _Pragma("unroll") for (int m = 0; m < 4; ++m) _Pragma("unroll") for (int k = 0; k < 2; ++k) dst[m][k] = *(const PG8_LAS bf16x8*)(lds + PG8_SA(b, h) + aoff + m * 2048 + k * 1024); } while (0)
#define PG8_LDB(dst, b, h) do { _Pragma("unroll") for (int n = 0; n < 2; ++n) _Pragma("unroll") for (int k = 0; k < 2; ++k) dst[n][k] = *(const PG8_LAS bf16x8*)(lds + PG8_SB(b, h) + boff + n * 2048 + k * 1024); } while (0)
#define PG8_MMA(ai, bj, At, Bt) do { __builtin_amdgcn_s_setprio(1); \
        if constexpr (F8) { typedef int v8i_ __attribute__((ext_vector_type(8))); typedef int v4i_ __attribute__((ext_vector_type(4))); \
            _Pragma("unroll") for (int m = 0; m < 4; ++m) _Pragma("unroll") for (int n = 0; n < 2; ++n) { \
                const v4i_ b0_ = __builtin_bit_cast(v4i_, Bt[n][0]), b1_ = __builtin_bit_cast(v4i_, Bt[n][1]), a0_ = __builtin_bit_cast(v4i_, At[m][0]), a1_ = __builtin_bit_cast(v4i_, At[m][1]); \
                const v8i_ bb_ = {b0_[0], b0_[1], b0_[2], b0_[3], b1_[0], b1_[1], b1_[2], b1_[3]}, aa_ = {a0_[0], a0_[1], a0_[2], a0_[3], a1_[0], a1_[1], a1_[2], a1_[3]}; \
                asm volatile("v_mfma_scale_f32_16x16x128_f8f6f4 %0, %1, %2, %0, %3, %3 op_sel_hi:[0,0,0]" : "+v"(acc[ai][bj][m][n]) : "v"(bb_), "v"(aa_), "v"(f8scale_)); } } \
        else { _Pragma("unroll") for (int m = 0; m < 4; ++m) _Pragma("unroll") for (int n = 0; n < 2; ++n) _Pragma("unroll") for (int k = 0; k < 2; ++k) \
            acc[ai][bj][m][n] = __builtin_amdgcn_mfma_f32_16x16x32_bf16(Bt[n][k], At[m][k], acc[ai][bj][m][n], 0, 0, 0); } \
        __builtin_amdgcn_s_setprio(0); } while (0)
#define PG8_WAIT_V(n) asm volatile("s_waitcnt vmcnt(" #n ")" ::: "memory")
#define PG8_WAIT_L(n) asm volatile("s_waitcnt lgkmcnt(" #n ")" ::: "memory")
#define PG8_BAR __builtin_amdgcn_s_barrier()
#define PG8_SCHED __builtin_amdgcn_sched_barrier(0)
    Unit cur, nxt; int ui = 0;
    if (!S.next(0, cur)) return;
    cur.ord = 0;
    f32x4 acc[2][2][4][2];
#pragma unroll
    for (int a = 0; a < 2; ++a)
#pragma unroll
        for (int b = 0; b < 2; ++b)
#pragma unroll
            for (int m = 0; m < 4; ++m)
#pragma unroll
                for (int n = 0; n < 2; ++n) acc[a][b][m][n] = (f32x4){0.f, 0.f, 0.f, 0.f};
    bf16x8 At[4][2], B0[2][2], B1[2][2];
    const char* cA = (const char*)g.A + (size_t)cur.pm * tstep; const char* cB = (const char*)g.Bt + (size_t)cur.pn * tstep;
    S.a_ready(cur);
    if constexpr (SP2) {
        PG8_STAGE(PG8_SB(0, 0), cB, voffB); PG8_STAGE(PG8_SB(0, 1), cB + hstep, voffB); PG8_STAGE(PG8_SA(0, 0), cA, voffA); PG8_STAGE(PG8_SA(0, 1), cA + hstep, voffA);
        if (wr == 1) PG8_BAR;
        PG8_WAIT_V(2); PG8_BAR;
        PG8_STAGE(PG8_SB(1, 0), cB + kstep, voffB); PG8_STAGE(PG8_SA(1, 0), cA + kstep, voffA); PG8_STAGE(PG8_SB(1, 1), cB + hstep + kstep, voffB);
        PG8_WAIT_V(6); PG8_BAR;
    } else {
        PG8_STAGE(PG8_SB(0, 0), cB, voffB); PG8_STAGE(PG8_SA(0, 0), cA, voffA); PG8_STAGE(PG8_SB(0, 1), cB + hstep, voffB); PG8_STAGE(PG8_SA(0, 1), cA + hstep, voffA);
        if (wr == 1) PG8_BAR;
        PG8_WAIT_V(4); PG8_BAR;
        PG8_STAGE(PG8_SB(1, 0), cB + kstep, voffB); PG8_STAGE(PG8_SA(1, 0), cA + kstep, voffA); PG8_STAGE(PG8_SB(1, 1), cB + hstep + kstep, voffB);
        PG8_WAIT_V(6); PG8_BAR;
    }
    for (;;) {
        const bool has_next = S.next(ui + 1, nxt); nxt.ord = ui + 1;
        const char* nA = has_next ? (const char*)g.A + (size_t)nxt.pm * tstep : cA; const char* nB = has_next ? (const char*)g.Bt + (size_t)nxt.pn * tstep : cB;
        for (int t = 0; t < nt; t += 2) {
            const bool last = (t == nt - 2);
            const char* a1 = cA + (size_t)(t + 1) * kstep;
            const char* a2 = last ? nA : cA + (size_t)(t + 2) * kstep; const char* b2 = last ? nB : cB + (size_t)(t + 2) * kstep;
            const char* a3 = a2 + kstep; const char* b3 = b2 + kstep;
            if (last && has_next) S.a_ready(nxt);
            if constexpr (SP2) {
            PG8_LDB(B0, 0, 0); PG8_LDB(B1, 0, 1); PG8_SCHED; PG8_LDA(At, 0, 0); PG8_STAGE(PG8_SA(1, 1), a1 + hstep, voffA);
            PG8_WAIT_V(8); PG8_WAIT_L(0); PG8_BAR; PG8_MMA(0, 0, At, B0); PG8_MMA(0, 1, At, B1); PG8_BAR; PG8_SCHED;
            PG8_LDA(At, 0, 1); PG8_STAGE(PG8_SB(0, 0), b2, voffB); PG8_STAGE(PG8_SB(0, 1), b2 + hstep, voffB); PG8_STAGE(PG8_SA(0, 0), a2, voffA);
            PG8_WAIT_V(8); PG8_WAIT_L(0); PG8_BAR; PG8_MMA(1, 0, At, B0); PG8_MMA(1, 1, At, B1); PG8_BAR; PG8_SCHED;
            PG8_LDB(B0, 1, 0); PG8_LDB(B1, 1, 1); PG8_SCHED; PG8_LDA(At, 1, 0); PG8_STAGE(PG8_SA(0, 1), a2 + hstep, voffA);
            PG8_WAIT_V(8); PG8_WAIT_L(0); PG8_BAR; PG8_MMA(0, 0, At, B0); PG8_MMA(0, 1, At, B1); PG8_BAR; PG8_SCHED;
            PG8_LDA(At, 1, 1); PG8_STAGE(PG8_SB(1, 0), b3, voffB); PG8_STAGE(PG8_SB(1, 1), b3 + hstep, voffB); PG8_STAGE(PG8_SA(1, 0), a3, voffA);
            PG8_WAIT_V(8); PG8_WAIT_L(0); PG8_BAR; PG8_MMA(1, 0, At, B0); PG8_MMA(1, 1, At, B1); PG8_BAR; PG8_SCHED;
            } else {
            PG8_LDB(B0, 0, 0); PG8_SCHED; PG8_LDA(At, 0, 0); PG8_STAGE(PG8_SA(1, 1), a1 + hstep, voffA);
            PG8_WAIT_L(8); PG8_BAR; PG8_WAIT_L(0); PG8_MMA(0, 0, At, B0); PG8_BAR; PG8_SCHED;
            PG8_LDB(B1, 0, 1); PG8_STAGE(PG8_SB(0, 0), b2, voffB);
            PG8_BAR; PG8_WAIT_L(0); PG8_MMA(0, 1, At, B1); PG8_BAR;
            PG8_LDA(At, 0, 1); PG8_STAGE(PG8_SA(0, 0), a2, voffA);
            PG8_BAR; PG8_WAIT_L(0); PG8_MMA(1, 0, At, B0); PG8_BAR; PG8_SCHED;
            PG8_STAGE(PG8_SB(0, 1), b2 + hstep, voffB);
            PG8_WAIT_V(6); PG8_BAR; PG8_MMA(1, 1, At, B1); PG8_BAR;
            PG8_LDB(B0, 1, 0); PG8_SCHED; PG8_LDA(At, 1, 0); PG8_STAGE(PG8_SA(0, 1), a2 + hstep, voffA);
            PG8_WAIT_L(8); PG8_BAR; PG8_WAIT_L(0); PG8_MMA(0, 0, At, B0); PG8_BAR; PG8_SCHED;
            PG8_LDB(B1, 1, 1); PG8_STAGE(PG8_SB(1, 0), b3, voffB);
            PG8_BAR; PG8_WAIT_L(0); PG8_MMA(0, 1, At, B1); PG8_BAR;
            PG8_LDA(At, 1, 1); PG8_STAGE(PG8_SA(1, 0), a3, voffA);
            PG8_BAR; PG8_WAIT_L(0); PG8_MMA(1, 0, At, B0); PG8_BAR; PG8_SCHED;
            PG8_STAGE(PG8_SB(1, 1), b3 + hstep, voffB);
            PG8_WAIT_V(6); PG8_BAR; PG8_MMA(1, 1, At, B1); PG8_BAR;
            }
        }
        if constexpr (F8) asm volatile("s_nop 15\n\ts_nop 15" ::: "memory");
        if constexpr (ALIGN_EPI) { if (wr == 0) PG8_BAR; }
        if constexpr (!Epi::AFTER_DRAIN) { E(acc, cur, wr, wc, fr, fq); S.done(cur); }
        if (!has_next) break;
#pragma unroll
        for (int a = 0; a < 2; ++a)
#pragma unroll
            for (int b = 0; b < 2; ++b)
#pragma unroll
                for (int m = 0; m < 4; ++m)
#pragma unroll
                    for (int n = 0; n < 2; ++n) acc[a][b][m][n] = (f32x4){0.f, 0.f, 0.f, 0.f};
        cur = nxt; cA = nA; cB = nB; ++ui;
        if constexpr (ALIGN_EPI) { if (wr == 1) PG8_BAR; }
    }
    PG8_WAIT_V(0);
    if constexpr (!ALIGN_EPI) { if (wr == 0) PG8_BAR; }
    PG8_BAR;
    if constexpr (Epi::AFTER_DRAIN) { E.fused(acc, cur, wr, wc, fr, fq, lds, wid, lane); S.done(cur); }
#undef PG8_SA
#undef PG8_SB
#undef PG8_STAGE
#undef PG8_LDA
#undef PG8_LDB
#undef PG8_MMA
#undef PG8_WAIT_V
#undef PG8_WAIT_L
#undef PG8_BAR
#undef PG8_SCHED
}
}

#define GAS __attribute__((address_space(1)))
#define LAS __attribute__((address_space(3)))
typedef unsigned short bf16;
typedef unsigned v4u __attribute__((ext_vector_type(4)));
typedef float f32x4 __attribute__((ext_vector_type(4)));
typedef short bf16x8 __attribute__((ext_vector_type(8)));
typedef GAS unsigned gu32;
typedef GAS unsigned long long gu64;
#define RLX_AGENT __ATOMIC_RELAXED, __HIP_MEMORY_SCOPE_AGENT

#define XB_TMO      128
#define XB_XCNT(j)  (256  + 64 * (j))
#define XB_XSUB(j)  (1280 + 64 * (j))
#define XB_XGEN(j)  (2304 + 64 * (j))
#define XB_TOP      3328
#define XB_TOPGEN   3392
#define XCD_BAR_WORDS 3456
#define XB_SPIN_CAP (1u << 18)

__device__ __forceinline__ unsigned xb_ld(unsigned* p)              { return __hip_atomic_load(p, __ATOMIC_RELAXED, __HIP_MEMORY_SCOPE_AGENT); }
__device__ __forceinline__ unsigned xb_add(unsigned* p, unsigned v) { return __hip_atomic_fetch_add(p, v, __ATOMIC_RELAXED, __HIP_MEMORY_SCOPE_AGENT); }
__device__ __forceinline__ unsigned xb_xcc_id() { return (unsigned)__builtin_amdgcn_s_getreg((3 << 11) | 20) & 0xFu; }
#define XB_SPIN(cond, bar) do { unsigned _sp = 0; while (cond) { __builtin_amdgcn_s_sleep(1); \
    if ((++_sp & 255u) == 0u) { if (xb_ld(&(bar)[XB_TMO])) break; if (_sp > XB_SPIN_CAP) { atomicAdd(&(bar)[XB_TMO], 1u); break; } } } } while (0)

struct XcdBarrier {
    unsigned* bar; unsigned x;
    volatile LAS unsigned* st;
};

__device__ __forceinline__ XcdBarrier xcd_barrier_post(unsigned* bar, volatile LAS unsigned* st) {
    XcdBarrier b; b.bar = bar; b.x = xb_xcc_id(); b.st = st;
    if (threadIdx.x == 0) (void)xb_add(&bar[XB_XCNT(b.x)], 1u);
    return b;
}
__device__ __forceinline__ void xcd_barrier_complete(unsigned* bar, unsigned x, unsigned& nloc, unsigned& nx) {
    const unsigned G = gridDim.x * gridDim.y * gridDim.z;
    unsigned sum, cnt, mine, sp = 0u;
    for (;;) {
        sum = 0u; cnt = 0u; mine = 0u;
#pragma unroll
        for (unsigned j = 0; j < 16; ++j) { const unsigned c = xb_ld(&bar[XB_XCNT(j)]); sum += c; cnt += (c > 0u) ? 1u : 0u; mine = (j == x) ? c : mine; }
        if (sum == G) break;
        __builtin_amdgcn_s_sleep(1);
        if ((++sp & 255u) == 0u) { if (xb_ld(&bar[XB_TMO])) break; if (sp > XB_SPIN_CAP) { atomicAdd(&bar[XB_TMO], 1u); break; } }
    }
    nloc = mine > 0u ? mine : 1u; nx = cnt > 0u ? cnt : 1u;
}

__device__ __forceinline__ void xcd_barrier(const XcdBarrier& b) {
    asm volatile("s_waitcnt vmcnt(0)" ::: "memory");
    __syncthreads();
    if (threadIdx.x == 0) {
        unsigned* bar = b.bar;
        __builtin_amdgcn_s_waitcnt(0);
        unsigned nloc = b.st[0], nx = b.st[1];
        if (nloc == 0u) { xcd_barrier_complete(bar, b.x, nloc, nx); b.st[0] = nloc; b.st[1] = nx; }
        const unsigned old = xb_add(&bar[XB_XSUB(b.x)], 1u);
        const unsigned gen = old / nloc;
        if (old + 1u == (gen + 1u) * nloc) {
            __builtin_amdgcn_fence(__ATOMIC_RELEASE, "agent");
            asm volatile("s_waitcnt vmcnt(0)" ::: "memory");
            const unsigned og = xb_add(&bar[XB_TOP], 1u);
            const unsigned tg = og / nx;
            if (og + 1u == (tg + 1u) * nx) xb_add(&bar[XB_TOPGEN], 1u);
            else XB_SPIN(xb_ld(&bar[XB_TOPGEN]) == tg, bar);
            __builtin_amdgcn_fence(__ATOMIC_ACQUIRE, "agent");
            xb_add(&bar[XB_XGEN(b.x)], 1u);
            asm volatile("s_waitcnt vmcnt(0)" ::: "memory");
        } else {
            XB_SPIN(xb_ld(&bar[XB_XGEN(b.x)]) == gen, bar);
            __builtin_amdgcn_fence(__ATOMIC_ACQUIRE, "agent");
            asm volatile("s_waitcnt vmcnt(0)" ::: "memory");
        }
    }
    __syncthreads();
}

constexpr int BATCH = 4, T = 8192, D = 1024, M = BATCH * T, FF = 2816, DPLE = 256, DIN = 4040;
constexpr int NWAVES = 8;
constexpr size_t MiB = 1u << 20;
constexpr size_t WS_CTL = 0, CTL_ZERO_BYTES = 1 * MiB;
constexpr size_t WS_RSQ1 = 1 * MiB, WS_RSQ2 = 3 * MiB, WS_RSQ3 = 5 * MiB, WS_RSQ4 = 7 * MiB, WS_IW = 9 * MiB;
constexpr size_t WS_W1 = 10 * MiB, WS_W2 = 21 * MiB, WS_WIN = 27 * MiB, WS_WA = 35 * MiB, WS_WB = 36 * MiB, WS_WO = 37 * MiB, WS_W3 = 39 * MiB, WS_W4 = 50 * MiB, WS_WG = 56 * MiB, WS_WP = 58 * MiB;
constexpr size_t WS_HB = 64 * MiB, WS_ACT = 128 * MiB, WS_TA = WS_ACT, WS_MIX = WS_ACT + 64 * MiB, WS_PP = WS_ACT;
constexpr size_t WS_X8 = 304 * MiB, WS_SEL = WS_X8, WS_AQ = 336 * MiB, WS_BQ = 368 * MiB, WS_IQ = 400 * MiB, WS_AK = 432 * MiB, WS_AVT = 440 * MiB, WS_BK = 448 * MiB, WS_BV = 452 * MiB, WS_IK = 456 * MiB, WS_PB = 460 * MiB, WS_YA8 = 476 * MiB, WS_YB8 = 492 * MiB, WS_END = 508 * MiB;
constexpr int CW_BAR = 4096;
static_assert(pg8::PJ_AQ == WS_AQ && pg8::PJ_BQ == WS_BQ && pg8::PJ_IQ == WS_IQ && pg8::PJ_AK == WS_AK && pg8::PJ_AVT == WS_AVT && pg8::PJ_BK == WS_BK && pg8::PJ_BV == WS_BV && pg8::PJ_IK == WS_IK && pg8::PJ_IW == WS_IW, "EpiProj offsets");
constexpr int RING_OFF = 0, RING_BYTES = 131072;
constexpr int LDSCTL_OFF = 159744, MISC_OFF = LDSCTL_OFF + 320;
constexpr int LDS_BYTES = 160256;

#define LDS_WAIT() asm volatile("s_waitcnt lgkmcnt(0)" ::: "memory")
#define VM_WAIT() asm volatile("s_waitcnt vmcnt(0)" ::: "memory")
__device__ __forceinline__ unsigned f2bf(float f) { unsigned u = __builtin_bit_cast(unsigned, f); return (u + 0x7fffu + ((u >> 16) & 1u)) >> 16; }
__device__ __forceinline__ unsigned pk2(float lo, float hi) { return f2bf(lo) | (f2bf(hi) << 16); }
__device__ __forceinline__ float wave_sum(float v) {
#pragma unroll
    for (int o = 1; o < 64; o <<= 1) v += __shfl_xor(v, o);
    return v;
}

struct MapId { __device__ __forceinline__ void operator()(int n, int& sc, float& cs) const { sc = n; cs = 1.f; } };
struct MapFfnIn { __device__ __forceinline__ void operator()(int n, int& sc, float& cs) const { const int pn = n >> 8, bj = (n >> 7) & 1, i = n & 127; sc = bj * FF + 128 * pn + i; cs = 1.f; } };
struct MapWin { __device__ __forceinline__ void operator()(int n, int& sc, float& cs) const {
    const float CQ = 0.125f * 1.4426950408889634f; cs = 1.f;
    if (n < 1280) { sc = n; if (n < 512 || n >= 768) cs = CQ; }
    else if (n < 1536) { const int i = n - 1280; if (i < 128) sc = 1280 + i; else if (i < 192) sc = 1920 + (i - 128); else if (i < 200) { sc = 1984 + (i - 192); cs = 0.35355339059327373f; } else sc = -1; }
    else if (n < 2048) { sc = 1408 + (n - 1536); cs = 0.125f; }
    else if (n < 3072) sc = 1992 + (n - 2048);
    else sc = 3016 + (n - 3072);
} };
struct MapGate { __device__ __forceinline__ void operator()(int n, int& sc, float& cs) const { sc = 1992 + n; cs = 1.f; } };
template <class MAP>
__device__ __forceinline__ void tr_item(const float* W, int Nsrc, int K, bf16* WT, const float* gain, LAS float* scr, int item, int nblk, int lane, MAP map) {
    const int kb = item / nblk, nb = item % nblk, k0 = 64 * kb, n0 = 32 * nb;
    int sc; float cs; map(n0 + (lane & 7) * 4, sc, cs);
    {
        f32x4 ld[8];
#pragma unroll
        for (int i = 0; i < 8; ++i) { const int kk = 8 * i + (lane >> 3); ld[i] = (f32x4){0.f, 0.f, 0.f, 0.f}; if (sc >= 0) ld[i] = *(const GAS f32x4*)(W + (size_t)(k0 + kk) * Nsrc + sc); }
#pragma unroll
        for (int i = 0; i < 8; ++i) { const int kk = 8 * i + (lane >> 3); float gk = cs; if (gain) gk *= gain[k0 + kk]; LAS float* d = scr + kk * 33 + (lane & 7) * 4; d[0] = ld[i][0] * gk; d[1] = ld[i][1] * gk; d[2] = ld[i][2] * gk; d[3] = ld[i][3] * gk; }
    }
    LDS_WAIT(); asm volatile("" ::: "memory");
    const int c = lane & 7;
#pragma unroll
    for (int j = 0; j < 4; ++j) { const int n = (lane >> 3) + 8 * j; const LAS float* s = scr + (8 * c) * 33 + n;
        v4u o; o.x = pk2(s[0 * 33], s[1 * 33]); o.y = pk2(s[2 * 33], s[3 * 33]); o.z = pk2(s[4 * 33], s[5 * 33]); o.w = pk2(s[6 * 33], s[7 * 33]);
        *(GAS v4u*)(WT + (size_t)(n0 + n) * K + k0 + 8 * c) = o; }
    LDS_WAIT(); asm volatile("" ::: "memory");
}

template <class MAP>
__device__ __forceinline__ void tr_item8(const float* W, int Nsrc, int K, unsigned char* WT, const float* gain, LAS float* scr, int item, int nblk, int lane, MAP map, float scale) {
    const int kb = item / nblk, nb = item % nblk, k0 = 64 * kb, n0 = 32 * nb;
    int sc; float cs; map(n0 + (lane & 7) * 4, sc, cs); cs *= scale;
    {
        f32x4 ld[8];
#pragma unroll
        for (int i = 0; i < 8; ++i) { const int kk = 8 * i + (lane >> 3); ld[i] = (f32x4){0.f, 0.f, 0.f, 0.f}; if (sc >= 0) ld[i] = *(const GAS f32x4*)(W + (size_t)(k0 + kk) * Nsrc + sc); }
#pragma unroll
        for (int i = 0; i < 8; ++i) { const int kk = 8 * i + (lane >> 3); float gk = cs; if (gain) gk *= gain[k0 + kk]; LAS float* d = scr + kk * 33 + (lane & 7) * 4; d[0] = ld[i][0] * gk; d[1] = ld[i][1] * gk; d[2] = ld[i][2] * gk; d[3] = ld[i][3] * gk; }
    }
    LDS_WAIT(); asm volatile("" ::: "memory");
    const int c = lane & 3;
#pragma unroll
    for (int j = 0; j < 2; ++j) { const int n = (lane >> 2) + 16 * j; const LAS float* s = scr + (16 * c) * 33 + n;
        v4u o; o.x = pg8::pack4_fp8(s[0 * 33], s[1 * 33], s[2 * 33], s[3 * 33]); o.y = pg8::pack4_fp8(s[4 * 33], s[5 * 33], s[6 * 33], s[7 * 33]);
        o.z = pg8::pack4_fp8(s[8 * 33], s[9 * 33], s[10 * 33], s[11 * 33]); o.w = pg8::pack4_fp8(s[12 * 33], s[13 * 33], s[14 * 33], s[15 * 33]);
        *(GAS v4u*)(WT + (size_t)(n0 + n) * K + k0 + 16 * c) = o; }
    LDS_WAIT(); asm volatile("" ::: "memory");
}

__device__ __forceinline__ void tr_generic(const float* W, int Nsrc, int K, unsigned char* dst, const float* gain, int mapid, int f8, LAS float* scr, int item, int nblk, int lane) {
    const int kb = item / nblk, nb = item % nblk, k0 = 64 * kb, n0 = 32 * nb;
    int sc; float cs; { const int n = n0 + (lane & 7) * 4;
        if (mapid == 0) MapId()(n, sc, cs); else if (mapid == 1) MapFfnIn()(n, sc, cs); else if (mapid == 2) MapWin()(n, sc, cs); else MapGate()(n, sc, cs); }
    if (f8) cs *= pg8::F8_WSCALE;
    {
        f32x4 ld[8];
#pragma unroll
        for (int i = 0; i < 8; ++i) { const int kk = 8 * i + (lane >> 3); ld[i] = (f32x4){0.f, 0.f, 0.f, 0.f}; if (sc >= 0) ld[i] = *(const GAS f32x4*)(W + (size_t)(k0 + kk) * Nsrc + sc); }
#pragma unroll
        for (int i = 0; i < 8; ++i) { const int kk = 8 * i + (lane >> 3); float gk = cs; if (gain) gk *= gain[k0 + kk]; LAS float* d = scr + kk * 33 + (lane & 7) * 4; d[0] = ld[i][0] * gk; d[1] = ld[i][1] * gk; d[2] = ld[i][2] * gk; d[3] = ld[i][3] * gk; }
    }
    LDS_WAIT(); asm volatile("" ::: "memory");
    if (f8) {
        const int c = lane & 3;
#pragma unroll
        for (int j = 0; j < 2; ++j) { const int n = (lane >> 2) + 16 * j; const LAS float* s = scr + (16 * c) * 33 + n;
            v4u o; o.x = pg8::pack4_fp8(s[0 * 33], s[1 * 33], s[2 * 33], s[3 * 33]); o.y = pg8::pack4_fp8(s[4 * 33], s[5 * 33], s[6 * 33], s[7 * 33]);
            o.z = pg8::pack4_fp8(s[8 * 33], s[9 * 33], s[10 * 33], s[11 * 33]); o.w = pg8::pack4_fp8(s[12 * 33], s[13 * 33], s[14 * 33], s[15 * 33]);
            *(GAS v4u*)(dst + (size_t)(n0 + n) * K + k0 + 16 * c) = o; }
    } else {
        const int c = lane & 7;
#pragma unroll
        for (int j = 0; j < 4; ++j) { const int n = (lane >> 3) + 8 * j; const LAS float* s = scr + (8 * c) * 33 + n;
            v4u o; o.x = pk2(s[0 * 33], s[1 * 33]); o.y = pk2(s[2 * 33], s[3 * 33]); o.z = pk2(s[4 * 33], s[5 * 33]); o.w = pk2(s[6 * 33], s[7 * 33]);
            *(GAS v4u*)(dst + ((size_t)(n0 + n) * K + k0 + 8 * c) * 2) = o; }
    }
    LDS_WAIT(); asm volatile("" ::: "memory");
}

#ifndef PH_MASK
#define PH_MASK 0x7ff
#endif
template <class T_> __device__ __forceinline__ T_* as_global(T_* p) { return (T_*)(GAS T_*)p; }


namespace att {
typedef float f32x16 __attribute__((ext_vector_type(16)));
typedef short s16x4 __attribute__((ext_vector_type(4)));
typedef unsigned long long u64;
constexpr float LOG2E = 1.4426950408889634f;
__device__ __forceinline__ int crow(int r, int hi) { return (r & 3) + 8 * (r >> 2) + 4 * hi; }
__device__ __forceinline__ unsigned cvtpk(float lo, float hi) { unsigned r; asm volatile("v_cvt_pk_bf16_f32 %0, %1, %2" : "=v"(r) : "v"(lo), "v"(hi)); return r; }

constexpr int SWA_K = 0, SWA_V = 32768, SWA_VROW = 520;
__device__ __forceinline__ void swa_unit(int b, int n, int g, unsigned char* wsb, const float* sink, LAS unsigned char* L, int wid, int lane, int tid, size_t dst_off) {
    { GAS unsigned char* wg_ = (GAS unsigned char*)wsb; asm volatile("" : "+s"(wg_)); wsb = (unsigned char*)wg_; } const bf16* AQ = (const bf16*)(wsb + WS_AQ); const bf16* AK = (const bf16*)(wsb + WS_AK); const bf16* AVT = (const bf16*)(wsb + WS_AVT);
    const int hh = wid >> 1, qh = wid & 1, head = 4 * g + hh, r32 = lane & 31, hi = lane >> 5;
    const float slope2 = __builtin_amdgcn_exp2f(-0.5f * (float)(head + 1)) * LOG2E, sink2 = sink[head] * LOG2E;
    const size_t rowb = (size_t)b * T;
    const int kt0 = 128 * n - 128;
#pragma unroll
    for (int i = 0; i < 4; ++i) {
        const int row = (tid >> 3) + 64 * i, ch = tid & 7; int key = kt0 + row; if (key < 0) key = 0;
        const v4u v = *(const v4u*)(AK + (rowb + key) * 128 + g * 64 + ch * 8);
        *(LAS v4u*)(L + SWA_K + row * 128 + ((ch ^ ((row >> 1) & 7)) << 4)) = v;
    }
#pragma unroll
    for (int i = 0; i < 4; ++i) {
        const int d = (tid >> 5) + 16 * i, ch = tid & 31; int key0 = kt0 + 8 * ch; if (key0 < 0) key0 = 0;
        const v4u v = *(const v4u*)(AVT + ((size_t)((b * 2 + g) * 64 + d)) * T + key0);
        LAS u64* dp = (LAS u64*)(L + SWA_V + d * SWA_VROW + ch * 16);
        dp[0] = (u64)v.x | ((u64)v.y << 32); dp[1] = (u64)v.z | ((u64)v.w << 32);
    }
    __syncthreads();
    for (int qs = 0; qs < 2; ++qs) {
        const int qq0 = 128 * n + 64 * qh + 32 * qs, kbase = qq0 - 128, lrow0 = 64 * qh + 32 * qs;
        const bf16* qp = AQ + (rowb + qq0 + r32) * 512 + head * 64;
        bf16x8 qf[4];
#pragma unroll
        for (int ks = 0; ks < 4; ++ks) qf[ks] = *(const bf16x8*)(qp + 8 * hi + 16 * ks);
        float mrun = sink2, lrun = 1.0f;
        f32x16 O0 = {}, O1 = {};
#pragma unroll
        for (int kb = 0; kb < 5; ++kb) {
            const int row = lrow0 + 32 * kb + r32, sw = (row >> 1) & 7;
            f32x16 acc = {};
#pragma unroll
            for (int ks = 0; ks < 4; ++ks) acc = __builtin_amdgcn_mfma_f32_32x32x16_bf16(*(const LAS bf16x8*)(L + SWA_K + row * 128 + (((2 * ks + hi) ^ sw) << 4)), qf[ks], acc, 0, 0, 0);
            float bm = -__builtin_inff();
            int dist0 = r32 + 128 - 32 * kb - 4 * hi; asm volatile("" : "+v"(dist0));
            const bool bvalid = (kbase + 32 * kb) >= 0;
#pragma unroll
            for (int r = 0; r < 16; ++r) {
                const int dist = dist0 - ((r & 3) + 8 * (r >> 2));
                const bool valid = bvalid && ((unsigned)dist < 128u);
                const float l = valid ? (acc[r] - slope2 * (float)dist) : -__builtin_inff();
                acc[r] = l; bm = fmaxf(bm, l);
            }
            bm = fmaxf(bm, __shfl_xor(bm, 32));
            const float mnew = fmaxf(mrun, bm), alpha = __builtin_amdgcn_exp2f(mrun - mnew);
            float bs = 0.f;
#pragma unroll
            for (int r = 0; r < 16; ++r) { const float e = __builtin_amdgcn_exp2f(acc[r] - mnew); acc[r] = e; bs += e; }
            bs += __shfl_xor(bs, 32);
            lrun = lrun * alpha + bs; mrun = mnew;
#pragma unroll
            for (int r = 0; r < 16; ++r) { O0[r] *= alpha; O1[r] *= alpha; }
#pragma unroll
            for (int s2 = 0; s2 < 2; ++s2) {
                v4u pw; pw.x = cvtpk(acc[8 * s2 + 0], acc[8 * s2 + 1]); pw.y = cvtpk(acc[8 * s2 + 2], acc[8 * s2 + 3]);
                pw.z = cvtpk(acc[8 * s2 + 4], acc[8 * s2 + 5]); pw.w = cvtpk(acc[8 * s2 + 6], acc[8 * s2 + 7]);
                const bf16x8 pf = __builtin_bit_cast(bf16x8, pw);
                const int tb = lrow0 + 32 * kb + 16 * s2 + 4 * hi;
                const LAS unsigned char* vp = L + SWA_V + r32 * SWA_VROW + 2 * tb;
                typedef u64 u64x2 __attribute__((ext_vector_type(2)));
                u64x2 v0, v1; v0.x = *(const LAS u64*)vp; v0.y = *(const LAS u64*)(vp + 16); v1.x = *(const LAS u64*)(vp + 32 * SWA_VROW); v1.y = *(const LAS u64*)(vp + 32 * SWA_VROW + 16);
                O0 = __builtin_amdgcn_mfma_f32_32x32x16_bf16(__builtin_bit_cast(bf16x8, v0), pf, O0, 0, 0, 0);
                O1 = __builtin_amdgcn_mfma_f32_32x32x16_bf16(__builtin_bit_cast(bf16x8, v1), pf, O1, 0, 0, 0);
            }
        }
        { const float inv = 1.0f / lrun;
#pragma unroll
          for (int r = 0; r < 16; ++r) { O0[r] *= inv; O1[r] *= inv; } }
#pragma unroll
        for (int rg = 0; rg < 4; ++rg) {
            const int d = 8 * rg + 4 * hi;
            const unsigned w0 = pg8::pack4_fp8(O0[4 * rg], O0[4 * rg + 1], O0[4 * rg + 2], O0[4 * rg + 3]);
            const unsigned w1 = pg8::pack4_fp8(O1[4 * rg], O1[4 * rg + 1], O1[4 * rg + 2], O1[4 * rg + 3]);
            unsigned char* op = (unsigned char*)(wsb + dst_off) + (rowb + qq0 + r32) * 512 + head * 64; *(unsigned*)(op + d) = w0; *(unsigned*)(op + 32 + d) = w1;
        }
    }
    __syncthreads();
}

constexpr int CB = 448;
constexpr int L_KT = 0, L_BUF = 32768, L_HIST = 32768, L_QINFO = L_BUF + 64 * CB * 4, L_WSCR = L_QINFO + 2048, L_END = L_WSCR + 8 * 1024, L_VBUF = 0;
__device__ __forceinline__ float relu_i(float x) { const int b = __builtin_bit_cast(int, x); return __builtin_bit_cast(float, b > 0 ? b : 0); }
template <int PASS>
__device__ __forceinline__ void idx_post(const f32x16& acc, int rb, int kb, int s, int t0, LAS unsigned char* L, const float (&wq)[2][2][8], const int (&qa)[2][2], const int (&qb)[2][2], int (&eqseen)[2][2], int (&cnt)[2][2], unsigned (&cw)[2][2][2], int wid, int r32, int hi) {
    LAS unsigned* hist = (LAS unsigned*)(L + L_HIST);
    LAS unsigned* buf = (LAS unsigned*)(L + L_BUF);
#pragma unroll
    for (int g2 = 0; g2 < 2; ++g2) {
        float sc = relu_i(acc[8 * g2]) * wq[rb][g2][0];
#pragma unroll
        for (int hd = 1; hd < 8; ++hd) sc = fmaf(relu_i(acc[8 * g2 + hd]), wq[rb][g2][hd], sc);
        const int ql = 8 * wid + 4 * rb + 2 * g2 + hi, tq = t0 + ql;
        const bool valid = s <= tq;
        const _Float16 hf = (_Float16)sc; const int hb = (int)__builtin_bit_cast(short, hf);
        const unsigned u = (unsigned)(hb ^ ((hb >> 16) | 0x8000)) & 0xffffu;
        if (PASS == 1 || PASS == 4) { if (PASS == 1) __hip_atomic_fetch_add(hist + ql * 256 + (u >> 8), valid ? (1u << ((u >> 3) & 16u)) : 0u, __ATOMIC_RELAXED, __HIP_MEMORY_SCOPE_WORKGROUP);
            cw[rb][g2][kb >> 1] |= (valid ? u : 0u) << (16 * (kb & 1)); }
        else if (PASS == 2) { const bool c = valid && (int)(u >> 7) == qa[rb][g2]; if (__ballot(c) != 0ull) __hip_atomic_fetch_add(hist + ql * 256 + (u & 127u), c ? 1u : 0u, __ATOMIC_RELAXED, __HIP_MEMORY_SCOPE_WORKGROUP); }
        else {
            const bool gt = valid && ((int)u > qa[rb][g2]), eq = valid && ((int)u == qa[rb][g2]);
            const unsigned ltm = (1u << r32) - 1u;
            const u64 em = __ballot(eq);
            const unsigned mh = hi ? (unsigned)(em >> 32) : (unsigned)em;
            const bool keep = gt || (eq && (eqseen[rb][g2] + __popc(mh & ltm)) < qb[rb][g2]);
            eqseen[rb][g2] += __popc(mh);
            const u64 km = __ballot(keep);
            const unsigned kh = hi ? (unsigned)(km >> 32) : (unsigned)km;
            const int pos = cnt[rb][g2] + __popc(kh & ltm);
            if (keep && pos < CB) buf[ql * CB + pos] = (u << 16) | (unsigned)s;
            cnt[rb][g2] += __popc(kh);
        }
    }
}
template <int PASS>
__device__ __forceinline__ void idx_tile(int t0, int kt, const LAS unsigned char* kbuf, LAS unsigned char* L, const bf16x8 (&af)[2][4], const float (&wq)[2][2][8], const int (&qa)[2][2], const int (&qb)[2][2], int (&eqseen)[2][2], int (&cnt)[2][2], unsigned short* codes, int cstride, int wid, int r32, int hi) {
    unsigned cw[2][2][2];
#pragma unroll
    for (int rb = 0; rb < 2; ++rb)
#pragma unroll
        for (int g2 = 0; g2 < 2; ++g2) { cw[rb][g2][0] = 0u; cw[rb][g2][1] = 0u; }
#pragma unroll
    for (int kb = 0; kb < 4; ++kb) {
        bf16x8 bfr[4];
        const int lrow = 32 * kb + r32;
#pragma unroll
        for (int ks = 0; ks < 4; ++ks) bfr[ks] = *(const LAS bf16x8*)(kbuf + lrow * 128 + (((2 * ks + hi) ^ ((lrow >> 1) & 7)) << 4));
        const int s = 128 * kt + 4 * r32 + kb;
        f32x16 acc0 = {}, acc1 = {};
#pragma unroll
        for (int ks = 0; ks < 4; ++ks) acc0 = __builtin_amdgcn_mfma_f32_32x32x16_bf16(af[0][ks], bfr[ks], acc0, 0, 0, 0);
#pragma unroll
        for (int ks = 0; ks < 4; ++ks) acc1 = __builtin_amdgcn_mfma_f32_32x32x16_bf16(af[1][ks], bfr[ks], acc1, 0, 0, 0);
        idx_post<PASS>(acc0, 0, kb, s, t0, L, wq, qa, qb, eqseen, cnt, cw, wid, r32, hi);
        idx_post<PASS>(acc1, 1, kb, s, t0, L, wq, qa, qb, eqseen, cnt, cw, wid, r32, hi);
    }
    if (PASS == 1 || PASS == 4) {
#pragma unroll
        for (int rb = 0; rb < 2; ++rb)
#pragma unroll
            for (int g2 = 0; g2 < 2; ++g2) { const int ql = 8 * wid + 4 * rb + 2 * g2 + hi;
                *(u64*)(codes + (size_t)ql * cstride + 128 * kt + 4 * r32) = (u64)cw[rb][g2][0] | ((u64)cw[rb][g2][1] << 32); }
    }
}
template <int PASS>
__device__ __forceinline__ void idx_pass(int b, int t0, int kt0, int nt, unsigned char* wsb, unsigned short* codes, int cstride, LAS unsigned char* L, const bf16x8 (&af)[2][4], const float (&wq)[2][2][8], int wid, int lane, int tid) {
    { GAS unsigned char* wg_ = (GAS unsigned char*)wsb; asm volatile("" : "+s"(wg_)); wsb = (unsigned char*)wg_; } const bf16* IK = (const bf16*)(wsb + WS_IK);
    const int r32 = lane & 31, hi = lane >> 5;
    LAS int* qinfo = (LAS int*)(L + L_QINFO);
    int qa[2][2], qb[2][2], eqseen[2][2], cnt[2][2];
#pragma unroll
    for (int rb = 0; rb < 2; ++rb)
#pragma unroll
        for (int g2 = 0; g2 < 2; ++g2) { const int ql = 8 * wid + 4 * rb + 2 * g2 + hi; eqseen[rb][g2] = 0; cnt[rb][g2] = 0;
            if (PASS == 2) { qa[rb][g2] = qinfo[ql]; qb[rb][g2] = 0; } else if (PASS == 3) { qa[rb][g2] = qinfo[128 + ql]; qb[rb][g2] = qinfo[192 + ql]; cnt[rb][g2] = qinfo[256 + ql]; eqseen[rb][g2] = qinfo[384 + ql]; } else { qa[rb][g2] = 0; qb[rb][g2] = 0; } }
    const int skey = tid >> 2, sc0 = (tid & 3) * 2;
    const bf16* src = IK + ((size_t)b * T + skey) * 64 + sc0 * 8;
    const int srow = (skey & 3) * 32 + (skey >> 2);
    const int sd0 = srow * 128 + ((sc0 ^ ((srow >> 1) & 7)) << 4), sd1 = srow * 128 + (((sc0 + 1) ^ ((srow >> 1) & 7)) << 4);
    v4u A0, A1, B0, B1;
#define IDX_LOAD(R0, R1, tile) do { const bf16* s_ = src + (size_t)(tile) * (128 * 64); R0 = *(const v4u*)s_; R1 = *(const v4u*)(s_ + 8); } while (0)
#define IDX_WRITE(R0, R1, buf) do { *(LAS v4u*)(L + L_KT + (buf) * 16384 + sd0) = R0; *(LAS v4u*)(L + L_KT + (buf) * 16384 + sd1) = R1; } while (0)
    IDX_LOAD(A0, A1, kt0); IDX_LOAD(B0, B1, (kt0 + 1 < nt ? kt0 + 1 : kt0));
    IDX_WRITE(A0, A1, 0);
    __syncthreads();
    for (int kt = kt0; kt < nt; kt += 2) {
        { const int tn = (kt + 2 < nt) ? kt + 2 : nt - 1; IDX_LOAD(A0, A1, tn); }
        idx_tile<PASS>(t0, kt, L + L_KT, L, af, wq, qa, qb, eqseen, cnt, codes, cstride, wid, r32, hi);
        IDX_WRITE(B0, B1, 1);
        __syncthreads();
        if (kt + 1 >= nt) break;
        { const int tn = (kt + 3 < nt) ? kt + 3 : nt - 1; IDX_LOAD(B0, B1, tn); }
        idx_tile<PASS>(t0, kt + 1, L + L_KT + 16384, L, af, wq, qa, qb, eqseen, cnt, codes, cstride, wid, r32, hi);
        IDX_WRITE(A0, A1, 0);
        __syncthreads();
    }
#undef IDX_LOAD
#undef IDX_WRITE
    if (PASS == 3) {
#pragma unroll
        for (int rb = 0; rb < 2; ++rb)
#pragma unroll
            for (int g2 = 0; g2 < 2; ++g2) if (r32 == 0) qinfo[256 + 8 * wid + 4 * rb + 2 * g2 + hi] = cnt[rb][g2];
    }
}
template <bool NB16>
__device__ __forceinline__ void find_bin(const LAS unsigned* hq, int K, int lane, int& bin, int& above, int& incnt) {
    const v4u w = *(const LAS v4u*)(hq + 4 * lane);
    int c[8];
    if (NB16) { c[0] = w.x & 0xffffu; c[1] = w.x >> 16; c[2] = w.y & 0xffffu; c[3] = w.y >> 16; c[4] = w.z & 0xffffu; c[5] = w.z >> 16; c[6] = w.w & 0xffffu; c[7] = w.w >> 16; }
    else { c[0] = (int)w.x; c[1] = (int)w.y; c[2] = (int)w.z; c[3] = (int)w.w; c[4] = 0; c[5] = 0; c[6] = 0; c[7] = 0; }
    constexpr int NC = NB16 ? 8 : 4;
    int tot = 0;
#pragma unroll
    for (int i = 0; i < NC; ++i) tot += c[i];
    int S = tot;
#pragma unroll
    for (int o = 1; o < 64; o <<= 1) { const int t = __shfl_down(S, o); if (lane + o < 64) S += t; }
    const int ab = S - tot;
    const bool here = (S >= K) && (ab < K);
    const u64 bm = __ballot(here);
    int mybin = NC * lane, myab = ab, myc = c[0]; bool found = false;
#pragma unroll
    for (int i = NC - 1; i >= 0; --i) { if (!found) { if (myab + c[i] >= K || i == 0) { mybin = NC * lane + i; myc = c[i]; found = true; } else myab += c[i]; } }
    const int Ls = (bm == 0ull) ? 0 : (__ffsll((long long)bm) - 1);
    bin = __shfl(mybin, Ls); above = __shfl(myab, Ls); incnt = __shfl(myc, Ls);
}
__device__ __forceinline__ int prune256(LAS unsigned* buf, int n, LAS unsigned* wh, int lane) {
    const unsigned ltm_lo = (lane < 32) ? ((1u << lane) - 1u) : 0xffffffffu, ltm_hi = (lane < 32) ? 0u : ((1u << (lane - 32)) - 1u);
#pragma unroll
    for (int i = 0; i < 4; ++i) wh[i * 64 + lane] = 0u;
    LDS_WAIT();
    for (int i = lane; i < n; i += 64) __hip_atomic_fetch_add(wh + (buf[i] >> 24), 1u, __ATOMIC_RELAXED, __HIP_MEMORY_SCOPE_WORKGROUP);
    LDS_WAIT();
    int b1, ab1, c1; find_bin<false>(wh, 256, lane, b1, ab1, c1);
#pragma unroll
    for (int i = 0; i < 4; ++i) wh[i * 64 + lane] = 0u;
    LDS_WAIT();
    for (int i = lane; i < n; i += 64) { const unsigned e = buf[i]; if ((int)(e >> 24) == b1) __hip_atomic_fetch_add(wh + ((e >> 16) & 255u), 1u, __ATOMIC_RELAXED, __HIP_MEMORY_SCOPE_WORKGROUP); }
    LDS_WAIT();
    int b2, ab2, c2; find_bin<false>(wh, 256 - ab1, lane, b2, ab2, c2);
    const int Tc = (b1 << 8) | b2, need = 256 - ab1 - ab2;
    int eqseen = 0, outc = 0;
    for (int c0 = 0; c0 < n; c0 += 64) {
        const int i = c0 + lane; const unsigned e = (i < n) ? buf[i] : 0u; const int code = (int)(e >> 16);
        const bool gt = (i < n) && code > Tc, eq = (i < n) && code == Tc;
        const u64 em = __ballot(eq);
        const int rank = eqseen + __popc((unsigned)em & ltm_lo) + __popc((unsigned)(em >> 32) & ltm_hi);
        const bool keep = gt || (eq && rank < need);
        eqseen += __popcll(em);
        const u64 km = __ballot(keep);
        const int pos = outc + __popc((unsigned)km & ltm_lo) + __popc((unsigned)(km >> 32) & ltm_hi);
        LDS_WAIT();
        if (keep) buf[pos] = e;
        outc += __popcll(km);
    }
    LDS_WAIT();
    return Tc;
}

__device__ __forceinline__ unsigned scan_hits(const v4u cur, int T) {
    const unsigned c0 = cur.x & 0xffffu, c1 = cur.x >> 16, c2 = cur.y & 0xffffu, c3 = cur.y >> 16, c4 = cur.z & 0xffffu, c5 = cur.z >> 16, c6 = cur.w & 0xffffu, c7 = cur.w >> 16;
    return ((int)c0 > T ? 1u : 0u) | ((int)c1 > T ? 2u : 0u) | ((int)c2 > T ? 4u : 0u) | ((int)c3 > T ? 8u : 0u) | ((int)c4 > T ? 16u : 0u) | ((int)c5 > T ? 32u : 0u) | ((int)c6 > T ? 64u : 0u) | ((int)c7 > T ? 128u : 0u);
}
__device__ __forceinline__ void scan_block(const v4u cur, int kk, int& T, LAS unsigned* buf, int& cnt, LAS unsigned* wh, int lane, u64 ltm) {
    unsigned keep = scan_hits(cur, T);
    int kc = __popc(keep);
    u64 b0 = __ballot(kc & 1), b1 = __ballot(kc & 2), b2 = __ballot(kc & 4), b3 = __ballot(kc & 8);
    int tot = __popcll(b0) + 2 * __popcll(b1) + 4 * __popcll(b2) + 8 * __popcll(b3);
    if (cnt + tot > CB && cnt > 256) {
        LDS_WAIT();
        T = prune256(buf, cnt, wh, lane); cnt = 256;
        keep = scan_hits(cur, T); kc = __popc(keep);
        b0 = __ballot(kc & 1); b1 = __ballot(kc & 2); b2 = __ballot(kc & 4); b3 = __ballot(kc & 8);
        tot = __popcll(b0) + 2 * __popcll(b1) + 4 * __popcll(b2) + 8 * __popcll(b3);
    }
    int pos = cnt + __popcll(b0 & ltm) + 2 * __popcll(b1 & ltm) + 4 * __popcll(b2 & ltm) + 8 * __popcll(b3 & ltm);
    cnt += tot;
    const u64 lo64 = (u64)cur.x | ((u64)cur.y << 32), hi64 = (u64)cur.z | ((u64)cur.w << 32);
    while (keep) {
        const int e = __ffs((int)keep) - 1; keep &= keep - 1u;
        const unsigned code = (unsigned)(((e & 4) ? hi64 : lo64) >> (16 * (e & 3))) & 0xffffu;
        if (pos < CB) buf[pos] = (code << 16) | (unsigned)(kk + e);
        ++pos;
    }
}
__device__ __forceinline__ void scan_codes(const unsigned short* crow, int nkeys, int T, LAS unsigned* buf, int& cnt_io, LAS unsigned* wh, int lane) {
    int cnt = cnt_io;
    const u64 ltm = (lane == 0) ? 0ull : (~0ull >> (64 - lane));
    v4u w0, w1, w2, w3;
#define SC_LOAD(R, kq) do { const int kq_ = (kq) + 8 * lane; R = (kq_ < nkeys) ? *(const v4u*)(crow + kq_) : (v4u){0u, 0u, 0u, 0u}; } while (0)
    SC_LOAD(w0, 0); SC_LOAD(w1, 512); SC_LOAD(w2, 1024); SC_LOAD(w3, 1536);
    for (int k0 = 0; k0 < nkeys; k0 += 2048) {
        { const v4u cur = w0; SC_LOAD(w0, k0 + 2048); scan_block(cur, k0 + 8 * lane, T, buf, cnt, wh, lane, ltm); }
        if (k0 + 512 >= nkeys) break;
        { const v4u cur = w1; SC_LOAD(w1, k0 + 2560); scan_block(cur, k0 + 512 + 8 * lane, T, buf, cnt, wh, lane, ltm); }
        if (k0 + 1024 >= nkeys) break;
        { const v4u cur = w2; SC_LOAD(w2, k0 + 3072); scan_block(cur, k0 + 1024 + 8 * lane, T, buf, cnt, wh, lane, ltm); }
        if (k0 + 1536 >= nkeys) break;
        { const v4u cur = w3; SC_LOAD(w3, k0 + 3584); scan_block(cur, k0 + 1536 + 8 * lane, T, buf, cnt, wh, lane, ltm); }
    }
#undef SC_LOAD
    cnt_io = cnt;
}

__device__ __forceinline__ void sparse_query(int b, int t, const LAS unsigned* idx, unsigned char* wsb, LAS unsigned char* L, int wid, int lane, size_t dst_off) {
    { GAS unsigned char* wg_ = (GAS unsigned char*)wsb; asm volatile("" : "+s"(wg_)); wsb = (unsigned char*)wg_; } bf16* BQ = (bf16*)(wsb + WS_BQ); const bf16* BK = (const bf16*)(wsb + WS_BK); const bf16* BV = (const bf16*)(wsb + WS_BV);
    const int fr = lane & 15, fq = lane >> 4;
    LAS unsigned char* vbuf = L + L_VBUF + wid * 4096;
    const size_t rowb = (size_t)b * T;
    bf16* qrow = BQ + (rowb + t) * 512;
    bf16x8 qf0 = {}, qf1 = {};
    if (fr < 8) { qf0 = *(const bf16x8*)(qrow + fr * 64 + 8 * fq); qf1 = *(const bf16x8*)(qrow + fr * 64 + 32 + 8 * fq); }
    f32x4 S[16];
    {
        v4u kreg[4][4];
#pragma unroll
        for (int c8 = 0; c8 < 4; ++c8)
#pragma unroll
            for (int i = 0; i < 4; ++i) {
                const int row = 8 * i + (lane >> 3), ch = lane & 7;
                unsigned ki = idx[32 * c8 + row] & 0xffffu; if (ki == 0xffffu) ki = 0u;
                kreg[c8][i] = *(const v4u*)(BK + (rowb + ki) * 64 + ch * 8);
            }
#pragma unroll
        for (int c8 = 0; c8 < 8; ++c8) {
#pragma unroll
            for (int i = 0; i < 4; ++i) {
                const int row = 8 * i + (lane >> 3), ch = lane & 7;
                *(LAS v4u*)(vbuf + row * 128 + ((ch ^ (((row >> 1) & 3) << 1)) << 4)) = kreg[c8 & 3][i];
            }
            if (c8 + 4 < 8) {
#pragma unroll
                for (int i = 0; i < 4; ++i) {
                    const int row = 8 * i + (lane >> 3), ch = lane & 7;
                    unsigned ki = idx[32 * (c8 + 4) + row] & 0xffffu; if (ki == 0xffffu) ki = 0u;
                    kreg[c8 & 3][i] = *(const v4u*)(BK + (rowb + ki) * 64 + ch * 8);
                }
            }
            LDS_WAIT();
#pragma unroll
            for (int kbl = 0; kbl < 2; ++kbl) {
                const int row = 16 * kbl + fr, sw = ((row >> 1) & 3) << 1;
                const bf16x8 a0 = *(const LAS bf16x8*)(vbuf + row * 128 + ((fq ^ sw) << 4)), a1 = *(const LAS bf16x8*)(vbuf + row * 128 + (((fq + 4) ^ sw) << 4));
                f32x4 acc = {0.f, 0.f, 0.f, 0.f};
                acc = __builtin_amdgcn_mfma_f32_16x16x32_bf16(a0, qf0, acc, 0, 0, 0);
                acc = __builtin_amdgcn_mfma_f32_16x16x32_bf16(a1, qf1, acc, 0, 0, 0);
                S[2 * c8 + kbl] = acc;
            }
            LDS_WAIT();
        }
    }
    v4u vreg[4][4];
#pragma unroll
    for (int c8 = 0; c8 < 4; ++c8)
#pragma unroll
        for (int i = 0; i < 4; ++i) {
            const int row = 8 * i + (lane >> 3), ch = lane & 7;
            unsigned ki = idx[32 * c8 + row] & 0xffffu; if (ki == 0xffffu) ki = 0u;
            vreg[c8][i] = *(const v4u*)(BV + (rowb + ki) * 64 + ch * 8);
        }
    const float slope2 = __builtin_amdgcn_exp2f(-0.5f * (float)((fr & 7) + 9)) * LOG2E;
    float mx = -__builtin_inff();
#pragma unroll
    for (int kb = 0; kb < 16; ++kb) {
        const v4u i4 = *(const LAS v4u*)(idx + 16 * kb + 4 * fq);
        const unsigned k0 = i4.x & 0xffffu, k1 = i4.y & 0xffffu, k2 = i4.z & 0xffffu, k3 = i4.w & 0xffffu;
        { const float l = (k0 != 0xffffu) ? (S[kb][0] - slope2 * (float)(t - (int)k0)) : -__builtin_inff(); S[kb][0] = l; mx = fmaxf(mx, l); }
        { const float l = (k1 != 0xffffu) ? (S[kb][1] - slope2 * (float)(t - (int)k1)) : -__builtin_inff(); S[kb][1] = l; mx = fmaxf(mx, l); }
        { const float l = (k2 != 0xffffu) ? (S[kb][2] - slope2 * (float)(t - (int)k2)) : -__builtin_inff(); S[kb][2] = l; mx = fmaxf(mx, l); }
        { const float l = (k3 != 0xffffu) ? (S[kb][3] - slope2 * (float)(t - (int)k3)) : -__builtin_inff(); S[kb][3] = l; mx = fmaxf(mx, l); }
    }
    mx = fmaxf(mx, __shfl_xor(mx, 16)); mx = fmaxf(mx, __shfl_xor(mx, 32));
    float sum = 0.f;
#pragma unroll
    for (int kb = 0; kb < 16; ++kb)
#pragma unroll
        for (int r = 0; r < 4; ++r) { const float e = __builtin_amdgcn_exp2f(S[kb][r] - mx); S[kb][r] = e; sum += e; }
    sum += __shfl_xor(sum, 16); sum += __shfl_xor(sum, 32);
    const float inv = 1.0f / sum;
    f32x4 O[4];
#pragma unroll
    for (int db = 0; db < 4; ++db) O[db] = (f32x4){0.f, 0.f, 0.f, 0.f};
#pragma unroll
    for (int c8 = 0; c8 < 8; ++c8) {
#pragma unroll
        for (int i = 0; i < 4; ++i) {
            const int row = 8 * i + (lane >> 3), ch = lane & 7;
            *(LAS v4u*)(vbuf + row * 128 + ((ch ^ (((row >> 1) & 3) << 1)) << 4)) = vreg[c8 & 3][i];
        }
        if (c8 + 4 < 8) {
#pragma unroll
            for (int i = 0; i < 4; ++i) {
                const int row = 8 * i + (lane >> 3), ch = lane & 7;
                unsigned ki = idx[32 * (c8 + 4) + row] & 0xffffu; if (ki == 0xffffu) ki = 0u;
                vreg[c8 & 3][i] = *(const v4u*)(BV + (rowb + ki) * 64 + ch * 8);
            }
        }
        LDS_WAIT();
        v4u pw; pw.x = cvtpk(S[2 * c8][0] * inv, S[2 * c8][1] * inv); pw.y = cvtpk(S[2 * c8][2] * inv, S[2 * c8][3] * inv);
        pw.z = cvtpk(S[2 * c8 + 1][0] * inv, S[2 * c8 + 1][1] * inv); pw.w = cvtpk(S[2 * c8 + 1][2] * inv, S[2 * c8 + 1][3] * inv);
        const bf16x8 pa = __builtin_bit_cast(bf16x8, pw);
        const int row0 = 4 * fq + (fr >> 2), row1 = row0 + 16;
#pragma unroll
        for (int db = 0; db < 4; ++db) {
            const int chunk = 2 * db + ((fr & 3) >> 1), sub = (fr & 1) * 8;
            const s16x4 lo = __builtin_bit_cast(s16x4, __builtin_amdgcn_ds_read_tr16_b64_v4i16((LAS s16x4*)(vbuf + row0 * 128 + ((chunk ^ (((row0 >> 1) & 3) << 1)) << 4) + sub)));
            const s16x4 hi4 = __builtin_bit_cast(s16x4, __builtin_amdgcn_ds_read_tr16_b64_v4i16((LAS s16x4*)(vbuf + row1 * 128 + ((chunk ^ (((row1 >> 1) & 3) << 1)) << 4) + sub)));
            const bf16x8 vb = (bf16x8){lo[0], lo[1], lo[2], lo[3], hi4[0], hi4[1], hi4[2], hi4[3]};
            O[db] = __builtin_amdgcn_mfma_f32_16x16x32_bf16(pa, vb, O[db], 0, 0, 0);
        }
    }
    if (fq < 2) {
#pragma unroll
        for (int db = 0; db < 4; ++db)
#pragma unroll
            for (int r = 0; r < 4; ++r) ((unsigned char*)(wsb + dst_off))[(rowb + t) * 512 + (4 * fq + r) * 64 + 16 * db + fr] = (unsigned char)(pg8::pack4_fp8(O[db][r], 0.f, 0.f, 0.f) & 0xffu);
    }
}

__device__ __forceinline__ void sparse_unit(int b, int j, unsigned short* codes, int cstride, unsigned char* wsb, LAS unsigned char* L, int wid, int lane, int tid) {
    { GAS unsigned char* wg_ = (GAS unsigned char*)wsb; asm volatile("" : "+s"(wg_)); wsb = (unsigned char*)wg_; } const bf16* IQ = (const bf16*)(wsb + WS_IQ); const float* IW = (const float*)(wsb + WS_IW);
    const int t0 = 64 * j, ntiles = (j >> 1) + 1, r32 = lane & 31, hi = lane >> 5;
    const size_t rowb = (size_t)b * T;
    LAS unsigned* hist = (LAS unsigned*)(L + L_HIST);
    LAS unsigned* cbuf = (LAS unsigned*)(L + L_BUF);
    LAS int* qinfo = (LAS int*)(L + L_QINFO);
    bf16x8 af[2][4];
    { const int a = r32 >> 3, hp = (r32 >> 2) & 1, bb = r32 & 3, qi = 2 * (a >> 1) + hp, hd = 4 * (a & 1) + bb;
#pragma unroll
      for (int rb = 0; rb < 2; ++rb) { const bf16* ap = IQ + (rowb + t0 + 8 * wid + 4 * rb + qi) * 512 + hd * 64 + 8 * hi;
#pragma unroll
          for (int ks = 0; ks < 4; ++ks) af[rb][ks] = *(const bf16x8*)(ap + 16 * ks); } }
    float wq[2][2][8];
#pragma unroll
    for (int rb = 0; rb < 2; ++rb)
#pragma unroll
        for (int g2 = 0; g2 < 2; ++g2) { const float* wp = IW + (rowb + t0 + 8 * wid + 4 * rb + 2 * g2 + hi) * 8; const f32x4 w0 = *(const f32x4*)wp, w1 = *(const f32x4*)(wp + 4);
            wq[rb][g2][0] = w0[0]; wq[rb][g2][1] = w0[1]; wq[rb][g2][2] = w0[2]; wq[rb][g2][3] = w0[3]; wq[rb][g2][4] = w1[0]; wq[rb][g2][5] = w1[1]; wq[rb][g2][6] = w1[2]; wq[rb][g2][7] = w1[3]; }
#ifndef REP_P1
#define REP_P1 1
#endif
    for (int rp1_ = 0; rp1_ < REP_P1; ++rp1_) {
#pragma unroll
    for (int i = 0; i < 32; ++i) hist[(8 * wid) * 256 + i * 64 + lane] = 0u;
    __syncthreads();
    idx_pass<1>(b, t0, 0, ntiles, wsb, codes, cstride, L, af, wq, wid, lane, tid);
    }
    for (int i = 0; i < 8; ++i) {
        const int ql = 8 * wid + i, t = t0 + ql; int bin = 0, above = 0, inc = 0;
        if (t + 1 > 256) find_bin<true>(hist + ql * 256, 256, lane, bin, above, inc);
        if (lane == 0) qinfo[128 + ql] = (t + 1 > 256) ? ((bin << 7) - 1) : 0;
    }
    LDS_WAIT();
    __syncthreads();
    VM_WAIT();
    __builtin_amdgcn_fence(__ATOMIC_ACQUIRE, "agent"); VM_WAIT();
#ifndef REP_SCAN
#define REP_SCAN 1
#endif
#ifndef REP_SCPR
#define REP_SCPR 1
#endif
    LAS unsigned* wh = (LAS unsigned*)(L + L_WSCR + wid * 1024);
    for (int rsp_ = 0; rsp_ < REP_SCPR; ++rsp_) {
    for (int rsc_ = 0; rsc_ < REP_SCAN; ++rsc_)
    { const int nstored = ntiles * 128;
      for (int i = 0; i < 8; ++i) {
        const int ql = 8 * wid + i; int c = 0;
        scan_codes(codes + (size_t)ql * cstride, nstored, qinfo[128 + ql], cbuf + ql * CB, c, wh, lane);
        if (lane == 0) qinfo[256 + ql] = c;
      } }
    LDS_WAIT();
    for (int i = 0; i < 8; ++i) {
        const int ql = 8 * wid + i; int n = qinfo[256 + ql]; if (n > CB) n = CB;
        LAS unsigned* qb_ = cbuf + ql * CB;
        if (n > 256) (void)prune256(qb_, n, wh, lane);
        else { for (int p = n + lane; p < 256; p += 64) qb_[p] = 0xffffffffu; LDS_WAIT(); }
    }
    }
    __syncthreads();
#ifndef REP_ATT
#define REP_ATT 1
#endif
    for (int ra_ = 0; ra_ < REP_ATT; ++ra_)
    for (int i = 0; i < 8; ++i) sparse_query(b, t0 + 8 * wid + i, cbuf + (8 * wid + i) * CB, wsb, L, wid, lane, WS_YB8);
    __syncthreads();
}
}

struct Args { const float* in[18]; float* out; unsigned char* ws; int ph_lo, ph_hi, use_bar, pad; };

__global__ void __launch_bounds__(NWAVES * 64, 2) mega(Args args) {
    extern __shared__ __attribute__((aligned(16))) unsigned char lds[];
    LAS unsigned char* L = (LAS unsigned char*)lds;
    volatile LAS unsigned* MISC = (volatile LAS unsigned*)(L + MISC_OFF);
    const int wave = __builtin_amdgcn_readfirstlane((int)threadIdx.x >> 6);
#define LANE_TID int lane; asm volatile("v_mbcnt_lo_u32_b32 %0, -1, 0\n\tv_mbcnt_hi_u32_b32 %0, -1, %0" : "=v"(lane)); const int tid = wave * 64 + lane; (void)tid;
    const int G = gridDim.x; const int bx = blockIdx.x; const int vcu = (G % 8 == 0) ? (bx % 8) * (G / 8) + bx / 8 : bx;
    { LANE_TID for (int u = tid; u < (LDS_BYTES - LDSCTL_OFF) / 4; u += NWAVES * 64) ((LAS unsigned*)(L + LDSCTL_OFF))[u] = 0u; }
    __syncthreads();
    if (args.use_bar) (void)xcd_barrier_post((unsigned*)((gu32*)(args.ws + WS_CTL) + CW_BAR), MISC + 8);
    const int lo = args.ph_lo, hi = args.ph_hi;
#define IN(k) (lo <= (k) && (k) < hi)
#define WSP(off) ((bf16*)(wsl + (off)))
#define WSF(off) ((float*)(wsl + (off)))
#define PHASE_WS GAS unsigned char* wsg_ = (GAS unsigned char*)args.ws; asm volatile("" : "+s"(wsg_)); unsigned char* wsl = (unsigned char*)wsg_;
#define PHASE_PTRS LANE_TID GAS unsigned char* wsg_ = (GAS unsigned char*)args.ws; asm volatile("" : "+s"(wsg_)); unsigned char* wsl = (unsigned char*)wsg_;
#define GRID_BAR(k) do { if (IN(k) && IN((k) + 1)) { XcdBarrier bb_; bb_.bar = (unsigned*)((gu32*)(args.ws + WS_CTL) + CW_BAR); bb_.x = xb_xcc_id(); bb_.st = (volatile LAS unsigned*)(L + MISC_OFF) + 8; xcd_barrier(bb_); } } while (0)
    const int gw = vcu * NWAVES + wave, NGW = G * NWAVES;

#if (PH_MASK >> 0) & 1
    if (IN(0)) {
        PHASE_PTRS
        const float* x = as_global(args.in[0]); const float* pin = as_global(args.in[1]); const float* ln_ffn1 = as_global(args.in[2]); const float* w_ffn1_in = as_global(args.in[3]); const float* w_ffn1_out = as_global(args.in[4]); const float* ln_mix = as_global(args.in[5]); const float* w_in = as_global(args.in[6]);
        const float* w_br_a = as_global(args.in[8]); const float* w_br_b = as_global(args.in[9]); const float* w_out = as_global(args.in[10]); const float* ln_ffn2 = as_global(args.in[11]); const float* w_ffn2_in = as_global(args.in[12]); const float* w_ffn2_out = as_global(args.in[13]); const float* ln_ple = as_global(args.in[14]); const float* w_ple_gate = as_global(args.in[15]); const float* w_ple_proj = as_global(args.in[16]);
        bf16 *W1 = WSP(WS_W1), *W2 = WSP(WS_W2), *WIN = WSP(WS_WIN), *WA = WSP(WS_WA), *WB = WSP(WS_WB), *WO = WSP(WS_WO), *W3 = WSP(WS_W3), *W4 = WSP(WS_W4), *WG = WSP(WS_WG), *WP = WSP(WS_WP), *HB = WSP(WS_HB), *PB = WSP(WS_PB);
        LAS float* scr = (LAS float*)(L + RING_OFF + wave * 16384);
        constexpr int I_W1 = 16 * 176, I_W2 = 44 * 32, I_WIN = 16 * 64, I_WA = 8 * 32, I_WO = 16 * 32, I_WP = 4 * 32;
        constexpr int NITEMS = 2 * I_W1 + 2 * I_W2 + 2 * I_WIN + 2 * I_WA + 2 * I_WO + I_WP;
        const int n_it = (NITEMS - gw + NGW - 1) / NGW, n_x = (M / 2 - gw + NGW - 1) / NGW;
        for (int st = 0; st < (n_it > n_x ? n_it : n_x); ++st) {
            const int m0 = (gw + st * NGW) * 2; const bool has_x = st < n_x;
            f32x4 v[2][4];
            if (has_x) {
#pragma unroll
                for (int r = 0; r < 2; ++r) { const GAS f32x4* xr = (const GAS f32x4*)(x + (size_t)(m0 + r) * D) + lane;
#pragma unroll
                    for (int j = 0; j < 4; ++j) v[r][j] = xr[64 * j]; }
            }
            const int it = gw + st * NGW;
            if (it < NITEMS) {
                int r = it; const float* Wp_ = w_ffn1_in; int Ns = 2 * FF, Kk = D, nblk = 176, mapid = 1, f8 = 0; unsigned char* dst = (unsigned char*)W1; const float* gn = ln_ffn1;
                if (r >= I_W1) { r -= I_W1; Wp_ = w_ffn2_in; dst = (unsigned char*)W3; gn = ln_ffn2; f8 = 1;
                  if (r >= I_W1) { r -= I_W1; Wp_ = w_ffn1_out; Ns = D; Kk = FF; nblk = 32; mapid = 0; f8 = 1; dst = (unsigned char*)W2; gn = nullptr;
                    if (r >= I_W2) { r -= I_W2; Wp_ = w_ffn2_out; dst = (unsigned char*)W4; f8 = 1;
                      if (r >= I_W2) { r -= I_W2; Wp_ = w_in; Ns = DIN; Kk = D; nblk = 64; mapid = 2; f8 = 0; dst = (unsigned char*)WIN; gn = ln_mix;
                        if (r >= I_WIN) { r -= I_WIN; mapid = 3; f8 = 1; dst = (unsigned char*)WIN + 4 * MiB;
                          if (r >= I_WIN) { r -= I_WIN; Wp_ = w_br_a; Ns = D; Kk = 512; nblk = 32; mapid = 0; dst = (unsigned char*)WA; gn = nullptr;
                            if (r >= I_WA) { r -= I_WA; Wp_ = w_br_b; dst = (unsigned char*)WB;
                              if (r >= I_WA) { r -= I_WA; Wp_ = w_out; Kk = D; dst = (unsigned char*)WO;
                                if (r >= I_WO) { r -= I_WO; Wp_ = w_ple_gate; dst = (unsigned char*)WG; gn = ln_ple;
                                  if (r >= I_WO) { r -= I_WO; Wp_ = w_ple_proj; Kk = DPLE; dst = (unsigned char*)WP; gn = nullptr; } } } } } } } } } }
                tr_generic(Wp_, Ns, Kk, dst, gn, mapid, f8, scr, r, nblk, lane);
            }
            if (has_x) {
#pragma unroll
                for (int r = 0; r < 2; ++r) { float s = 0.f;
#pragma unroll
                    for (int j = 0; j < 4; ++j) s += (v[r][j].x * v[r][j].x + v[r][j].y * v[r][j].y) + (v[r][j].z * v[r][j].z + v[r][j].w * v[r][j].w);
                    const float rs = __builtin_amdgcn_rsqf(wave_sum(s) * (1.f / D) + 1e-6f);
                    GAS unsigned long long* o8 = (GAS unsigned long long*)(HB + (size_t)(m0 + r) * D) + lane;
#pragma unroll
                    for (int j = 0; j < 4; ++j) o8[64 * j] = (unsigned long long)pk2(v[r][j].x * rs, v[r][j].y * rs) | ((unsigned long long)pk2(v[r][j].z * rs, v[r][j].w * rs) << 32); }
            }
        }
        { const size_t NV = (size_t)M * DPLE / 4, stride = (size_t)G * 512;
          for (size_t i = (size_t)(bx * 512 + tid); i < NV; i += 4 * stride) {
            f32x4 v[4];
#pragma unroll
            for (int u = 0; u < 4; ++u) { const size_t ii = i + u * stride; v[u] = (ii < NV) ? ((const GAS f32x4*)pin)[ii] : (f32x4){0.f, 0.f, 0.f, 0.f}; }
#pragma unroll
            for (int u = 0; u < 4; ++u) { const size_t ii = i + u * stride; if (ii < NV) ((GAS unsigned*)PB)[ii] = pg8::pack4_fp8(v[u].x, v[u].y, v[u].z, v[u].w); }
          } }
    }
#endif
    GRID_BAR(0);
#if (PH_MASK >> 1) & 1
    if (IN(1)) {
        PHASE_WS bf16 *HB = WSP(WS_HB), *W1 = WSP(WS_W1), *ACT = WSP(WS_ACT);
        pg8::Gemm g{HB, W1, M, 2 * FF, D}; pg8::StaticOrder S; S.init(M, 2 * FF, G, bx);
        pg8::EpiSwiglu<false, false, true> E{ACT, L};
        pg8::gemm_phase<pg8::EpiSwiglu<false, false, true>, pg8::StaticOrder, true, true, false>(L + RING_OFF, g, S, E, wave);
    }
#endif
    GRID_BAR(1);
#if (PH_MASK >> 2) & 1
    if (IN(2)) {
        PHASE_WS bf16 *HB = WSP(WS_HB), *W2 = WSP(WS_W2), *ACT = WSP(WS_ACT); float* RSQ1 = WSF(WS_RSQ1); const float* x = as_global(args.in[0]);
        pg8::Gemm g{ACT, W2, M, D, FF / 2}; pg8::StaticOrder S; S.init(M, D, G, bx);
        pg8::EpiResid<true, true, true, true> E{x, HB, RSQ1, (unsigned char*)(wsl + WS_X8)};
        pg8::gemm_phase<pg8::EpiResid<true, true, true, true>, pg8::StaticOrder, true, true, true>(L + RING_OFF, g, S, E, wave);
    }
#endif
    GRID_BAR(2);
#if (PH_MASK >> 3) & 1
    if (IN(3)) {
        PHASE_WS bf16 *HB = WSP(WS_HB), *WIN = WSP(WS_WIN); float *RSQ1 = WSF(WS_RSQ1); bf16* SG = (bf16*)as_global(args.out);
        { pg8::Gemm g{HB, WIN, M, 2048, D}; pg8::StaticOrder S; S.init(M, 2048, G, bx);
          { LANE_TID pg8::stage_rs(L, S, RSQ1, tid, 1.0f); }
          pg8::EpiProj E{L, wsl, SG};
          pg8::gemm_phase<pg8::EpiProj, pg8::StaticOrder, true, true>(L + RING_OFF, g, S, E, wave); }
        { pg8::Gemm g{WSP(WS_X8), (bf16*)((unsigned char*)WIN + 4 * MiB), M, 2048, D / 2}; pg8::StaticOrder S; S.init(M, 2048, G, bx);
          { LANE_TID pg8::stage_rs(L, S, RSQ1, tid, 1.0f); }
          pg8::EpiSig E{L, SG};
          pg8::gemm_phase<pg8::EpiSig, pg8::StaticOrder, true, true, true>(L + RING_OFF, g, S, E, wave); }
    }
#endif
    GRID_BAR(3);
#if (PH_MASK >> 4) & 1
    if (IN(4)) {
                LANE_TID unsigned char* wsl = as_global(args.ws); const float* a_sink = as_global(args.in[7]);
#ifndef NO_SWA
#ifndef REP_SWA
#define REP_SWA 1
#endif
        for (int rs_ = 0; rs_ < REP_SWA; ++rs_)
        for (int i = 0; i < 2; ++i) { const int su = vcu + 256 * i; if (su < 512) att::swa_unit(su >> 7, (su >> 1) & 63, su & 1, wsl, a_sink, L, wave, lane, tid, (rs_ + 1 < REP_SWA) ? WS_ACT : WS_YA8); }
#endif
#ifndef NO_SP
        if (vcu < 256) { const int sb = vcu >> 6, sj = vcu & 63, mh = sj >> 1;
            const int pre = 64 * sj - (mh * (mh - 1) + ((sj & 1) ? mh : 0)) + sb * 3104, cstride = (64 - mh) * 128;
            unsigned short* codes = (unsigned short*)(wsl + WS_ACT + (size_t)pre * 16384);
            att::sparse_unit(sb, sj, codes, cstride, wsl, L, wave, lane, tid);
            att::sparse_unit(sb, 127 - sj, codes, cstride, wsl, L, wave, lane, tid); }
#endif


    }
#endif
    GRID_BAR(4);
#if (PH_MASK >> 5) & 1
    if (IN(5)) {
        PHASE_WS bf16 *AQ = WSP(WS_AQ), *BQ = WSP(WS_BQ), *WA = WSP(WS_WA), *WB = WSP(WS_WB), *TA = WSP(WS_TA), *MIX = WSP(WS_MIX); bf16* SG = (bf16*)as_global(args.out);
        { pg8::Gemm g{WSP(WS_YA8), WA, M, D, 256}; pg8::StaticOrder S; S.init(M, D, G, bx);
          pg8::EpiGate<1, true, true> E{TA, SG, 0, nullptr};
          pg8::gemm_phase<pg8::EpiGate<1, true, true>, pg8::StaticOrder, true, true, true>(L + RING_OFF, g, S, E, wave); }
        VM_WAIT(); __syncthreads();
        { pg8::Gemm g{WSP(WS_YB8), WB, M, D, 256}; pg8::StaticOrder S; S.init(M, D, G, bx);
          pg8::EpiGate<2, true, true> E{MIX, SG, 1024, TA};
          pg8::gemm_phase<pg8::EpiGate<2, true, true>, pg8::StaticOrder, true, true, true>(L + RING_OFF, g, S, E, wave); }
    }
#endif
    GRID_BAR(5);
#if (PH_MASK >> 6) & 1
    if (IN(6)) {
        PHASE_WS bf16 *HB = WSP(WS_HB), *WO = WSP(WS_WO), *MIX = WSP(WS_MIX); float* RSQ2 = WSF(WS_RSQ2);
        pg8::Gemm g{MIX, WO, M, D, D / 2}; pg8::StaticOrder S; S.init(M, D, G, bx);
        pg8::EpiResid<false, false, true, true> E{nullptr, HB, RSQ2, (unsigned char*)(wsl + WS_X8)};
        pg8::gemm_phase<pg8::EpiResid<false, false, true, true>, pg8::StaticOrder, true, true, true>(L + RING_OFF, g, S, E, wave);
    }
#endif
    GRID_BAR(6);
#if (PH_MASK >> 7) & 1
    if (IN(7)) {
        PHASE_WS bf16 *HB = WSP(WS_HB), *W3 = WSP(WS_W3), *ACT = WSP(WS_ACT); float* RSQ2 = WSF(WS_RSQ2);
        pg8::Gemm g{WSP(WS_X8), W3, M, 2 * FF, D / 2}; pg8::StaticOrder S; S.init(M, 2 * FF, G, bx);
        { LANE_TID pg8::stage_rs(L, S, RSQ2, tid, 1.0f); }
        pg8::EpiSwiglu<true, true> E{ACT, L};
        pg8::gemm_phase<pg8::EpiSwiglu<true, true>, pg8::StaticOrder, true, true, true>(L + RING_OFF, g, S, E, wave);
    }
#endif
    GRID_BAR(7);
#if (PH_MASK >> 8) & 1
    if (IN(8)) {
        PHASE_WS bf16 *HB = WSP(WS_HB), *W4 = WSP(WS_W4), *ACT = WSP(WS_ACT); float* RSQ3 = WSF(WS_RSQ3);
        pg8::Gemm g{ACT, W4, M, D, FF / 2}; pg8::StaticOrder S; S.init(M, D, G, bx);
        pg8::EpiResid<false, true, true, true> E{nullptr, HB, RSQ3, (unsigned char*)(wsl + WS_X8)};
        pg8::gemm_phase<pg8::EpiResid<false, true, true, true>, pg8::StaticOrder, true, true, true>(L + RING_OFF, g, S, E, wave);
    }
#endif
    GRID_BAR(8);
#if (PH_MASK >> 9) & 1
    if (IN(9)) {
        PHASE_WS bf16 *HB = WSP(WS_HB), *PB = WSP(WS_PB), *WP = WSP(WS_WP), *WG = WSP(WS_WG), *PP = WSP(WS_PP); float *RSQ3 = WSF(WS_RSQ3), *RSQ4 = WSF(WS_RSQ4); float* out = as_global(args.out);
        { pg8::Gemm g{PB, WP, M, D, DPLE / 2}; pg8::StaticOrder S; S.init(M, D, G, bx);
          pg8::EpiGate<0, true, true> E{PP, nullptr, 0, nullptr};
          pg8::gemm_phase<pg8::EpiGate<0, true, true>, pg8::StaticOrder, true, true, true>(L + RING_OFF, g, S, E, wave); }
        VM_WAIT(); __syncthreads();
        { pg8::Gemm g{WSP(WS_X8), WG, M, D, D / 2}; pg8::StaticOrder S; S.init(M, D, G, bx);
          { LANE_TID pg8::stage_rs(L, S, RSQ3, tid, 1.0f); }
          pg8::EpiPle<true> E{L, HB, PP, out, RSQ4, (unsigned*)(wsl + WS_CTL) + 32768, as_global(args.in[17])};
          pg8::gemm_phase<pg8::EpiPle<true>, pg8::StaticOrder, true, true, true>(L + RING_OFF, g, S, E, wave); }
    }
#endif
#undef IN
#undef GRID_BAR
}


#ifndef MK_SINGLE
#define MK_SINGLE 1
#endif
extern "C" void kernel_launch(void* const* d_in, const int* in_sizes, int n_in, void* d_out, int out_size, void* d_ws, size_t ws_size, hipStream_t stream) {
    static int grid = 0;
    if (grid == 0) {
        int dev = 0, cus = 0;
        if (ws_size < WS_END || hipGetDevice(&dev) != hipSuccess || hipDeviceGetAttribute(&cus, hipDeviceAttributeMultiprocessorCount, dev) != hipSuccess) { fprintf(stderr, "kernel_launch: setup failed (ws %zu)\n", ws_size); grid = -1; return; }
        if (hipFuncSetAttribute((const void*)mega, hipFuncAttributeMaxDynamicSharedMemorySize, LDS_BYTES) != hipSuccess) { fprintf(stderr, "kernel_launch: hipFuncSetAttribute failed\n"); grid = -1; return; }
        grid = cus;
    }
    if (grid < 0) return;
    (void)hipMemsetAsync((char*)d_ws + WS_CTL, 0, CTL_ZERO_BYTES, stream);
    Args a{};
    for (int i = 0; i < 18; ++i) a.in[i] = (const float*)d_in[i];
    a.out = (float*)d_out; a.ws = (unsigned char*)d_ws;
    if (MK_SINGLE) { a.use_bar = 1; a.ph_lo = 0; a.ph_hi = 10; hipLaunchKernelGGL(mega, dim3(grid), dim3(NWAVES * 64), LDS_BYTES, stream, a); }
    else { a.use_bar = 0;
#ifndef REP_MASK
#define REP_MASK 0
#endif
        for (int ph = 0; ph < 10; ++ph) { const int reps = 1 + ((REP_MASK >> ph) & 1); for (int r = 0; r < reps; ++r) { a.ph_lo = ph; a.ph_hi = ph + 1; hipLaunchKernelGGL(mega, dim3(grid), dim3(NWAVES * 64), LDS_BYTES, stream, a); } } }
}
```

```cpp
#include <hip/hip_runtime.h>
#include <cstdio>
#include <cstdint>

namespace pg8 {
#define PG8_LAS __attribute__((address_space(3)))
typedef unsigned short bf16_t;
typedef short bf16x8 __attribute__((ext_vector_type(8)));
typedef float f32x4 __attribute__((ext_vector_type(4)));
typedef unsigned u32x4 __attribute__((ext_vector_type(4)));
typedef unsigned u32x2 __attribute__((ext_vector_type(2)));
constexpr int BM = 256, BK = 64, HALF = 128, HTB = HALF * BK * 2, STAGE_BYTES = 8 * HTB, NXCD = 8, WGM = 8;

__host__ __device__ __forceinline__ int lds_byte(int r, int c) { const int st = (r >> 4) * 2 + (c >> 5), rr = r & 15, cc = c & 31, ob = rr * 64 + cc * 2; return st * 1024 + (ob ^ (((ob >> 9) & 1) << 5)); }
__host__ __device__ __forceinline__ void stage_rc(int b, int& R, int& C) { const int st = b / 1024, sb = b % 1024, swz = sb ^ (((sb >> 9) & 1) << 5); R = (st >> 1) * 16 + swz / 64; C = (st & 1) * 32 + (swz % 64) / 2; }
__host__ __device__ __forceinline__ int perm32(int rho) { const int n = rho >> 4, i = rho & 15; return 8 * (i >> 2) + 4 * n + (i & 3); }

struct Unit { int pm, pn, ord; };
struct Gemm { const bf16_t* A; const bf16_t* Bt; int M, N, K; };

struct StaticOrder {
    int nM, nN, nwg, G, c;
    __host__ __device__ void init(int M, int N, int G_, int c_) { nM = M / BM; nN = N / BM; nwg = nM * nN; G = G_; c = c_; }
    __host__ __device__ bool next(int i, Unit& u) const {
        const long L = (long)i * G + c; if (L >= nwg) return false;
        int wgid = (int)L; { const int q = nwg / NXCD, r = nwg % NXCD, xcd = wgid % NXCD, off = wgid / NXCD; wgid = (xcd < r ? xcd * (q + 1) : r * (q + 1) + (xcd - r) * q) + off; }
        const int nig = WGM * nN, gid = wgid / nig, fm = gid * WGM, gsz = (nM - fm) < WGM ? (nM - fm) : WGM;
        u.pm = fm + ((wgid % nig) % gsz); u.pn = (wgid % nig) / gsz; return true;
    }
    __device__ __forceinline__ void a_ready(const Unit&) const {}
    __device__ __forceinline__ void done(const Unit&) const {}
};

__device__ __forceinline__ unsigned cvt_pk_bf16(float lo, float hi) { unsigned r; asm volatile("v_cvt_pk_bf16_f32 %0, %1, %2" : "=v"(r) : "v"(lo), "v"(hi)); return r; }
__device__ __forceinline__ float bf_lo(unsigned w) { return __uint_as_float(w << 16); }
__device__ __forceinline__ float bf_hi(unsigned w) { return __uint_as_float(w & 0xffff0000u); }
__device__ __forceinline__ float fsigmoid(float x) { return __builtin_amdgcn_rcpf(1.0f + __builtin_amdgcn_exp2f(-1.4426950408889634f * x)); }
__device__ __forceinline__ float rs_of(const float* rsq, int row) {
    const f32x4* p = (const f32x4*)(rsq + (size_t)row * 16);
    const f32x4 a = p[0], b = p[1], c = p[2], d = p[3];
    const float s = ((a[0] + a[1]) + (a[2] + a[3])) + ((b[0] + b[1]) + (b[2] + b[3])) + ((c[0] + c[1]) + (c[2] + c[3])) + ((d[0] + d[1]) + (d[2] + d[3]));
    return __builtin_amdgcn_rsqf(s * (1.0f / 1024.0f) + 1e-6f);
}
__device__ __forceinline__ void rs8_of(const float* rsq, int row0, int fq, float (&rs)[2][4]) {
    f32x4 p[2][4];
#pragma unroll
    for (int ai = 0; ai < 2; ++ai)
#pragma unroll
        for (int m = 0; m < 4; ++m) p[ai][m] = *(const f32x4*)(rsq + (size_t)(row0 + ai * HALF + m * 16) * 16 + 4 * fq);
#pragma unroll
    for (int ai = 0; ai < 2; ++ai)
#pragma unroll
        for (int m = 0; m < 4; ++m) { float s = (p[ai][m][0] + p[ai][m][1]) + (p[ai][m][2] + p[ai][m][3]); s += __shfl_xor(s, 16); s += __shfl_xor(s, 32); rs[ai][m] = __builtin_amdgcn_rsqf(s * (1.0f / 1024.0f) + 1e-6f); }
}
constexpr int RS_LDS_OFF = 131072, RS_LDS_MAXU = 12;
template <class Sched> __device__ __forceinline__ void stage_rs(PG8_LAS unsigned char* lds0, const Sched& S, const float* rsq, int tid, float mul) {
    PG8_LAS float* tab = (PG8_LAS float*)(lds0 + RS_LDS_OFF);
    Unit u;
    for (int i = 0; i < RS_LDS_MAXU && S.next(i, u); ++i) if (tid < 256) tab[i * 256 + tid] = rs_of(rsq, u.pm * BM + tid) * mul;
    asm volatile("s_waitcnt lgkmcnt(0)" ::: "memory"); __builtin_amdgcn_s_barrier(); asm volatile("" ::: "memory");
}
__device__ __forceinline__ void rs8_lds(PG8_LAS unsigned char* lds0, int ord, int wr, int fr, float (&rs)[2][4]) {
    const PG8_LAS float* tab = (const PG8_LAS float*)(lds0 + RS_LDS_OFF) + ord * 256 + wr * 64 + fr;
#pragma unroll
    for (int ai = 0; ai < 2; ++ai)
#pragma unroll
        for (int m = 0; m < 4; ++m) rs[ai][m] = tab[ai * HALF + m * 16];
}
__device__ __forceinline__ u32x4 pack8(const f32x4 v0, const f32x4 v1) { u32x4 w; w.x = cvt_pk_bf16(v0[0], v0[1]); w.y = cvt_pk_bf16(v0[2], v0[3]); w.z = cvt_pk_bf16(v1[0], v1[1]); w.w = cvt_pk_bf16(v1[2], v1[3]); return w; }
__device__ __forceinline__ void unpack8(const u32x4 w, f32x4& v0, f32x4& v1) { v0 = (f32x4){bf_lo(w.x), bf_hi(w.x), bf_lo(w.y), bf_hi(w.y)}; v1 = (f32x4){bf_lo(w.z), bf_hi(w.z), bf_lo(w.w), bf_hi(w.w)}; }
__device__ __forceinline__ float sq8(const f32x4 a, const f32x4 b) { return ((a[0] * a[0] + a[1] * a[1]) + (a[2] * a[2] + a[3] * a[3])) + ((b[0] * b[0] + b[1] * b[1]) + (b[2] * b[2] + b[3] * b[3])); }

typedef float f32x2_ __attribute__((ext_vector_type(2)));
__device__ __forceinline__ void unpack8_f8(const u32x2 w, f32x4& v0, f32x4& v1) {
    const f32x2_ a = __builtin_amdgcn_cvt_pk_f32_fp8((int)w.x, false), b = __builtin_amdgcn_cvt_pk_f32_fp8((int)w.x, true), c = __builtin_amdgcn_cvt_pk_f32_fp8((int)w.y, false), d = __builtin_amdgcn_cvt_pk_f32_fp8((int)w.y, true);
    v0 = (f32x4){a[0], a[1], b[0], b[1]}; v1 = (f32x4){c[0], c[1], d[0], d[1]};
}
constexpr float F8_WSCALE = 64.0f;
__device__ __forceinline__ unsigned pack4_fp8(float a, float b, float c, float d) { int p = __builtin_amdgcn_cvt_pk_fp8_f32(a, b, 0, false); p = __builtin_amdgcn_cvt_pk_fp8_f32(c, d, p, true); return (unsigned)p; }
template <bool HAS_RS, bool F8, bool F8OUT = F8> struct EpiSwiglu {
    static constexpr bool PERM = true, AFTER_DRAIN = false;
    bf16_t* O; PG8_LAS unsigned char* lds0;
    __device__ __forceinline__ void operator()(const f32x4 (&acc)[2][2][4][2], const Unit& u, int wr, int wc, int fr, int fq) const {
        const int row0 = u.pm * BM + wr * 64 + fr, oc = u.pn * 128 + wc * 32 + 8 * fq;
        float rs8[2][4]; if (HAS_RS) rs8_lds(lds0, u.ord, wr, fr, rs8);
#pragma unroll
        for (int ai = 0; ai < 2; ++ai)
#pragma unroll
            for (int m = 0; m < 4; ++m) {
                const int row = row0 + ai * HALF + m * 16;
                float rs = F8 ? (1.0f / F8_WSCALE) : 1.f; if (HAS_RS) rs *= rs8[ai][m];
                const float rsl = -1.4426950408889634f * rs, rs2 = rs * rs;
                f32x4 o0, o1;
#pragma unroll
                for (int j = 0; j < 4; ++j) {
                    const float A0 = acc[ai][0][m][0][j], A1 = acc[ai][0][m][1][j];
                    const float r0 = __builtin_amdgcn_rcpf(1.0f + __builtin_amdgcn_exp2f(A0 * rsl)), r1 = __builtin_amdgcn_rcpf(1.0f + __builtin_amdgcn_exp2f(A1 * rsl));
                    o0[j] = (A0 * acc[ai][1][m][0][j]) * (r0 * rs2); o1[j] = (A1 * acc[ai][1][m][1][j]) * (r1 * rs2);
                }
                if (F8OUT) { u32x2 w; w.x = pack4_fp8(o0[0], o0[1], o0[2], o0[3]); w.y = pack4_fp8(o1[0], o1[1], o1[2], o1[3]); *(u32x2*)((unsigned char*)O + (size_t)row * 2816 + oc) = w; }
                else *(u32x4*)(O + (size_t)row * 2816 + oc) = pack8(o0, o1);
            }
    }
};
template <bool SRC_F32, bool HALF_ALPHA, bool F8IN, bool F8COPY> struct EpiResid {
    static constexpr bool PERM = true, AFTER_DRAIN = false;
    const float* X; bf16_t* H; float* rsq_out; unsigned char* H8;
    __device__ __forceinline__ void operator()(const f32x4 (&acc)[2][2][4][2], const Unit& u, int wr, int wc, int fr, int fq) const {
        const int row0 = u.pm * BM + wr * 64 + fr, c0 = u.pn * BM + wc * 32 + 8 * fq;
        const float alpha = (HALF_ALPHA ? 0.5f : 1.0f) * (F8IN ? (1.0f / F8_WSCALE) : 1.0f);
#pragma unroll
        for (int ai = 0; ai < 2; ++ai) {
            u32x4 rb[4][2]; f32x4 rf[SRC_F32 ? 4 : 1][2][2];
            if (!SRC_F32) {
#pragma unroll
                for (int m = 0; m < 4; ++m)
#pragma unroll
                    for (int bj = 0; bj < 2; ++bj) rb[m][bj] = *(const u32x4*)(H + (size_t)(row0 + ai * HALF + m * 16) * 1024 + c0 + bj * HALF);
            }
#pragma unroll
            for (int mh = 0; mh < 2; ++mh) {
                if (SRC_F32) {
#pragma unroll
                    for (int m2 = 0; m2 < 2; ++m2)
#pragma unroll
                        for (int bj = 0; bj < 2; ++bj) { const float* xp = X + (size_t)(row0 + ai * HALF + (2 * mh + m2) * 16) * 1024 + c0 + bj * HALF; rf[2 * mh + m2][bj][0] = *(const f32x4*)xp; rf[2 * mh + m2][bj][1] = *(const f32x4*)(xp + 4); }
                }
#pragma unroll
                for (int m2 = 0; m2 < 2; ++m2) {
                    const int m = 2 * mh + m2, row = row0 + ai * HALF + m * 16; float sq = 0.f;
#pragma unroll
                    for (int bj = 0; bj < 2; ++bj) {
                        const size_t off = (size_t)row * 1024 + c0 + bj * HALF; f32x4 r0, r1;
                        if (SRC_F32) { r0 = rf[m][bj][0]; r1 = rf[m][bj][1]; } else unpack8(rb[m][bj], r0, r1);
                        const f32x4 v0 = r0 + alpha * acc[ai][bj][m][0], v1 = r1 + alpha * acc[ai][bj][m][1];
                        sq += sq8(v0, v1);
                        *(u32x4*)(H + off) = pack8(v0, v1);
                        if (F8COPY) { u32x2 w8; w8.x = pack4_fp8(v0[0], v0[1], v0[2], v0[3]); w8.y = pack4_fp8(v1[0], v1[1], v1[2], v1[3]); *(u32x2*)(H8 + off) = w8; }
                    }
                    sq += __shfl_xor(sq, 16); sq += __shfl_xor(sq, 32);
                    if (fq == 0) rsq_out[(size_t)row * 16 + u.pn * 4 + wc] = sq;
                }
                asm volatile("" ::: "memory");
            }
        }
    }
};
constexpr size_t PJ_MiB = 1u << 20, PJ_AQ = 336 * PJ_MiB, PJ_BQ = 368 * PJ_MiB, PJ_IQ = 400 * PJ_MiB, PJ_AK = 432 * PJ_MiB, PJ_AVT = 440 * PJ_MiB, PJ_BK = 448 * PJ_MiB, PJ_BV = 452 * PJ_MiB, PJ_IK = 456 * PJ_MiB, PJ_IW = 9 * PJ_MiB;
struct EpiProj {
    static constexpr bool PERM = true, AFTER_DRAIN = false;
    PG8_LAS unsigned char* lds0; unsigned char* wsb; bf16_t* SG;
    __device__ __forceinline__ void dest(int pn, int cw, bf16_t*& base, int& stride, int& col0, int& kind) const {
        kind = 0; base = SG; stride = 2048; col0 = 0;
        if (pn < 2) { base = (bf16_t*)(wsb + PJ_AQ); stride = 512; col0 = pn * 256 + cw; }
        else if (pn == 2) { if (cw < 128) { base = (bf16_t*)(wsb + PJ_AK); stride = 128; col0 = cw; } else { kind = 2; base = (bf16_t*)(wsb + PJ_AVT); col0 = cw - 128; } }
        else if (pn < 5) { base = (bf16_t*)(wsb + PJ_BQ); stride = 512; col0 = (pn - 3) * 256 + cw; }
        else if (pn == 5) { stride = 64;
            if (cw < 64) { base = (bf16_t*)(wsb + PJ_BK); col0 = cw; } else if (cw < 128) { base = (bf16_t*)(wsb + PJ_BV); col0 = cw - 64; } else if (cw < 192) { base = (bf16_t*)(wsb + PJ_IK); col0 = cw - 128; }
            else if (cw == 192) { kind = 3; base = (bf16_t*)(wsb + PJ_IW); } else kind = 4; }
        else if (pn < 8) { base = (bf16_t*)(wsb + PJ_IQ); stride = 512; col0 = (pn - 6) * 256 + cw; }
        else { kind = 1; col0 = (pn - 8) * 256 + cw; }
    }
    __device__ __forceinline__ void operator()(const f32x4 (&acc)[2][2][4][2], const Unit& u, int wr, int wc, int fr, int fq) const {
        const int row0 = u.pm * BM + wr * 64 + fr;
        bf16_t *base0, *base1; int st0, st1, c00, c01, k0, k1;
        dest(u.pn, wc * 32, base0, st0, c00, k0); dest(u.pn, HALF + wc * 32, base1, st1, c01, k1);
        float rs8[2][4]; rs8_lds(lds0, u.ord, wr, fr, rs8);
#pragma unroll
        for (int ai = 0; ai < 2; ++ai)
#pragma unroll
            for (int m = 0; m < 4; ++m) {
                const int row = row0 + ai * HALF + m * 16; const float rs = rs8[ai][m];
#pragma unroll
                for (int bj = 0; bj < 2; ++bj) {
                    bf16_t* base = bj ? base1 : base0; const int stride = bj ? st1 : st0, col0 = bj ? c01 : c00, kind = bj ? k1 : k0;
                    f32x4 v0 = acc[ai][bj][m][0] * rs, v1 = acc[ai][bj][m][1] * rs;
                    if (kind == 1) {
#pragma unroll
                        for (int j = 0; j < 4; ++j) { v0[j] = fsigmoid(v0[j]); v1[j] = fsigmoid(v1[j]); }
                    }
                    if (kind <= 1) { *(u32x4*)(base + (size_t)row * stride + col0 + 8 * fq) = pack8(v0, v1); }
                    else if (kind == 2) { const int i = col0 + 8 * fq, g = i >> 6, d = i & 63, b = row >> 13, t = row & 8191; bf16_t* p = base + ((size_t)((b * 2 + g) * 64 + d)) * 8192 + t; const u32x4 w = pack8(v0, v1);
                        p[0] = (bf16_t)(w.x & 0xffffu); p[8192] = (bf16_t)(w.x >> 16); p[2 * 8192] = (bf16_t)(w.y & 0xffffu); p[3 * 8192] = (bf16_t)(w.y >> 16);
                        p[4 * 8192] = (bf16_t)(w.z & 0xffffu); p[5 * 8192] = (bf16_t)(w.z >> 16); p[6 * 8192] = (bf16_t)(w.w & 0xffffu); p[7 * 8192] = (bf16_t)(w.w >> 16); }
                    else if (kind == 3) { if (fq == 0) { float* iw = (float*)base + (size_t)row * 8; *(f32x4*)iw = v0; *(f32x4*)(iw + 4) = v1; } }
                }
                asm volatile("" ::: "memory");
            }
    }
};
struct EpiSig {
    static constexpr bool PERM = true, AFTER_DRAIN = false;
    PG8_LAS unsigned char* lds0; bf16_t* SG;
    __device__ __forceinline__ void operator()(const f32x4 (&acc)[2][2][4][2], const Unit& u, int wr, int wc, int fr, int fq) const {
        const int row0 = u.pm * BM + wr * 64 + fr, c0 = u.pn * BM + wc * 32 + 8 * fq;
        float rs8[2][4]; rs8_lds(lds0, u.ord, wr, fr, rs8);
#pragma unroll
        for (int ai = 0; ai < 2; ++ai)
#pragma unroll
            for (int m = 0; m < 4; ++m) {
                const int row = row0 + ai * HALF + m * 16; const float rs = rs8[ai][m] * (1.0f / F8_WSCALE);
#pragma unroll
                for (int bj = 0; bj < 2; ++bj) {
                    f32x4 v0 = acc[ai][bj][m][0] * rs, v1 = acc[ai][bj][m][1] * rs;
#pragma unroll
                    for (int j = 0; j < 4; ++j) { v0[j] = fsigmoid(v0[j]); v1[j] = fsigmoid(v1[j]); }
                    { u32x2 w8; w8.x = pack4_fp8(v0[0], v0[1], v0[2], v0[3]); w8.y = pack4_fp8(v1[0], v1[1], v1[2], v1[3]); *(u32x2*)((unsigned char*)SG + (size_t)row * 2048 + c0 + bj * HALF) = w8; }
                }
            }
    }
};
template <int MODE, bool F8OUT = false, bool F8IN = false> struct EpiGate {
    static constexpr bool PERM = true, AFTER_DRAIN = false;
    bf16_t* O; const bf16_t* G; int gofs; const bf16_t* P;
    __device__ __forceinline__ void operator()(const f32x4 (&acc)[2][2][4][2], const Unit& u, int wr, int wc, int fr, int fq) const {
        const int row0 = u.pm * BM + wr * 64 + fr, c0 = u.pn * BM + wc * 32 + 8 * fq;
#pragma unroll
        for (int ai = 0; ai < 2; ++ai) {
            u32x2 gv[4][2], pv[4][2];
            if (MODE >= 1) {
#pragma unroll
                for (int m = 0; m < 4; ++m)
#pragma unroll
                    for (int bj = 0; bj < 2; ++bj) gv[m][bj] = *(const u32x2*)((const unsigned char*)G + (size_t)(row0 + ai * HALF + m * 16) * 2048 + gofs + c0 + bj * HALF);
            }
            if (MODE == 2) {
#pragma unroll
                for (int m = 0; m < 4; ++m)
#pragma unroll
                    for (int bj = 0; bj < 2; ++bj) pv[m][bj] = *(const u32x2*)((const unsigned char*)P + (size_t)(row0 + ai * HALF + m * 16) * 1024 + c0 + bj * HALF);
            }
#pragma unroll
            for (int m = 0; m < 4; ++m) {
                const int row = row0 + ai * HALF + m * 16;
#pragma unroll
                for (int bj = 0; bj < 2; ++bj) {
                    const int col = c0 + bj * HALF; f32x4 v0 = acc[ai][bj][m][0], v1 = acc[ai][bj][m][1];
                    if (F8IN) { v0 = v0 * (1.0f / F8_WSCALE); v1 = v1 * (1.0f / F8_WSCALE); }
                    if (MODE >= 1) { f32x4 g0, g1; unpack8_f8(gv[m][bj], g0, g1); v0 = v0 * g0; v1 = v1 * g1; }
                    if (MODE == 2) { f32x4 p0, p1; unpack8_f8(pv[m][bj], p0, p1); v0 = v0 + p0; v1 = v1 + p1; }
                    if (F8OUT) { u32x2 w8; w8.x = pack4_fp8(v0[0], v0[1], v0[2], v0[3]); w8.y = pack4_fp8(v1[0], v1[1], v1[2], v1[3]); *(u32x2*)((unsigned char*)O + (size_t)row * 1024 + col) = w8; }
                    else *(u32x4*)(O + (size_t)row * 1024 + col) = pack8(v0, v1);
                }
            }
            asm volatile("" ::: "memory");
        }
    }
};
template <bool F8IN> struct EpiPle {
    static constexpr bool PERM = true, AFTER_DRAIN = false;
    PG8_LAS unsigned char* lds0; const bf16_t* H; const bf16_t* PP; float* out; float* rsq_out; unsigned* cnt; const float* gfin;
    __device__ __forceinline__ void operator()(f32x4 (&acc)[2][2][4][2], const Unit& u, int wr, int wc, int fr, int fq) const {
        const int row0 = u.pm * BM + wr * 64 + fr, c0 = u.pn * BM + wc * 32 + 8 * fq;
        float rs8[2][4]; rs8_lds(lds0, u.ord, wr, fr, rs8);
#pragma unroll
        for (int aim = 0; aim < 4; ++aim) {
            const int ai = aim >> 1;
            u32x4 hv[2][2]; u32x2 qv[2][2];
#pragma unroll
            for (int m2 = 0; m2 < 2; ++m2)
#pragma unroll
                for (int bj = 0; bj < 2; ++bj) { const size_t off = (size_t)(row0 + ai * HALF + (2 * (aim & 1) + m2) * 16) * 1024 + c0 + bj * HALF; hv[m2][bj] = *(const u32x4*)(H + off); qv[m2][bj] = *(const u32x2*)((const unsigned char*)PP + off); }
#pragma unroll
            for (int m2 = 0; m2 < 2; ++m2) {
                const int m = 2 * (aim & 1) + m2;
                const int row = row0 + ai * HALF + m * 16; const float rs = rs8[ai][m] * (F8IN ? (1.0f / F8_WSCALE) : 1.0f); float sq = 0.f;
#pragma unroll
                for (int bj = 0; bj < 2; ++bj) {
                    f32x4 h0, h1, p0, p1; unpack8(hv[m2][bj], h0, h1); unpack8_f8(qv[m2][bj], p0, p1);
                    f32x4 v0 = acc[ai][bj][m][0] * rs, v1 = acc[ai][bj][m][1] * rs;
#pragma unroll
                    for (int j = 0; j < 4; ++j) { v0[j] = h0[j] + fsigmoid(v0[j]) * p0[j]; v1[j] = h1[j] + fsigmoid(v1[j]) * p1[j]; }
                    sq += sq8(v0, v1);
                    acc[ai][bj][m][0] = v0; acc[ai][bj][m][1] = v1;
                }
                sq += __shfl_xor(sq, 16); sq += __shfl_xor(sq, 32);
                if (fq == 0) __hip_atomic_store((unsigned*)(rsq_out + (size_t)row * 16 + u.pn * 4 + wc), __float_as_uint(sq), __ATOMIC_RELAXED, __HIP_MEMORY_SCOPE_AGENT);
            }
            asm volatile("" ::: "memory");
        }
        asm volatile("s_waitcnt vmcnt(0)" ::: "memory");
        unsigned* pc = cnt + 64 * u.pm;
        if ((fr | fq) == 0) __hip_atomic_fetch_add(pc, 1u, __ATOMIC_RELAXED, __HIP_MEMORY_SCOPE_AGENT);
        { unsigned spins = 0;
          while ((unsigned)__builtin_amdgcn_readfirstlane(__hip_atomic_load(pc, __ATOMIC_RELAXED, __HIP_MEMORY_SCOPE_AGENT)) < 32u) { __builtin_amdgcn_s_sleep(2); if (++spins > (1u << 22)) break; } }
        __builtin_amdgcn_fence(__ATOMIC_ACQUIRE, "agent");
        asm volatile("s_waitcnt vmcnt(0)" ::: "memory");
        f32x4 g00 = *(const f32x4*)(gfin + c0), g01 = *(const f32x4*)(gfin + c0 + 4), g10 = *(const f32x4*)(gfin + c0 + HALF), g11 = *(const f32x4*)(gfin + c0 + HALF + 4);
        float rf8[2][4]; rs8_of(rsq_out, row0, fq, rf8);
#pragma unroll
        for (int ai = 0; ai < 2; ++ai)
#pragma unroll
            for (int m = 0; m < 4; ++m) {
                const int row = row0 + ai * HALF + m * 16; const float rs = rf8[ai][m];
                const size_t off = (size_t)row * 1024 + c0;
                *(f32x4*)(out + off) = acc[ai][0][m][0] * rs * g00; *(f32x4*)(out + off + 4) = acc[ai][0][m][1] * rs * g01;
                *(f32x4*)(out + off + HALF) = acc[ai][1][m][0] * rs * g10; *(f32x4*)(out + off + HALF + 4) = acc[ai][1][m][1] * rs * g11;
                asm volatile("" ::: "memory");
            }
    }
};

template <class Epi, class Sched, bool ALIGN_EPI = false, bool SP2 = false, bool F8 = false>
__device__ __forceinline__ void gemm_phase(PG8_LAS unsigned char* lds, const Gemm g, const Sched& S, const Epi& E, int wid_s) {
    int lane_o; asm volatile("v_mbcnt_lo_u32_b32 %0, -1, 0\n\tv_mbcnt_hi_u32_b32 %0, -1, %0" : "=v"(lane_o)); const int tid = wid_s * 64 + lane_o;
    const int wid = __builtin_amdgcn_readfirstlane(tid >> 6), lane = tid & 63, wr = wid >> 2, wc = wid & 3, fr = lane & 15, fq = lane >> 4;
    int f8scale_ = 0x7f7f7f7f; if constexpr (F8) asm volatile("" : "+v"(f8scale_));     (void)f8scale_;
    const int K = g.K, nt = K / BK;
    unsigned voffA[2], voffB[2];
#pragma unroll
    for (int i = 0; i < 2; ++i) { int R, C; stage_rc(tid * 16 + i * 8192, R, C); const int Rb = Epi::PERM ? ((R & ~31) + perm32(R & 31)) : R;
        voffA[i] = (unsigned)(R * K + C) * 2u; voffB[i] = (unsigned)(Rb * K + C) * 2u; }
    const size_t kstep = (size_t)(BK * 2);
    const size_t hstep = (size_t)HALF * K * 2;
    const size_t tstep = 2 * hstep;
    const unsigned ldsw = (unsigned)wid * 1024u;
    const int aoff = lds_byte(wr * 64 + fr, fq * 8), boff = lds_byte(wc * 32 + fr, fq * 8);
#define PG8_SA(b, h) (((b) * 2 + (h)) * HTB)
#define PG8_SB(b, h) ((4 + (b) * 2 + (h)) * HTB)
#define PG8_STAGE(bufoff, gbase, voff) do { _Pragma("unroll") for (int _i = 0; _i < 2; ++_i) \
        __builtin_amdgcn_global_load_lds((const unsigned*)((const char*)(gbase) + (voff)[_i]), (PG8_LAS unsigned*)(lds + (bufoff) + ldsw + _i * 8192), 16, 0, 0); } while (0)
#define PG8_LDA(dst, b, h) do { _Pragma("unroll") for (int m = 0; m < 4; ++m) _Pragma("unroll") for (int k = 0; k < 2; ++k) dst[m][k] = *(const PG8_LAS bf16x8*)(lds + PG8_SA(b, h) + aoff + m * 2048 + k * 1024); } while (0)
#define PG8_LDB(dst, b, h) do { _Pragma("unroll") for (int n = 0; n < 2; ++n) _Pragma("unroll") for (int k = 0; k < 2; ++k) dst[n][k] = *(const PG8_LAS bf16x8*)(lds + PG8_SB(b, h) + boff + n * 2048 + k * 1024); } while (0)
#define PG8_MMA(ai, bj, At, Bt) do { __builtin_amdgcn_s_setprio(1); \
        if constexpr (F8) { typedef int v8i_ __attribute__((ext_vector_type(8))); typedef int v4i_ __attribute__((ext_vector_type(4))); \
            _Pragma("unroll") for (int m = 0; m < 4; ++m) _Pragma("unroll") for (int n = 0; n < 2; ++n) { \
                const v4i_ b0_ = __builtin_bit_cast(v4i_, Bt[n][0]), b1_ = __builtin_bit_cast(v4i_, Bt[n][1]), a0_ = __builtin_bit_cast(v4i_, At[m][0]), a1_ = __builtin_bit_cast(v4i_, At[m][1]); \
                const v8i_ bb_ = {b0_[0], b0_[1], b0_[2], b0_[3], b1_[0], b1_[1], b1_[2], b1_[3]}, aa_ = {a0_[0], a0_[1], a0_[2], a0_[3], a1_[0], a1_[1], a1_[2], a1_[3]}; \
                asm volatile("v_mfma_scale_f32_16x16x128_f8f6f4 %0, %1, %2, %0, %3, %3 op_sel_hi:[0,0,0]" : "+v"(acc[ai][bj][m][n]) : "v"(bb_), "v"(aa_), "v"(f8scale_)); } } \
        else { _Pragma("unroll") for (int m = 0; m < 4; ++m) _Pragma("unroll") for (int n = 0; n < 2; ++n) _Pragma("unroll") for (int k = 0; k < 2; ++k) \
            acc[ai][bj][m][n] = __builtin_amdgcn_mfma_f32_16x16x32_bf16(Bt[n][k], At[m][k], acc[ai][bj][m][n], 0, 0, 0); } \
        __builtin_amdgcn_s_setprio(0); } while (0)
#define PG8_WAIT_V(n) asm volatile("s_waitcnt vmcnt(" #n ")" ::: "memory")
#define PG8_WAIT_L(n) asm volatile("s_waitcnt lgkmcnt(" #n ")" ::: "memory")
#define PG8_BAR __builtin_amdgcn_s_barrier()
#define PG8_SCHED __builtin_amdgcn_sched_barrier(0)
    Unit cur, nxt; int ui = 0;
    if (!S.next(0, cur)) return;
    cur.ord = 0;
    f32x4 acc[2][2][4][2];
#pragma unroll
    for (int a = 0; a < 2; ++a)
#pragma unroll
        for (int b = 0; b < 2; ++b)
#pragma unroll
            for (int m = 0; m < 4; ++m)
#pragma unroll
                for (int n = 0; n < 2; ++n) acc[a][b][m][n] = (f32x4){0.f, 0.f, 0.f, 0.f};
    bf16x8 At[4][2], B0[2][2], B1[2][2];
    const char* cA = (const char*)g.A + (size_t)cur.pm * tstep; const char* cB = (const char*)g.Bt + (size_t)cur.pn * tstep;
    S.a_ready(cur);
    if constexpr (SP2) {
        PG8_STAGE(PG8_SB(0, 0), cB, voffB); PG8_STAGE(PG8_SB(0, 1), cB + hstep, voffB); PG8_STAGE(PG8_SA(0, 0), cA, voffA); PG8_STAGE(PG8_SA(0, 1), cA + hstep, voffA);
        if (wr == 1) PG8_BAR;
        PG8_WAIT_V(2); PG8_BAR;
        PG8_STAGE(PG8_SB(1, 0), cB + kstep, voffB); PG8_STAGE(PG8_SA(1, 0), cA + kstep, voffA); PG8_STAGE(PG8_SB(1, 1), cB + hstep + kstep, voffB);
        PG8_WAIT_V(6); PG8_BAR;
    } else {
        PG8_STAGE(PG8_SB(0, 0), cB, voffB); PG8_STAGE(PG8_SA(0, 0), cA, voffA); PG8_STAGE(PG8_SB(0, 1), cB + hstep, voffB); PG8_STAGE(PG8_SA(0, 1), cA + hstep, voffA);
        if (wr == 1) PG8_BAR;
        PG8_WAIT_V(4); PG8_BAR;
        PG8_STAGE(PG8_SB(1, 0), cB + kstep, voffB); PG8_STAGE(PG8_SA(1, 0), cA + kstep, voffA); PG8_STAGE(PG8_SB(1, 1), cB + hstep + kstep, voffB);
        PG8_WAIT_V(6); PG8_BAR;
    }
    for (;;) {
        const bool has_next = S.next(ui + 1, nxt); nxt.ord = ui + 1;
        const char* nA = has_next ? (const char*)g.A + (size_t)nxt.pm * tstep : cA; const char* nB = has_next ? (const char*)g.Bt + (size_t)nxt.pn * tstep : cB;
        for (int t = 0; t < nt; t += 2) {
            const bool last = (t == nt - 2);
            const char* a1 = cA + (size_t)(t + 1) * kstep;
            const char* a2 = last ? nA : cA + (size_t)(t + 2) * kstep; const char* b2 = last ? nB : cB + (size_t)(t + 2) * kstep;
            const char* a3 = a2 + kstep; const char* b3 = b2 + kstep;
            if (last && has_next) S.a_ready(nxt);
            if constexpr (SP2) {
            PG8_LDB(B0, 0, 0); PG8_LDB(B1, 0, 1); PG8_SCHED; PG8_LDA(At, 0, 0); PG8_STAGE(PG8_SA(1, 1), a1 + hstep, voffA);
            PG8_WAIT_V(8); PG8_WAIT_L(0); PG8_BAR; PG8_MMA(0, 0, At, B0); PG8_MMA(0, 1, At, B1); PG8_BAR; PG8_SCHED;
            PG8_LDA(At, 0, 1); PG8_STAGE(PG8_SB(0, 0), b2, voffB); PG8_STAGE(PG8_SB(0, 1), b2 + hstep, voffB); PG8_STAGE(PG8_SA(0, 0), a2, voffA);
            PG8_WAIT_V(8); PG8_WAIT_L(0); PG8_BAR; PG8_MMA(1, 0, At, B0); PG8_MMA(1, 1, At, B1); PG8_BAR; PG8_SCHED;
            PG8_LDB(B0, 1, 0); PG8_LDB(B1, 1, 1); PG8_SCHED; PG8_LDA(At, 1, 0); PG8_STAGE(PG8_SA(0, 1), a2 + hstep, voffA);
            PG8_WAIT_V(8); PG8_WAIT_L(0); PG8_BAR; PG8_MMA(0, 0, At, B0); PG8_MMA(0, 1, At, B1); PG8_BAR; PG8_SCHED;
            PG8_LDA(At, 1, 1); PG8_STAGE(PG8_SB(1, 0), b3, voffB); PG8_STAGE(PG8_SB(1, 1), b3 + hstep, voffB); PG8_STAGE(PG8_SA(1, 0), a3, voffA);
            PG8_WAIT_V(8); PG8_WAIT_L(0); PG8_BAR; PG8_MMA(1, 0, At, B0); PG8_MMA(1, 1, At, B1); PG8_BAR; PG8_SCHED;
            } else {
            PG8_LDB(B0, 0, 0); PG8_SCHED; PG8_LDA(At, 0, 0); PG8_STAGE(PG8_SA(1, 1), a1 + hstep, voffA);
            PG8_WAIT_L(8); PG8_BAR; PG8_WAIT_L(0); PG8_MMA(0, 0, At, B0); PG8_BAR; PG8_SCHED;
            PG8_LDB(B1, 0, 1); PG8_STAGE(PG8_SB(0, 0), b2, voffB);
            PG8_BAR; PG8_WAIT_L(0); PG8_MMA(0, 1, At, B1); PG8_BAR;
            PG8_LDA(At, 0, 1); PG8_STAGE(PG8_SA(0, 0), a2, voffA);
            PG8_BAR; PG8_WAIT_L(0); PG8_MMA(1, 0, At, B0); PG8_BAR; PG8_SCHED;
            PG8_STAGE(PG8_SB(0, 1), b2 + hstep, voffB);
            PG8_WAIT_V(6); PG8_BAR; PG8_MMA(1, 1, At, B1); PG8_BAR;
            PG8_LDB(B0, 1, 0); PG8_SCHED; PG8_LDA(At, 1, 0); PG8_STAGE(PG8_SA(0, 1), a2 + hstep, voffA);
            PG8_WAIT_L(8); PG8_BAR; PG8_WAIT_L(0); PG8_MMA(0, 0, At, B0); PG8_BAR; PG8_SCHED;
            PG8_LDB(B1, 1, 1); PG8_STAGE(PG8_SB(1, 0), b3, voffB);
            PG8_BAR; PG8_WAIT_L(0); PG8_MMA(0, 1, At, B1); PG8_BAR;
            PG8_LDA(At, 1, 1); PG8_STAGE(PG8_SA(1, 0), a3, voffA);
            PG8_BAR; PG8_WAIT_L(0); PG8_MMA(1, 0, At, B0); PG8_BAR; PG8_SCHED;
            PG8_STAGE(PG8_SB(1, 1), b3 + hstep, voffB);
            PG8_WAIT_V(6); PG8_BAR; PG8_MMA(1, 1, At, B1); PG8_BAR;
            }
        }
        if constexpr (F8) asm volatile("s_nop 15\n\ts_nop 15" ::: "memory");
        if constexpr (ALIGN_EPI) { if (wr == 0) PG8_BAR; }
        if constexpr (!Epi::AFTER_DRAIN) { E(acc, cur, wr, wc, fr, fq); S.done(cur); }
        if (!has_next) break;
#pragma unroll
        for (int a = 0; a < 2; ++a)
#pragma unroll
            for (int b = 0; b < 2; ++b)
#pragma unroll
                for (int m = 0; m < 4; ++m)
#pragma unroll
                    for (int n = 0; n < 2; ++n) acc[a][b][m][n] = (f32x4){0.f, 0.f, 0.f, 0.f};
        cur = nxt; cA = nA; cB = nB; ++ui;
        if constexpr (ALIGN_EPI) { if (wr == 1) PG8_BAR; }
    }
    PG8_WAIT_V(0);
    if constexpr (!ALIGN_EPI) { if (wr == 0) PG8_BAR; }
    PG8_BAR;
    if constexpr (Epi::AFTER_DRAIN) { E.fused(acc, cur, wr, wc, fr, fq, lds, wid, lane); S.done(cur); }
#undef PG8_SA
#undef PG8_SB
#undef PG8_STAGE
#undef PG8_LDA
#undef PG8_LDB
#undef PG8_MMA
#undef PG8_WAIT_V
#undef PG8_WAIT_L
#undef PG8_BAR
#undef PG8_SCHED
}
}

#define GAS __attribute__((address_space(1)))
#define LAS __attribute__((address_space(3)))
typedef unsigned short bf16;
typedef unsigned v4u __attribute__((ext_vector_type(4)));
typedef float f32x4 __attribute__((ext_vector_type(4)));
typedef short bf16x8 __attribute__((ext_vector_type(8)));
typedef GAS unsigned gu32;
typedef GAS unsigned long long gu64;
#define RLX_AGENT __ATOMIC_RELAXED, __HIP_MEMORY_SCOPE_AGENT

#define XB_TMO      128
#define XB_XCNT(j)  (256  + 64 * (j))
#define XB_XSUB(j)  (1280 + 64 * (j))
#define XB_XGEN(j)  (2304 + 64 * (j))
#define XB_TOP      3328
#define XB_TOPGEN   3392
#define XCD_BAR_WORDS 3456
#define XB_SPIN_CAP (1u << 18)

__device__ __forceinline__ unsigned xb_ld(unsigned* p)              { return __hip_atomic_load(p, __ATOMIC_RELAXED, __HIP_MEMORY_SCOPE_AGENT); }
__device__ __forceinline__ unsigned xb_add(unsigned* p, unsigned v) { return __hip_atomic_fetch_add(p, v, __ATOMIC_RELAXED, __HIP_MEMORY_SCOPE_AGENT); }
__device__ __forceinline__ unsigned xb_xcc_id() { return (unsigned)__builtin_amdgcn_s_getreg((3 << 11) | 20) & 0xFu; }
#define XB_SPIN(cond, bar) do { unsigned _sp = 0; while (cond) { __builtin_amdgcn_s_sleep(1); \
    if ((++_sp & 255u) == 0u) { if (xb_ld(&(bar)[XB_TMO])) break; if (_sp > XB_SPIN_CAP) { atomicAdd(&(bar)[XB_TMO], 1u); break; } } } } while (0)

struct XcdBarrier {
    unsigned* bar; unsigned x;
    volatile LAS unsigned* st;
};

__device__ __forceinline__ XcdBarrier xcd_barrier_post(unsigned* bar, volatile LAS unsigned* st) {
    XcdBarrier b; b.bar = bar; b.x = xb_xcc_id(); b.st = st;
    if (threadIdx.x == 0) (void)xb_add(&bar[XB_XCNT(b.x)], 1u);
    return b;
}
__device__ __forceinline__ void xcd_barrier_complete(unsigned* bar, unsigned x, unsigned& nloc, unsigned& nx) {
    const unsigned G = gridDim.x * gridDim.y * gridDim.z;
    unsigned sum, cnt, mine, sp = 0u;
    for (;;) {
        sum = 0u; cnt = 0u; mine = 0u;
#pragma unroll
        for (unsigned j = 0; j < 16; ++j) { const unsigned c = xb_ld(&bar[XB_XCNT(j)]); sum += c; cnt += (c > 0u) ? 1u : 0u; mine = (j == x) ? c : mine; }
        if (sum == G) break;
        __builtin_amdgcn_s_sleep(1);
        if ((++sp & 255u) == 0u) { if (xb_ld(&bar[XB_TMO])) break; if (sp > XB_SPIN_CAP) { atomicAdd(&bar[XB_TMO], 1u); break; } }
    }
    nloc = mine > 0u ? mine : 1u; nx = cnt > 0u ? cnt : 1u;
}

__device__ __forceinline__ void xcd_barrier(const XcdBarrier& b) {
    asm volatile("s_waitcnt vmcnt(0)" ::: "memory");
    __syncthreads();
    if (threadIdx.x == 0) {
        unsigned* bar = b.bar;
        __builtin_amdgcn_s_waitcnt(0);
        unsigned nloc = b.st[0], nx = b.st[1];
        if (nloc == 0u) { xcd_barrier_complete(bar, b.x, nloc, nx); b.st[0] = nloc; b.st[1] = nx; }
        const unsigned old = xb_add(&bar[XB_XSUB(b.x)], 1u);
        const unsigned gen = old / nloc;
        if (old + 1u == (gen + 1u) * nloc) {
            __builtin_amdgcn_fence(__ATOMIC_RELEASE, "agent");
            asm volatile("s_waitcnt vmcnt(0)" ::: "memory");
            const unsigned og = xb_add(&bar[XB_TOP], 1u);
            const unsigned tg = og / nx;
            if (og + 1u == (tg + 1u) * nx) xb_add(&bar[XB_TOPGEN], 1u);
            else XB_SPIN(xb_ld(&bar[XB_TOPGEN]) == tg, bar);
            __builtin_amdgcn_fence(__ATOMIC_ACQUIRE, "agent");
            xb_add(&bar[XB_XGEN(b.x)], 1u);
            asm volatile("s_waitcnt vmcnt(0)" ::: "memory");
        } else {
            XB_SPIN(xb_ld(&bar[XB_XGEN(b.x)]) == gen, bar);
            __builtin_amdgcn_fence(__ATOMIC_ACQUIRE, "agent");
            asm volatile("s_waitcnt vmcnt(0)" ::: "memory");
        }
    }
    __syncthreads();
}

constexpr int BATCH = 4, T = 8192, D = 1024, M = BATCH * T, FF = 2816, DPLE = 256, DIN = 4040;
constexpr int NWAVES = 8;
constexpr size_t MiB = 1u << 20;
constexpr size_t WS_CTL = 0, CTL_ZERO_BYTES = 1 * MiB;
constexpr size_t WS_RSQ1 = 1 * MiB, WS_RSQ2 = 3 * MiB, WS_RSQ3 = 5 * MiB, WS_RSQ4 = 7 * MiB, WS_IW = 9 * MiB;
constexpr size_t WS_W1 = 10 * MiB, WS_W2 = 21 * MiB, WS_WIN = 27 * MiB, WS_WA = 35 * MiB, WS_WB = 36 * MiB, WS_WO = 37 * MiB, WS_W3 = 39 * MiB, WS_W4 = 50 * MiB, WS_WG = 56 * MiB, WS_WP = 58 * MiB;
constexpr size_t WS_HB = 64 * MiB, WS_ACT = 128 * MiB, WS_TA = WS_ACT, WS_MIX = WS_ACT + 64 * MiB, WS_PP = WS_ACT;
constexpr size_t WS_X8 = 304 * MiB, WS_SEL = WS_X8, WS_AQ = 336 * MiB, WS_BQ = 368 * MiB, WS_IQ = 400 * MiB, WS_AK = 432 * MiB, WS_AVT = 440 * MiB, WS_BK = 448 * MiB, WS_BV = 452 * MiB, WS_IK = 456 * MiB, WS_PB = 460 * MiB, WS_YA8 = 476 * MiB, WS_YB8 = 492 * MiB, WS_END = 508 * MiB;
constexpr int CW_BAR = 4096;
static_assert(pg8::PJ_AQ == WS_AQ && pg8::PJ_BQ == WS_BQ && pg8::PJ_IQ == WS_IQ && pg8::PJ_AK == WS_AK && pg8::PJ_AVT == WS_AVT && pg8::PJ_BK == WS_BK && pg8::PJ_BV == WS_BV && pg8::PJ_IK == WS_IK && pg8::PJ_IW == WS_IW, "EpiProj offsets");
constexpr int RING_OFF = 0, RING_BYTES = 131072;
constexpr int LDSCTL_OFF = 159744, MISC_OFF = LDSCTL_OFF + 320;
constexpr int LDS_BYTES = 160256;

#define LDS_WAIT() asm volatile("s_waitcnt lgkmcnt(0)" ::: "memory")
#define VM_WAIT() asm volatile("s_waitcnt vmcnt(0)" ::: "memory")
__device__ __forceinline__ unsigned f2bf(float f) { unsigned u = __builtin_bit_cast(unsigned, f); return (u + 0x7fffu + ((u >> 16) & 1u)) >> 16; }
__device__ __forceinline__ unsigned pk2(float lo, float hi) { return f2bf(lo) | (f2bf(hi) << 16); }
__device__ __forceinline__ float wave_sum(float v) {
#pragma unroll
    for (int o = 1; o < 64; o <<= 1) v += __shfl_xor(v, o);
    return v;
}

struct MapId { __device__ __forceinline__ void operator()(int n, int& sc, float& cs) const { sc = n; cs = 1.f; } };
struct MapFfnIn { __device__ __forceinline__ void operator()(int n, int& sc, float& cs) const { const int pn = n >> 8, bj = (n >> 7) & 1, i = n & 127; sc = bj * FF + 128 * pn + i; cs = 1.f; } };
struct MapWin { __device__ __forceinline__ void operator()(int n, int& sc, float& cs) const {
    const float CQ = 0.125f * 1.4426950408889634f; cs = 1.f;
    if (n < 1280) { sc = n; if (n < 512 || n >= 768) cs = CQ; }
    else if (n < 1536) { const int i = n - 1280; if (i < 128) sc = 1280 + i; else if (i < 192) sc = 1920 + (i - 128); else if (i < 200) { sc = 1984 + (i - 192); cs = 0.35355339059327373f; } else sc = -1; }
    else if (n < 2048) { sc = 1408 + (n - 1536); cs = 0.125f; }
    else if (n < 3072) sc = 1992 + (n - 2048);
    else sc = 3016 + (n - 3072);
} };
struct MapGate { __device__ __forceinline__ void operator()(int n, int& sc, float& cs) const { sc = 1992 + n; cs = 1.f; } };
template <class MAP>
__device__ __forceinline__ void tr_item(const float* W, int Nsrc, int K, bf16* WT, const float* gain, LAS float* scr, int item, int nblk, int lane, MAP map) {
    const int kb = item / nblk, nb = item % nblk, k0 = 64 * kb, n0 = 32 * nb;
    int sc; float cs; map(n0 + (lane & 7) * 4, sc, cs);
    {
        f32x4 ld[8];
#pragma unroll
        for (int i = 0; i < 8; ++i) { const int kk = 8 * i + (lane >> 3); ld[i] = (f32x4){0.f, 0.f, 0.f, 0.f}; if (sc >= 0) ld[i] = *(const GAS f32x4*)(W + (size_t)(k0 + kk) * Nsrc + sc); }
#pragma unroll
        for (int i = 0; i < 8; ++i) { const int kk = 8 * i + (lane >> 3); float gk = cs; if (gain) gk *= gain[k0 + kk]; LAS float* d = scr + kk * 33 + (lane & 7) * 4; d[0] = ld[i][0] * gk; d[1] = ld[i][1] * gk; d[2] = ld[i][2] * gk; d[3] = ld[i][3] * gk; }
    }
    LDS_WAIT(); asm volatile("" ::: "memory");
    const int c = lane & 7;
#pragma unroll
    for (int j = 0; j < 4; ++j) { const int n = (lane >> 3) + 8 * j; const LAS float* s = scr + (8 * c) * 33 + n;
        v4u o; o.x = pk2(s[0 * 33], s[1 * 33]); o.y = pk2(s[2 * 33], s[3 * 33]); o.z = pk2(s[4 * 33], s[5 * 33]); o.w = pk2(s[6 * 33], s[7 * 33]);
        *(GAS v4u*)(WT + (size_t)(n0 + n) * K + k0 + 8 * c) = o; }
    LDS_WAIT(); asm volatile("" ::: "memory");
}

template <class MAP>
__device__ __forceinline__ void tr_item8(const float* W, int Nsrc, int K, unsigned char* WT, const float* gain, LAS float* scr, int item, int nblk, int lane, MAP map, float scale) {
    const int kb = item / nblk, nb = item % nblk, k0 = 64 * kb, n0 = 32 * nb;
    int sc; float cs; map(n0 + (lane & 7) * 4, sc, cs); cs *= scale;
    {
        f32x4 ld[8];
#pragma unroll
        for (int i = 0; i < 8; ++i) { const int kk = 8 * i + (lane >> 3); ld[i] = (f32x4){0.f, 0.f, 0.f, 0.f}; if (sc >= 0) ld[i] = *(const GAS f32x4*)(W + (size_t)(k0 + kk) * Nsrc + sc); }
#pragma unroll
        for (int i = 0; i < 8; ++i) { const int kk = 8 * i + (lane >> 3); float gk = cs; if (gain) gk *= gain[k0 + kk]; LAS float* d = scr + kk * 33 + (lane & 7) * 4; d[0] = ld[i][0] * gk; d[1] = ld[i][1] * gk; d[2] = ld[i][2] * gk; d[3] = ld[i][3] * gk; }
    }
    LDS_WAIT(); asm volatile("" ::: "memory");
    const int c = lane & 3;
#pragma unroll
    for (int j = 0; j < 2; ++j) { const int n = (lane >> 2) + 16 * j; const LAS float* s = scr + (16 * c) * 33 + n;
        v4u o; o.x = pg8::pack4_fp8(s[0 * 33], s[1 * 33], s[2 * 33], s[3 * 33]); o.y = pg8::pack4_fp8(s[4 * 33], s[5 * 33], s[6 * 33], s[7 * 33]);
        o.z = pg8::pack4_fp8(s[8 * 33], s[9 * 33], s[10 * 33], s[11 * 33]); o.w = pg8::pack4_fp8(s[12 * 33], s[13 * 33], s[14 * 33], s[15 * 33]);
        *(GAS v4u*)(WT + (size_t)(n0 + n) * K + k0 + 16 * c) = o; }
    LDS_WAIT(); asm volatile("" ::: "memory");
}

__device__ __forceinline__ void tr_generic(const float* W, int Nsrc, int K, unsigned char* dst, const float* gain, int mapid, int f8, LAS float* scr, int item, int nblk, int lane) {
    const int kb = item / nblk, nb = item % nblk, k0 = 64 * kb, n0 = 32 * nb;
    int sc; float cs; { const int n = n0 + (lane & 7) * 4;
        if (mapid == 0) MapId()(n, sc, cs); else if (mapid == 1) MapFfnIn()(n, sc, cs); else if (mapid == 2) MapWin()(n, sc, cs); else MapGate()(n, sc, cs); }
    if (f8) cs *= pg8::F8_WSCALE;
    {
        f32x4 ld[8];
#pragma unroll
        for (int i = 0; i < 8; ++i) { const int kk = 8 * i + (lane >> 3); ld[i] = (f32x4){0.f, 0.f, 0.f, 0.f}; if (sc >= 0) ld[i] = *(const GAS f32x4*)(W + (size_t)(k0 + kk) * Nsrc + sc); }
#pragma unroll
        for (int i = 0; i < 8; ++i) { const int kk = 8 * i + (lane >> 3); float gk = cs; if (gain) gk *= gain[k0 + kk]; LAS float* d = scr + kk * 33 + (lane & 7) * 4; d[0] = ld[i][0] * gk; d[1] = ld[i][1] * gk; d[2] = ld[i][2] * gk; d[3] = ld[i][3] * gk; }
    }
    LDS_WAIT(); asm volatile("" ::: "memory");
    if (f8) {
        const int c = lane & 3;
#pragma unroll
        for (int j = 0; j < 2; ++j) { const int n = (lane >> 2) + 16 * j; const LAS float* s = scr + (16 * c) * 33 + n;
            v4u o; o.x = pg8::pack4_fp8(s[0 * 33], s[1 * 33], s[2 * 33], s[3 * 33]); o.y = pg8::pack4_fp8(s[4 * 33], s[5 * 33], s[6 * 33], s[7 * 33]);
            o.z = pg8::pack4_fp8(s[8 * 33], s[9 * 33], s[10 * 33], s[11 * 33]); o.w = pg8::pack4_fp8(s[12 * 33], s[13 * 33], s[14 * 33], s[15 * 33]);
            *(GAS v4u*)(dst + (size_t)(n0 + n) * K + k0 + 16 * c) = o; }
    } else {
        const int c = lane & 7;
#pragma unroll
        for (int j = 0; j < 4; ++j) { const int n = (lane >> 3) + 8 * j; const LAS float* s = scr + (8 * c) * 33 + n;
            v4u o; o.x = pk2(s[0 * 33], s[1 * 33]); o.y = pk2(s[2 * 33], s[3 * 33]); o.z = pk2(s[4 * 33], s[5 * 33]); o.w = pk2(s[6 * 33], s[7 * 33]);
            *(GAS v4u*)(dst + ((size_t)(n0 + n) * K + k0 + 8 * c) * 2) = o; }
    }
    LDS_WAIT(); asm volatile("" ::: "memory");
}

#ifndef PH_MASK
#define PH_MASK 0x7ff
#endif
template <class T_> __device__ __forceinline__ T_* as_global(T_* p) { return (T_*)(GAS T_*)p; }


namespace att {
typedef float f32x16 __attribute__((ext_vector_type(16)));
typedef short s16x4 __attribute__((ext_vector_type(4)));
typedef unsigned long long u64;
constexpr float LOG2E = 1.4426950408889634f;
__device__ __forceinline__ int crow(int r, int hi) { return (r & 3) + 8 * (r >> 2) + 4 * hi; }
__device__ __forceinline__ unsigned cvtpk(float lo, float hi) { unsigned r; asm volatile("v_cvt_pk_bf16_f32 %0, %1, %2" : "=v"(r) : "v"(lo), "v"(hi)); return r; }

constexpr int SWA_K = 0, SWA_V = 32768, SWA_VROW = 520;
__device__ __forceinline__ void swa_unit(int b, int n, int g, unsigned char* wsb, const float* sink, LAS unsigned char* L, int wid, int lane, int tid, size_t dst_off) {
    { GAS unsigned char* wg_ = (GAS unsigned char*)wsb; asm volatile("" : "+s"(wg_)); wsb = (unsigned char*)wg_; } const bf16* AQ = (const bf16*)(wsb + WS_AQ); const bf16* AK = (const bf16*)(wsb + WS_AK); const bf16* AVT = (const bf16*)(wsb + WS_AVT);
    const int hh = wid >> 1, qh = wid & 1, head = 4 * g + hh, r32 = lane & 31, hi = lane >> 5;
    const float slope2 = __builtin_amdgcn_exp2f(-0.5f * (float)(head + 1)) * LOG2E, sink2 = sink[head] * LOG2E;
    const size_t rowb = (size_t)b * T;
    const int kt0 = 128 * n - 128;
#pragma unroll
    for (int i = 0; i < 4; ++i) {
        const int row = (tid >> 3) + 64 * i, ch = tid & 7; int key = kt0 + row; if (key < 0) key = 0;
        const v4u v = *(const v4u*)(AK + (rowb + key) * 128 + g * 64 + ch * 8);
        *(LAS v4u*)(L + SWA_K + row * 128 + ((ch ^ ((row >> 1) & 7)) << 4)) = v;
    }
#pragma unroll
    for (int i = 0; i < 4; ++i) {
        const int d = (tid >> 5) + 16 * i, ch = tid & 31; int key0 = kt0 + 8 * ch; if (key0 < 0) key0 = 0;
        const v4u v = *(const v4u*)(AVT + ((size_t)((b * 2 + g) * 64 + d)) * T + key0);
        LAS u64* dp = (LAS u64*)(L + SWA_V + d * SWA_VROW + ch * 16);
        dp[0] = (u64)v.x | ((u64)v.y << 32); dp[1] = (u64)v.z | ((u64)v.w << 32);
    }
    __syncthreads();
    for (int qs = 0; qs < 2; ++qs) {
        const int qq0 = 128 * n + 64 * qh + 32 * qs, kbase = qq0 - 128, lrow0 = 64 * qh + 32 * qs;
        const bf16* qp = AQ + (rowb + qq0 + r32) * 512 + head * 64;
        bf16x8 qf[4];
#pragma unroll
        for (int ks = 0; ks < 4; ++ks) qf[ks] = *(const bf16x8*)(qp + 8 * hi + 16 * ks);
        float mrun = sink2, lrun = 1.0f;
        f32x16 O0 = {}, O1 = {};
#pragma unroll
        for (int kb = 0; kb < 5; ++kb) {
            const int row = lrow0 + 32 * kb + r32, sw = (row >> 1) & 7;
            f32x16 acc = {};
#pragma unroll
            for (int ks = 0; ks < 4; ++ks) acc = __builtin_amdgcn_mfma_f32_32x32x16_bf16(*(const LAS bf16x8*)(L + SWA_K + row * 128 + (((2 * ks + hi) ^ sw) << 4)), qf[ks], acc, 0, 0, 0);
            float bm = -__builtin_inff();
            int dist0 = r32 + 128 - 32 * kb - 4 * hi; asm volatile("" : "+v"(dist0));
            const bool bvalid = (kbase + 32 * kb) >= 0;
#pragma unroll
            for (int r = 0; r < 16; ++r) {
                const int dist = dist0 - ((r & 3) + 8 * (r >> 2));
                const bool valid = bvalid && ((unsigned)dist < 128u);
                const float l = valid ? (acc[r] - slope2 * (float)dist) : -__builtin_inff();
                acc[r] = l; bm = fmaxf(bm, l);
            }
            bm = fmaxf(bm, __shfl_xor(bm, 32));
            const float mnew = fmaxf(mrun, bm), alpha = __builtin_amdgcn_exp2f(mrun - mnew);
            float bs = 0.f;
#pragma unroll
            for (int r = 0; r < 16; ++r) { const float e = __builtin_amdgcn_exp2f(acc[r] - mnew); acc[r] = e; bs += e; }
            bs += __shfl_xor(bs, 32);
            lrun = lrun * alpha + bs; mrun = mnew;
#pragma unroll
            for (int r = 0; r < 16; ++r) { O0[r] *= alpha; O1[r] *= alpha; }
#pragma unroll
            for (int s2 = 0; s2 < 2; ++s2) {
                v4u pw; pw.x = cvtpk(acc[8 * s2 + 0], acc[8 * s2 + 1]); pw.y = cvtpk(acc[8 * s2 + 2], acc[8 * s2 + 3]);
                pw.z = cvtpk(acc[8 * s2 + 4], acc[8 * s2 + 5]); pw.w = cvtpk(acc[8 * s2 + 6], acc[8 * s2 + 7]);
                const bf16x8 pf = __builtin_bit_cast(bf16x8, pw);
                const int tb = lrow0 + 32 * kb + 16 * s2 + 4 * hi;
                const LAS unsigned char* vp = L + SWA_V + r32 * SWA_VROW + 2 * tb;
                typedef u64 u64x2 __attribute__((ext_vector_type(2)));
                u64x2 v0, v1; v0.x = *(const LAS u64*)vp; v0.y = *(const LAS u64*)(vp + 16); v1.x = *(const LAS u64*)(vp + 32 * SWA_VROW); v1.y = *(const LAS u64*)(vp + 32 * SWA_VROW + 16);
                O0 = __builtin_amdgcn_mfma_f32_32x32x16_bf16(__builtin_bit_cast(bf16x8, v0), pf, O0, 0, 0, 0);
                O1 = __builtin_amdgcn_mfma_f32_32x32x16_bf16(__builtin_bit_cast(bf16x8, v1), pf, O1, 0, 0, 0);
            }
        }
        { const float inv = 1.0f / lrun;
#pragma unroll
          for (int r = 0; r < 16; ++r) { O0[r] *= inv; O1[r] *= inv; } }
#pragma unroll
        for (int rg = 0; rg < 4; ++rg) {
            const int d = 8 * rg + 4 * hi;
            const unsigned w0 = pg8::pack4_fp8(O0[4 * rg], O0[4 * rg + 1], O0[4 * rg + 2], O0[4 * rg + 3]);
            const unsigned w1 = pg8::pack4_fp8(O1[4 * rg], O1[4 * rg + 1], O1[4 * rg + 2], O1[4 * rg + 3]);
            unsigned char* op = (unsigned char*)(wsb + dst_off) + (rowb + qq0 + r32) * 512 + head * 64; *(unsigned*)(op + d) = w0; *(unsigned*)(op + 32 + d) = w1;
        }
    }
    __syncthreads();
}

constexpr int CB = 448;
constexpr int L_KT = 0, L_BUF = 32768, L_HIST = 32768, L_QINFO = L_BUF + 64 * CB * 4, L_WSCR = L_QINFO + 2048, L_END = L_WSCR + 8 * 1024, L_VBUF = 0;
__device__ __forceinline__ float relu_i(float x) { const int b = __builtin_bit_cast(int, x); return __builtin_bit_cast(float, b > 0 ? b : 0); }
template <int PASS>
__device__ __forceinline__ void idx_post(const f32x16& acc, int rb, int kb, int s, int t0, LAS unsigned char* L, const float (&wq)[2][2][8], const int (&qa)[2][2], const int (&qb)[2][2], int (&eqseen)[2][2], int (&cnt)[2][2], unsigned (&cw)[2][2][2], int wid, int r32, int hi) {
    LAS unsigned* hist = (LAS unsigned*)(L + L_HIST);
    LAS unsigned* buf = (LAS unsigned*)(L + L_BUF);
#pragma unroll
    for (int g2 = 0; g2 < 2; ++g2) {
        float sc = relu_i(acc[8 * g2]) * wq[rb][g2][0];
#pragma unroll
        for (int hd = 1; hd < 8; ++hd) sc = fmaf(relu_i(acc[8 * g2 + hd]), wq[rb][g2][hd], sc);
        const int ql = 8 * wid + 4 * rb + 2 * g2 + hi, tq = t0 + ql;
        const bool valid = s <= tq;
        const _Float16 hf = (_Float16)sc; const int hb = (int)__builtin_bit_cast(short, hf);
        const unsigned u = (unsigned)(hb ^ ((hb >> 16) | 0x8000)) & 0xffffu;
        if (PASS == 1 || PASS == 4) { if (PASS == 1) __hip_atomic_fetch_add(hist + ql * 256 + (u >> 8), valid ? (1u << ((u >> 3) & 16u)) : 0u, __ATOMIC_RELAXED, __HIP_MEMORY_SCOPE_WORKGROUP);
            cw[rb][g2][kb >> 1] |= (valid ? u : 0u) << (16 * (kb & 1)); }
        else if (PASS == 2) { const bool c = valid && (int)(u >> 7) == qa[rb][g2]; if (__ballot(c) != 0ull) __hip_atomic_fetch_add(hist + ql * 256 + (u & 127u), c ? 1u : 0u, __ATOMIC_RELAXED, __HIP_MEMORY_SCOPE_WORKGROUP); }
        else {
            const bool gt = valid && ((int)u > qa[rb][g2]), eq = valid && ((int)u == qa[rb][g2]);
            const unsigned ltm = (1u << r32) - 1u;
            const u64 em = __ballot(eq);
            const unsigned mh = hi ? (unsigned)(em >> 32) : (unsigned)em;
            const bool keep = gt || (eq && (eqseen[rb][g2] + __popc(mh & ltm)) < qb[rb][g2]);
            eqseen[rb][g2] += __popc(mh);
            const u64 km = __ballot(keep);
            const unsigned kh = hi ? (unsigned)(km >> 32) : (unsigned)km;
            const int pos = cnt[rb][g2] + __popc(kh & ltm);
            if (keep && pos < CB) buf[ql * CB + pos] = (u << 16) | (unsigned)s;
            cnt[rb][g2] += __popc(kh);
        }
    }
}
template <int PASS>
__device__ __forceinline__ void idx_tile(int t0, int kt, const LAS unsigned char* kbuf, LAS unsigned char* L, const bf16x8 (&af)[2][4], const float (&wq)[2][2][8], const int (&qa)[2][2], const int (&qb)[2][2], int (&eqseen)[2][2], int (&cnt)[2][2], unsigned short* codes, int cstride, int wid, int r32, int hi) {
    unsigned cw[2][2][2];
#pragma unroll
    for (int rb = 0; rb < 2; ++rb)
#pragma unroll
        for (int g2 = 0; g2 < 2; ++g2) { cw[rb][g2][0] = 0u; cw[rb][g2][1] = 0u; }
#pragma unroll
    for (int kb = 0; kb < 4; ++kb) {
        bf16x8 bfr[4];
        const int lrow = 32 * kb + r32;
#pragma unroll
        for (int ks = 0; ks < 4; ++ks) bfr[ks] = *(const LAS bf16x8*)(kbuf + lrow * 128 + (((2 * ks + hi) ^ ((lrow >> 1) & 7)) << 4));
        const int s = 128 * kt + 4 * r32 + kb;
        f32x16 acc0 = {}, acc1 = {};
#pragma unroll
        for (int ks = 0; ks < 4; ++ks) acc0 = __builtin_amdgcn_mfma_f32_32x32x16_bf16(af[0][ks], bfr[ks], acc0, 0, 0, 0);
#pragma unroll
        for (int ks = 0; ks < 4; ++ks) acc1 = __builtin_amdgcn_mfma_f32_32x32x16_bf16(af[1][ks], bfr[ks], acc1, 0, 0, 0);
        idx_post<PASS>(acc0, 0, kb, s, t0, L, wq, qa, qb, eqseen, cnt, cw, wid, r32, hi);
        idx_post<PASS>(acc1, 1, kb, s, t0, L, wq, qa, qb, eqseen, cnt, cw, wid, r32, hi);
    }
    if (PASS == 1 || PASS == 4) {
#pragma unroll
        for (int rb = 0; rb < 2; ++rb)
#pragma unroll
            for (int g2 = 0; g2 < 2; ++g2) { const int ql = 8 * wid + 4 * rb + 2 * g2 + hi;
                *(u64*)(codes + (size_t)ql * cstride + 128 * kt + 4 * r32) = (u64)cw[rb][g2][0] | ((u64)cw[rb][g2][1] << 32); }
    }
}
template <int PASS>
__device__ __forceinline__ void idx_pass(int b, int t0, int kt0, int nt, unsigned char* wsb, unsigned short* codes, int cstride, LAS unsigned char* L, const bf16x8 (&af)[2][4], const float (&wq)[2][2][8], int wid, int lane, int tid) {
    { GAS unsigned char* wg_ = (GAS unsigned char*)wsb; asm volatile("" : "+s"(wg_)); wsb = (unsigned char*)wg_; } const bf16* IK = (const bf16*)(wsb + WS_IK);
    const int r32 = lane & 31, hi = lane >> 5;
    LAS int* qinfo = (LAS int*)(L + L_QINFO);
    int qa[2][2], qb[2][2], eqseen[2][2], cnt[2][2];
#pragma unroll
    for (int rb = 0; rb < 2; ++rb)
#pragma unroll
        for (int g2 = 0; g2 < 2; ++g2) { const int ql = 8 * wid + 4 * rb + 2 * g2 + hi; eqseen[rb][g2] = 0; cnt[rb][g2] = 0;
            if (PASS == 2) { qa[rb][g2] = qinfo[ql]; qb[rb][g2] = 0; } else if (PASS == 3) { qa[rb][g2] = qinfo[128 + ql]; qb[rb][g2] = qinfo[192 + ql]; cnt[rb][g2] = qinfo[256 + ql]; eqseen[rb][g2] = qinfo[384 + ql]; } else { qa[rb][g2] = 0; qb[rb][g2] = 0; } }
    const int skey = tid >> 2, sc0 = (tid & 3) * 2;
    const bf16* src = IK + ((size_t)b * T + skey) * 64 + sc0 * 8;
    const int srow = (skey & 3) * 32 + (skey >> 2);
    const int sd0 = srow * 128 + ((sc0 ^ ((srow >> 1) & 7)) << 4), sd1 = srow * 128 + (((sc0 + 1) ^ ((srow >> 1) & 7)) << 4);
    v4u A0, A1, B0, B1;
#define IDX_LOAD(R0, R1, tile) do { const bf16* s_ = src + (size_t)(tile) * (128 * 64); R0 = *(const v4u*)s_; R1 = *(const v4u*)(s_ + 8); } while (0)
#define IDX_WRITE(R0, R1, buf) do { *(LAS v4u*)(L + L_KT + (buf) * 16384 + sd0) = R0; *(LAS v4u*)(L + L_KT + (buf) * 16384 + sd1) = R1; } while (0)
    IDX_LOAD(A0, A1, kt0); IDX_LOAD(B0, B1, (kt0 + 1 < nt ? kt0 + 1 : kt0));
    IDX_WRITE(A0, A1, 0);
    __syncthreads();
    for (int kt = kt0; kt < nt; kt += 2) {
        { const int tn = (kt + 2 < nt) ? kt + 2 : nt - 1; IDX_LOAD(A0, A1, tn); }
        idx_tile<PASS>(t0, kt, L + L_KT, L, af, wq, qa, qb, eqseen, cnt, codes, cstride, wid, r32, hi);
        IDX_WRITE(B0, B1, 1);
        __syncthreads();
        if (kt + 1 >= nt) break;
        { const int tn = (kt + 3 < nt) ? kt + 3 : nt - 1; IDX_LOAD(B0, B1, tn); }
        idx_tile<PASS>(t0, kt + 1, L + L_KT + 16384, L, af, wq, qa, qb, eqseen, cnt, codes, cstride, wid, r32, hi);
        IDX_WRITE(A0, A1, 0);
        __syncthreads();
    }
#undef IDX_LOAD
#undef IDX_WRITE
    if (PASS == 3) {
#pragma unroll
        for (int rb = 0; rb < 2; ++rb)
#pragma unroll
            for (int g2 = 0; g2 < 2; ++g2) if (r32 == 0) qinfo[256 + 8 * wid + 4 * rb + 2 * g2 + hi] = cnt[rb][g2];
    }
}
template <bool NB16>
__device__ __forceinline__ void find_bin(const LAS unsigned* hq, int K, int lane, int& bin, int& above, int& incnt) {
    const v4u w = *(const LAS v4u*)(hq + 4 * lane);
    int c[8];
    if (NB16) { c[0] = w.x & 0xffffu; c[1] = w.x >> 16; c[2] = w.y & 0xffffu; c[3] = w.y >> 16; c[4] = w.z & 0xffffu; c[5] = w.z >> 16; c[6] = w.w & 0xffffu; c[7] = w.w >> 16; }
    else { c[0] = (int)w.x; c[1] = (int)w.y; c[2] = (int)w.z; c[3] = (int)w.w; c[4] = 0; c[5] = 0; c[6] = 0; c[7] = 0; }
    constexpr int NC = NB16 ? 8 : 4;
    int tot = 0;
#pragma unroll
    for (int i = 0; i < NC; ++i) tot += c[i];
    int S = tot;
#pragma unroll
    for (int o = 1; o < 64; o <<= 1) { const int t = __shfl_down(S, o); if (lane + o < 64) S += t; }
    const int ab = S - tot;
    const bool here = (S >= K) && (ab < K);
    const u64 bm = __ballot(here);
    int mybin = NC * lane, myab = ab, myc = c[0]; bool found = false;
#pragma unroll
    for (int i = NC - 1; i >= 0; --i) { if (!found) { if (myab + c[i] >= K || i == 0) { mybin = NC * lane + i; myc = c[i]; found = true; } else myab += c[i]; } }
    const int Ls = (bm == 0ull) ? 0 : (__ffsll((long long)bm) - 1);
    bin = __shfl(mybin, Ls); above = __shfl(myab, Ls); incnt = __shfl(myc, Ls);
}
__device__ __forceinline__ int prune256(LAS unsigned* buf, int n, LAS unsigned* wh, int lane) {
    const unsigned ltm_lo = (lane < 32) ? ((1u << lane) - 1u) : 0xffffffffu, ltm_hi = (lane < 32) ? 0u : ((1u << (lane - 32)) - 1u);
#pragma unroll
    for (int i = 0; i < 4; ++i) wh[i * 64 + lane] = 0u;
    LDS_WAIT();
    for (int i = lane; i < n; i += 64) __hip_atomic_fetch_add(wh + (buf[i] >> 24), 1u, __ATOMIC_RELAXED, __HIP_MEMORY_SCOPE_WORKGROUP);
    LDS_WAIT();
    int b1, ab1, c1; find_bin<false>(wh, 256, lane, b1, ab1, c1);
#pragma unroll
    for (int i = 0; i < 4; ++i) wh[i * 64 + lane] = 0u;
    LDS_WAIT();
    for (int i = lane; i < n; i += 64) { const unsigned e = buf[i]; if ((int)(e >> 24) == b1) __hip_atomic_fetch_add(wh + ((e >> 16) & 255u), 1u, __ATOMIC_RELAXED, __HIP_MEMORY_SCOPE_WORKGROUP); }
    LDS_WAIT();
    int b2, ab2, c2; find_bin<false>(wh, 256 - ab1, lane, b2, ab2, c2);
    const int Tc = (b1 << 8) | b2, need = 256 - ab1 - ab2;
    int eqseen = 0, outc = 0;
    for (int c0 = 0; c0 < n; c0 += 64) {
        const int i = c0 + lane; const unsigned e = (i < n) ? buf[i] : 0u; const int code = (int)(e >> 16);
        const bool gt = (i < n) && code > Tc, eq = (i < n) && code == Tc;
        const u64 em = __ballot(eq);
        const int rank = eqseen + __popc((unsigned)em & ltm_lo) + __popc((unsigned)(em >> 32) & ltm_hi);
        const bool keep = gt || (eq && rank < need);
        eqseen += __popcll(em);
        const u64 km = __ballot(keep);
        const int pos = outc + __popc((unsigned)km & ltm_lo) + __popc((unsigned)(km >> 32) & ltm_hi);
        LDS_WAIT();
        if (keep) buf[pos] = e;
        outc += __popcll(km);
    }
    LDS_WAIT();
    return Tc;
}

__device__ __forceinline__ unsigned scan_hits(const v4u cur, int T) {
    const unsigned c0 = cur.x & 0xffffu, c1 = cur.x >> 16, c2 = cur.y & 0xffffu, c3 = cur.y >> 16, c4 = cur.z & 0xffffu, c5 = cur.z >> 16, c6 = cur.w & 0xffffu, c7 = cur.w >> 16;
    return ((int)c0 > T ? 1u : 0u) | ((int)c1 > T ? 2u : 0u) | ((int)c2 > T ? 4u : 0u) | ((int)c3 > T ? 8u : 0u) | ((int)c4 > T ? 16u : 0u) | ((int)c5 > T ? 32u : 0u) | ((int)c6 > T ? 64u : 0u) | ((int)c7 > T ? 128u : 0u);
}
__device__ __forceinline__ void scan_block(const v4u cur, int kk, int& T, LAS unsigned* buf, int& cnt, LAS unsigned* wh, int lane, u64 ltm) {
    unsigned keep = scan_hits(cur, T);
    int kc = __popc(keep);
    u64 b0 = __ballot(kc & 1), b1 = __ballot(kc & 2), b2 = __ballot(kc & 4), b3 = __ballot(kc & 8);
    int tot = __popcll(b0) + 2 * __popcll(b1) + 4 * __popcll(b2) + 8 * __popcll(b3);
    if (cnt + tot > CB && cnt > 256) {
        LDS_WAIT();
        T = prune256(buf, cnt, wh, lane); cnt = 256;
        keep = scan_hits(cur, T); kc = __popc(keep);
        b0 = __ballot(kc & 1); b1 = __ballot(kc & 2); b2 = __ballot(kc & 4); b3 = __ballot(kc & 8);
        tot = __popcll(b0) + 2 * __popcll(b1) + 4 * __popcll(b2) + 8 * __popcll(b3);
    }
    int pos = cnt + __popcll(b0 & ltm) + 2 * __popcll(b1 & ltm) + 4 * __popcll(b2 & ltm) + 8 * __popcll(b3 & ltm);
    cnt += tot;
    const u64 lo64 = (u64)cur.x | ((u64)cur.y << 32), hi64 = (u64)cur.z | ((u64)cur.w << 32);
    while (keep) {
        const int e = __ffs((int)keep) - 1; keep &= keep - 1u;
        const unsigned code = (unsigned)(((e & 4) ? hi64 : lo64) >> (16 * (e & 3))) & 0xffffu;
        if (pos < CB) buf[pos] = (code << 16) | (unsigned)(kk + e);
        ++pos;
    }
}
__device__ __forceinline__ void scan_codes(const unsigned short* crow, int nkeys, int T, LAS unsigned* buf, int& cnt_io, LAS unsigned* wh, int lane) {
    int cnt = cnt_io;
    const u64 ltm = (lane == 0) ? 0ull : (~0ull >> (64 - lane));
    v4u w0, w1, w2, w3;
#define SC_LOAD(R, kq) do { const int kq_ = (kq) + 8 * lane; R = (kq_ < nkeys) ? *(const v4u*)(crow + kq_) : (v4u){0u, 0u, 0u, 0u}; } while (0)
    SC_LOAD(w0, 0); SC_LOAD(w1, 512); SC_LOAD(w2, 1024); SC_LOAD(w3, 1536);
    for (int k0 = 0; k0 < nkeys; k0 += 2048) {
        { const v4u cur = w0; SC_LOAD(w0, k0 + 2048); scan_block(cur, k0 + 8 * lane, T, buf, cnt, wh, lane, ltm); }
        if (k0 + 512 >= nkeys) break;
        { const v4u cur = w1; SC_LOAD(w1, k0 + 2560); scan_block(cur, k0 + 512 + 8 * lane, T, buf, cnt, wh, lane, ltm); }
        if (k0 + 1024 >= nkeys) break;
        { const v4u cur = w2; SC_LOAD(w2, k0 + 3072); scan_block(cur, k0 + 1024 + 8 * lane, T, buf, cnt, wh, lane, ltm); }
        if (k0 + 1536 >= nkeys) break;
        { const v4u cur = w3; SC_LOAD(w3, k0 + 3584); scan_block(cur, k0 + 1536 + 8 * lane, T, buf, cnt, wh, lane, ltm); }
    }
#undef SC_LOAD
    cnt_io = cnt;
}

__device__ __forceinline__ void sparse_query(int b, int t, const LAS unsigned* idx, unsigned char* wsb, LAS unsigned char* L, int wid, int lane, size_t dst_off) {
    { GAS unsigned char* wg_ = (GAS unsigned char*)wsb; asm volatile("" : "+s"(wg_)); wsb = (unsigned char*)wg_; } bf16* BQ = (bf16*)(wsb + WS_BQ); const bf16* BK = (const bf16*)(wsb + WS_BK); const bf16* BV = (const bf16*)(wsb + WS_BV);
    const int fr = lane & 15, fq = lane >> 4;
    LAS unsigned char* vbuf = L + L_VBUF + wid * 4096;
    const size_t rowb = (size_t)b * T;
    bf16* qrow = BQ + (rowb + t) * 512;
    bf16x8 qf0 = {}, qf1 = {};
    if (fr < 8) { qf0 = *(const bf16x8*)(qrow + fr * 64 + 8 * fq); qf1 = *(const bf16x8*)(qrow + fr * 64 + 32 + 8 * fq); }
    f32x4 S[16];
    {
        v4u kreg[4][4];
#pragma unroll
        for (int c8 = 0; c8 < 4; ++c8)
#pragma unroll
            for (int i = 0; i < 4; ++i) {
                const int row = 8 * i + (lane >> 3), ch = lane & 7;
                unsigned ki = idx[32 * c8 + row] & 0xffffu; if (ki == 0xffffu) ki = 0u;
                kreg[c8][i] = *(const v4u*)(BK + (rowb + ki) * 64 + ch * 8);
            }
#pragma unroll
        for (int c8 = 0; c8 < 8; ++c8) {
#pragma unroll
            for (int i = 0; i < 4; ++i) {
                const int row = 8 * i + (lane >> 3), ch = lane & 7;
                *(LAS v4u*)(vbuf + row * 128 + ((ch ^ (((row >> 1) & 3) << 1)) << 4)) = kreg[c8 & 3][i];
            }
            if (c8 + 4 < 8) {
#pragma unroll
                for (int i = 0; i < 4; ++i) {
                    const int row = 8 * i + (lane >> 3), ch = lane & 7;
                    unsigned ki = idx[32 * (c8 + 4) + row] & 0xffffu; if (ki == 0xffffu) ki = 0u;
                    kreg[c8 & 3][i] = *(const v4u*)(BK + (rowb + ki) * 64 + ch * 8);
                }
            }
            LDS_WAIT();
#pragma unroll
            for (int kbl = 0; kbl < 2; ++kbl) {
                const int row = 16 * kbl + fr, sw = ((row >> 1) & 3) << 1;
                const bf16x8 a0 = *(const LAS bf16x8*)(vbuf + row * 128 + ((fq ^ sw) << 4)), a1 = *(const LAS bf16x8*)(vbuf + row * 128 + (((fq + 4) ^ sw) << 4));
                f32x4 acc = {0.f, 0.f, 0.f, 0.f};
                acc = __builtin_amdgcn_mfma_f32_16x16x32_bf16(a0, qf0, acc, 0, 0, 0);
                acc = __builtin_amdgcn_mfma_f32_16x16x32_bf16(a1, qf1, acc, 0, 0, 0);
                S[2 * c8 + kbl] = acc;
            }
            LDS_WAIT();
        }
    }
    v4u vreg[4][4];
#pragma unroll
    for (int c8 = 0; c8 < 4; ++c8)
#pragma unroll
        for (int i = 0; i < 4; ++i) {
            const int row = 8 * i + (lane >> 3), ch = lane & 7;
            unsigned ki = idx[32 * c8 + row] & 0xffffu; if (ki == 0xffffu) ki = 0u;
            vreg[c8][i] = *(const v4u*)(BV + (rowb + ki) * 64 + ch * 8);
        }
    const float slope2 = __builtin_amdgcn_exp2f(-0.5f * (float)((fr & 7) + 9)) * LOG2E;
    float mx = -__builtin_inff();
#pragma unroll
    for (int kb = 0; kb < 16; ++kb) {
        const v4u i4 = *(const LAS v4u*)(idx + 16 * kb + 4 * fq);
        const unsigned k0 = i4.x & 0xffffu, k1 = i4.y & 0xffffu, k2 = i4.z & 0xffffu, k3 = i4.w & 0xffffu;
        { const float l = (k0 != 0xffffu) ? (S[kb][0] - slope2 * (float)(t - (int)k0)) : -__builtin_inff(); S[kb][0] = l; mx = fmaxf(mx, l); }
        { const float l = (k1 != 0xffffu) ? (S[kb][1] - slope2 * (float)(t - (int)k1)) : -__builtin_inff(); S[kb][1] = l; mx = fmaxf(mx, l); }
        { const float l = (k2 != 0xffffu) ? (S[kb][2] - slope2 * (float)(t - (int)k2)) : -__builtin_inff(); S[kb][2] = l; mx = fmaxf(mx, l); }
        { const float l = (k3 != 0xffffu) ? (S[kb][3] - slope2 * (float)(t - (int)k3)) : -__builtin_inff(); S[kb][3] = l; mx = fmaxf(mx, l); }
    }
    mx = fmaxf(mx, __shfl_xor(mx, 16)); mx = fmaxf(mx, __shfl_xor(mx, 32));
    float sum = 0.f;
#pragma unroll
    for (int kb = 0; kb < 16; ++kb)
#pragma unroll
        for (int r = 0; r < 4; ++r) { const float e = __builtin_amdgcn_exp2f(S[kb][r] - mx); S[kb][r] = e; sum += e; }
    sum += __shfl_xor(sum, 16); sum += __shfl_xor(sum, 32);
    const float inv = 1.0f / sum;
    f32x4 O[4];
#pragma unroll
    for (int db = 0; db < 4; ++db) O[db] = (f32x4){0.f, 0.f, 0.f, 0.f};
#pragma unroll
    for (int c8 = 0; c8 < 8; ++c8) {
#pragma unroll
        for (int i = 0; i < 4; ++i) {
            const int row = 8 * i + (lane >> 3), ch = lane & 7;
            *(LAS v4u*)(vbuf + row * 128 + ((ch ^ (((row >> 1) & 3) << 1)) << 4)) = vreg[c8 & 3][i];
        }
        if (c8 + 4 < 8) {
#pragma unroll
            for (int i = 0; i < 4; ++i) {
                const int row = 8 * i + (lane >> 3), ch = lane & 7;
                unsigned ki = idx[32 * (c8 + 4) + row] & 0xffffu; if (ki == 0xffffu) ki = 0u;
                vreg[c8 & 3][i] = *(const v4u*)(BV + (rowb + ki) * 64 + ch * 8);
            }
        }
        LDS_WAIT();
        v4u pw; pw.x = cvtpk(S[2 * c8][0] * inv, S[2 * c8][1] * inv); pw.y = cvtpk(S[2 * c8][2] * inv, S[2 * c8][3] * inv);
        pw.z = cvtpk(S[2 * c8 + 1][0] * inv, S[2 * c8 + 1][1] * inv); pw.w = cvtpk(S[2 * c8 + 1][2] * inv, S[2 * c8 + 1][3] * inv);
        const bf16x8 pa = __builtin_bit_cast(bf16x8, pw);
        const int row0 = 4 * fq + (fr >> 2), row1 = row0 + 16;
#pragma unroll
        for (int db = 0; db < 4; ++db) {
            const int chunk = 2 * db + ((fr & 3) >> 1), sub = (fr & 1) * 8;
            const s16x4 lo = __builtin_bit_cast(s16x4, __builtin_amdgcn_ds_read_tr16_b64_v4i16((LAS s16x4*)(vbuf + row0 * 128 + ((chunk ^ (((row0 >> 1) & 3) << 1)) << 4) + sub)));
            const s16x4 hi4 = __builtin_bit_cast(s16x4, __builtin_amdgcn_ds_read_tr16_b64_v4i16((LAS s16x4*)(vbuf + row1 * 128 + ((chunk ^ (((row1 >> 1) & 3) << 1)) << 4) + sub)));
            const bf16x8 vb = (bf16x8){lo[0], lo[1], lo[2], lo[3], hi4[0], hi4[1], hi4[2], hi4[3]};
            O[db] = __builtin_amdgcn_mfma_f32_16x16x32_bf16(pa, vb, O[db], 0, 0, 0);
        }
    }
    if (fq < 2) {
#pragma unroll
        for (int db = 0; db < 4; ++db)
#pragma unroll
            for (int r = 0; r < 4; ++r) ((unsigned char*)(wsb + dst_off))[(rowb + t) * 512 + (4 * fq + r) * 64 + 16 * db + fr] = (unsigned char)(pg8::pack4_fp8(O[db][r], 0.f, 0.f, 0.f) & 0xffu);
    }
}

__device__ __forceinline__ void sparse_unit(int b, int j, unsigned short* codes, int cstride, unsigned char* wsb, LAS unsigned char* L, int wid, int lane, int tid) {
    { GAS unsigned char* wg_ = (GAS unsigned char*)wsb; asm volatile("" : "+s"(wg_)); wsb = (unsigned char*)wg_; } const bf16* IQ = (const bf16*)(wsb + WS_IQ); const float* IW = (const float*)(wsb + WS_IW);
    const int t0 = 64 * j, ntiles = (j >> 1) + 1, r32 = lane & 31, hi = lane >> 5;
    const size_t rowb = (size_t)b * T;
    LAS unsigned* hist = (LAS unsigned*)(L + L_HIST);
    LAS unsigned* cbuf = (LAS unsigned*)(L + L_BUF);
    LAS int* qinfo = (LAS int*)(L + L_QINFO);
    bf16x8 af[2][4];
    { const int a = r32 >> 3, hp = (r32 >> 2) & 1, bb = r32 & 3, qi = 2 * (a >> 1) + hp, hd = 4 * (a & 1) + bb;
#pragma unroll
      for (int rb = 0; rb < 2; ++rb) { const bf16* ap = IQ + (rowb + t0 + 8 * wid + 4 * rb + qi) * 512 + hd * 64 + 8 * hi;
#pragma unroll
          for (int ks = 0; ks < 4; ++ks) af[rb][ks] = *(const bf16x8*)(ap + 16 * ks); } }
    float wq[2][2][8];
#pragma unroll
    for (int rb = 0; rb < 2; ++rb)
#pragma unroll
        for (int g2 = 0; g2 < 2; ++g2) { const float* wp = IW + (rowb + t0 + 8 * wid + 4 * rb + 2 * g2 + hi) * 8; const f32x4 w0 = *(const f32x4*)wp, w1 = *(const f32x4*)(wp + 4);
            wq[rb][g2][0] = w0[0]; wq[rb][g2][1] = w0[1]; wq[rb][g2][2] = w0[2]; wq[rb][g2][3] = w0[3]; wq[rb][g2][4] = w1[0]; wq[rb][g2][5] = w1[1]; wq[rb][g2][6] = w1[2]; wq[rb][g2][7] = w1[3]; }
#ifndef REP_P1
#define REP_P1 1
#endif
    for (int rp1_ = 0; rp1_ < REP_P1; ++rp1_) {
#pragma unroll
    for (int i = 0; i < 32; ++i) hist[(8 * wid) * 256 + i * 64 + lane] = 0u;
    __syncthreads();
    idx_pass<1>(b, t0, 0, ntiles, wsb, codes, cstride, L, af, wq, wid, lane, tid);
    }
    for (int i = 0; i < 8; ++i) {
        const int ql = 8 * wid + i, t = t0 + ql; int bin = 0, above = 0, inc = 0;
        if (t + 1 > 256) find_bin<true>(hist + ql * 256, 256, lane, bin, above, inc);
        if (lane == 0) qinfo[128 + ql] = (t + 1 > 256) ? ((bin << 7) - 1) : 0;
    }
    LDS_WAIT();
    __syncthreads();
    VM_WAIT();
    __builtin_amdgcn_fence(__ATOMIC_ACQUIRE, "agent"); VM_WAIT();
#ifndef REP_SCAN
#define REP_SCAN 1
#endif
#ifndef REP_SCPR
#define REP_SCPR 1
#endif
    LAS unsigned* wh = (LAS unsigned*)(L + L_WSCR + wid * 1024);
    for (int rsp_ = 0; rsp_ < REP_SCPR; ++rsp_) {
    for (int rsc_ = 0; rsc_ < REP_SCAN; ++rsc_)
    { const int nstored = ntiles * 128;
      for (int i = 0; i < 8; ++i) {
        const int ql = 8 * wid + i; int c = 0;
        scan_codes(codes + (size_t)ql * cstride, nstored, qinfo[128 + ql], cbuf + ql * CB, c, wh, lane);
        if (lane == 0) qinfo[256 + ql] = c;
      } }
    LDS_WAIT();
    for (int i = 0; i < 8; ++i) {
        const int ql = 8 * wid + i; int n = qinfo[256 + ql]; if (n > CB) n = CB;
        LAS unsigned* qb_ = cbuf + ql * CB;
        if (n > 256) (void)prune256(qb_, n, wh, lane);
        else { for (int p = n + lane; p < 256; p += 64) qb_[p] = 0xffffffffu; LDS_WAIT(); }
    }
    }
    __syncthreads();
#ifndef REP_ATT
#define REP_ATT 1
#endif
    for (int ra_ = 0; ra_ < REP_ATT; ++ra_)
    for (int i = 0; i < 8; ++i) sparse_query(b, t0 + 8 * wid + i, cbuf + (8 * wid + i) * CB, wsb, L, wid, lane, WS_YB8);
    __syncthreads();
}
}

struct Args { const float* in[18]; float* out; unsigned char* ws; int ph_lo, ph_hi, use_bar, pad; };

__global__ void __launch_bounds__(NWAVES * 64, 2) mega(Args args) {
    extern __shared__ __attribute__((aligned(16))) unsigned char lds[];
    LAS unsigned char* L = (LAS unsigned char*)lds;
    volatile LAS unsigned* MISC = (volatile LAS unsigned*)(L + MISC_OFF);
    const int wave = __builtin_amdgcn_readfirstlane((int)threadIdx.x >> 6);
#define LANE_TID int lane; asm volatile("v_mbcnt_lo_u32_b32 %0, -1, 0\n\tv_mbcnt_hi_u32_b32 %0, -1, %0" : "=v"(lane)); const int tid = wave * 64 + lane; (void)tid;
    const int G = gridDim.x; const int bx = blockIdx.x; const int vcu = (G % 8 == 0) ? (bx % 8) * (G / 8) + bx / 8 : bx;
    { LANE_TID for (int u = tid; u < (LDS_BYTES - LDSCTL_OFF) / 4; u += NWAVES * 64) ((LAS unsigned*)(L + LDSCTL_OFF))[u] = 0u; }
    __syncthreads();
    if (args.use_bar) (void)xcd_barrier_post((unsigned*)((gu32*)(args.ws + WS_CTL) + CW_BAR), MISC + 8);
    const int lo = args.ph_lo, hi = args.ph_hi;
#define IN(k) (lo <= (k) && (k) < hi)
#define WSP(off) ((bf16*)(wsl + (off)))
#define WSF(off) ((float*)(wsl + (off)))
#define PHASE_WS GAS unsigned char* wsg_ = (GAS unsigned char*)args.ws; asm volatile("" : "+s"(wsg_)); unsigned char* wsl = (unsigned char*)wsg_;
#define PHASE_PTRS LANE_TID GAS unsigned char* wsg_ = (GAS unsigned char*)args.ws; asm volatile("" : "+s"(wsg_)); unsigned char* wsl = (unsigned char*)wsg_;
#define GRID_BAR(k) do { if (IN(k) && IN((k) + 1)) { XcdBarrier bb_; bb_.bar = (unsigned*)((gu32*)(args.ws + WS_CTL) + CW_BAR); bb_.x = xb_xcc_id(); bb_.st = (volatile LAS unsigned*)(L + MISC_OFF) + 8; xcd_barrier(bb_); } } while (0)
    const int gw = vcu * NWAVES + wave, NGW = G * NWAVES;

#if (PH_MASK >> 0) & 1
    if (IN(0)) {
        PHASE_PTRS
        const float* x = as_global(args.in[0]); const float* pin = as_global(args.in[1]); const float* ln_ffn1 = as_global(args.in[2]); const float* w_ffn1_in = as_global(args.in[3]); const float* w_ffn1_out = as_global(args.in[4]); const float* ln_mix = as_global(args.in[5]); const float* w_in = as_global(args.in[6]);
        const float* w_br_a = as_global(args.in[8]); const float* w_br_b = as_global(args.in[9]); const float* w_out = as_global(args.in[10]); const float* ln_ffn2 = as_global(args.in[11]); const float* w_ffn2_in = as_global(args.in[12]); const float* w_ffn2_out = as_global(args.in[13]); const float* ln_ple = as_global(args.in[14]); const float* w_ple_gate = as_global(args.in[15]); const float* w_ple_proj = as_global(args.in[16]);
        bf16 *W1 = WSP(WS_W1), *W2 = WSP(WS_W2), *WIN = WSP(WS_WIN), *WA = WSP(WS_WA), *WB = WSP(WS_WB), *WO = WSP(WS_WO), *W3 = WSP(WS_W3), *W4 = WSP(WS_W4), *WG = WSP(WS_WG), *WP = WSP(WS_WP), *HB = WSP(WS_HB), *PB = WSP(WS_PB);
        LAS float* scr = (LAS float*)(L + RING_OFF + wave * 16384);
        constexpr int I_W1 = 16 * 176, I_W2 = 44 * 32, I_WIN = 16 * 64, I_WA = 8 * 32, I_WO = 16 * 32, I_WP = 4 * 32;
        constexpr int NITEMS = 2 * I_W1 + 2 * I_W2 + 2 * I_WIN + 2 * I_WA + 2 * I_WO + I_WP;
        const int n_it = (NITEMS - gw + NGW - 1) / NGW, n_x = (M / 2 - gw + NGW - 1) / NGW;
        for (int st = 0; st < (n_it > n_x ? n_it : n_x); ++st) {
            const int m0 = (gw + st * NGW) * 2; const bool has_x = st < n_x;
            f32x4 v[2][4];
            if (has_x) {
#pragma unroll
                for (int r = 0; r < 2; ++r) { const GAS f32x4* xr = (const GAS f32x4*)(x + (size_t)(m0 + r) * D) + lane;
#pragma unroll
                    for (int j = 0; j < 4; ++j) v[r][j] = xr[64 * j]; }
            }
            const int it = gw + st * NGW;
            if (it < NITEMS) {
                int r = it; const float* Wp_ = w_ffn1_in; int Ns = 2 * FF, Kk = D, nblk = 176, mapid = 1, f8 = 1; unsigned char* dst = (unsigned char*)W1; const float* gn = ln_ffn1;
                if (r >= I_W1) { r -= I_W1; Wp_ = w_ffn2_in; dst = (unsigned char*)W3; gn = ln_ffn2; f8 = 1;
                  if (r >= I_W1) { r -= I_W1; Wp_ = w_ffn1_out; Ns = D; Kk = FF; nblk = 32; mapid = 0; f8 = 1; dst = (unsigned char*)W2; gn = nullptr;
                    if (r >= I_W2) { r -= I_W2; Wp_ = w_ffn2_out; dst = (unsigned char*)W4; f8 = 1;
                      if (r >= I_W2) { r -= I_W2; Wp_ = w_in; Ns = DIN; Kk = D; nblk = 64; mapid = 2; f8 = 0; dst = (unsigned char*)WIN; gn = ln_mix;
                        if (r >= I_WIN) { r -= I_WIN; mapid = 3; f8 = 1; dst = (unsigned char*)WIN + 4 * MiB;
                          if (r >= I_WIN) { r -= I_WIN; Wp_ = w_br_a; Ns = D; Kk = 512; nblk = 32; mapid = 0; dst = (unsigned char*)WA; gn = nullptr;
                            if (r >= I_WA) { r -= I_WA; Wp_ = w_br_b; dst = (unsigned char*)WB;
                              if (r >= I_WA) { r -= I_WA; Wp_ = w_out; Kk = D; dst = (unsigned char*)WO;
                                if (r >= I_WO) { r -= I_WO; Wp_ = w_ple_gate; dst = (unsigned char*)WG; gn = ln_ple;
                                  if (r >= I_WO) { r -= I_WO; Wp_ = w_ple_proj; Kk = DPLE; dst = (unsigned char*)WP; gn = nullptr; } } } } } } } } } }
                tr_generic(Wp_, Ns, Kk, dst, gn, mapid, f8, scr, r, nblk, lane);
            }
            if (has_x) {
#pragma unroll
                for (int r = 0; r < 2; ++r) { float s = 0.f;
#pragma unroll
                    for (int j = 0; j < 4; ++j) s += (v[r][j].x * v[r][j].x + v[r][j].y * v[r][j].y) + (v[r][j].z * v[r][j].z + v[r][j].w * v[r][j].w);
                    const float rs = __builtin_amdgcn_rsqf(wave_sum(s) * (1.f / D) + 1e-6f);
                    GAS unsigned* o8 = (GAS unsigned*)(wsl + WS_X8 + (size_t)(m0 + r) * D) + lane;
#pragma unroll
                    for (int j = 0; j < 4; ++j) o8[64 * j] = pg8::pack4_fp8(v[r][j].x * rs, v[r][j].y * rs, v[r][j].z * rs, v[r][j].w * rs); }
            }
        }
        { const size_t NV = (size_t)M * DPLE / 4, stride = (size_t)G * 512;
          for (size_t i = (size_t)(bx * 512 + tid); i < NV; i += 4 * stride) {
            f32x4 v[4];
#pragma unroll
            for (int u = 0; u < 4; ++u) { const size_t ii = i + u * stride; v[u] = (ii < NV) ? ((const GAS f32x4*)pin)[ii] : (f32x4){0.f, 0.f, 0.f, 0.f}; }
#pragma unroll
            for (int u = 0; u < 4; ++u) { const size_t ii = i + u * stride; if (ii < NV) ((GAS unsigned*)PB)[ii] = pg8::pack4_fp8(v[u].x, v[u].y, v[u].z, v[u].w); }
          } }
    }
#endif
    GRID_BAR(0);
#if (PH_MASK >> 1) & 1
    if (IN(1)) {
        PHASE_WS bf16 *HB = WSP(WS_HB), *W1 = WSP(WS_W1), *ACT = WSP(WS_ACT);
        pg8::Gemm g{WSP(WS_X8), W1, M, 2 * FF, D / 2}; pg8::StaticOrder S; S.init(M, 2 * FF, G, bx);
        pg8::EpiSwiglu<false, true, true> E{ACT, L};
        pg8::gemm_phase<pg8::EpiSwiglu<false, true, true>, pg8::StaticOrder, true, true, true>(L + RING_OFF, g, S, E, wave);
    }
#endif
    GRID_BAR(1);
#if (PH_MASK >> 2) & 1
    if (IN(2)) {
        PHASE_WS bf16 *HB = WSP(WS_HB), *W2 = WSP(WS_W2), *ACT = WSP(WS_ACT); float* RSQ1 = WSF(WS_RSQ1); const float* x = as_global(args.in[0]);
        pg8::Gemm g{ACT, W2, M, D, FF / 2}; pg8::StaticOrder S; S.init(M, D, G, bx);
        pg8::EpiResid<true, true, true, true> E{x, HB, RSQ1, (unsigned char*)(wsl + WS_X8)};
        pg8::gemm_phase<pg8::EpiResid<true, true, true, true>, pg8::StaticOrder, true, true, true>(L + RING_OFF, g, S, E, wave);
    }
#endif
    GRID_BAR(2);
#if (PH_MASK >> 3) & 1
    if (IN(3)) {
        PHASE_WS bf16 *HB = WSP(WS_HB), *WIN = WSP(WS_WIN); float *RSQ1 = WSF(WS_RSQ1); bf16* SG = (bf16*)as_global(args.out);
        { pg8::Gemm g{HB, WIN, M, 2048, D}; pg8::StaticOrder S; S.init(M, 2048, G, bx);
          { LANE_TID pg8::stage_rs(L, S, RSQ1, tid, 1.0f); }
          pg8::EpiProj E{L, wsl, SG};
          pg8::gemm_phase<pg8::EpiProj, pg8::StaticOrder, true, true>(L + RING_OFF, g, S, E, wave); }
        { pg8::Gemm g{WSP(WS_X8), (bf16*)((unsigned char*)WIN + 4 * MiB), M, 2048, D / 2}; pg8::StaticOrder S; S.init(M, 2048, G, bx);
          { LANE_TID pg8::stage_rs(L, S, RSQ1, tid, 1.0f); }
          pg8::EpiSig E{L, SG};
          pg8::gemm_phase<pg8::EpiSig, pg8::StaticOrder, true, true, true>(L + RING_OFF, g, S, E, wave); }
    }
#endif
    GRID_BAR(3);
#if (PH_MASK >> 4) & 1
    if (IN(4)) {
                LANE_TID unsigned char* wsl = as_global(args.ws); const float* a_sink = as_global(args.in[7]);
#ifndef NO_SWA
#ifndef REP_SWA
#define REP_SWA 1
#endif
        for (int rs_ = 0; rs_ < REP_SWA; ++rs_)
        for (int i = 0; i < 2; ++i) { const int su = vcu + 256 * i; if (su < 512) att::swa_unit(su >> 7, (su >> 1) & 63, su & 1, wsl, a_sink, L, wave, lane, tid, (rs_ + 1 < REP_SWA) ? WS_ACT : WS_YA8); }
#endif
#ifndef NO_SP
        if (vcu < 256) { const int sb = vcu >> 6, sj = vcu & 63, mh = sj >> 1;
            const int pre = 64 * sj - (mh * (mh - 1) + ((sj & 1) ? mh : 0)) + sb * 3104, cstride = (64 - mh) * 128;
            unsigned short* codes = (unsigned short*)(wsl + WS_ACT + (size_t)pre * 16384);
            att::sparse_unit(sb, sj, codes, cstride, wsl, L, wave, lane, tid);
            att::sparse_unit(sb, 127 - sj, codes, cstride, wsl, L, wave, lane, tid); }
#endif


    }
#endif
    GRID_BAR(4);
#if (PH_MASK >> 5) & 1
    if (IN(5)) {
        PHASE_WS bf16 *AQ = WSP(WS_AQ), *BQ = WSP(WS_BQ), *WA = WSP(WS_WA), *WB = WSP(WS_WB), *TA = WSP(WS_TA), *MIX = WSP(WS_MIX); bf16* SG = (bf16*)as_global(args.out);
        { pg8::Gemm g{WSP(WS_YA8), WA, M, D, 256}; pg8::StaticOrder S; S.init(M, D, G, bx);
          pg8::EpiGate<1, true, true> E{TA, SG, 0, nullptr};
          pg8::gemm_phase<pg8::EpiGate<1, true, true>, pg8::StaticOrder, true, true, true>(L + RING_OFF, g, S, E, wave); }
        VM_WAIT(); __syncthreads();
        { pg8::Gemm g{WSP(WS_YB8), WB, M, D, 256}; pg8::StaticOrder S; S.init(M, D, G, bx);
          pg8::EpiGate<2, true, true> E{MIX, SG, 1024, TA};
          pg8::gemm_phase<pg8::EpiGate<2, true, true>, pg8::StaticOrder, true, true, true>(L + RING_OFF, g, S, E, wave); }
    }
#endif
    GRID_BAR(5);
#if (PH_MASK >> 6) & 1
    if (IN(6)) {
        PHASE_WS bf16 *HB = WSP(WS_HB), *WO = WSP(WS_WO), *MIX = WSP(WS_MIX); float* RSQ2 = WSF(WS_RSQ2);
        pg8::Gemm g{MIX, WO, M, D, D / 2}; pg8::StaticOrder S; S.init(M, D, G, bx);
        pg8::EpiResid<false, false, true, true> E{nullptr, HB, RSQ2, (unsigned char*)(wsl + WS_X8)};
        pg8::gemm_phase<pg8::EpiResid<false, false, true, true>, pg8::StaticOrder, true, true, true>(L + RING_OFF, g, S, E, wave);
    }
#endif
    GRID_BAR(6);
#if (PH_MASK >> 7) & 1
    if (IN(7)) {
        PHASE_WS bf16 *HB = WSP(WS_HB), *W3 = WSP(WS_W3), *ACT = WSP(WS_ACT); float* RSQ2 = WSF(WS_RSQ2);
        pg8::Gemm g{WSP(WS_X8), W3, M, 2 * FF, D / 2}; pg8::StaticOrder S; S.init(M, 2 * FF, G, bx);
        { LANE_TID pg8::stage_rs(L, S, RSQ2, tid, 1.0f); }
        pg8::EpiSwiglu<true, true> E{ACT, L};
        pg8::gemm_phase<pg8::EpiSwiglu<true, true>, pg8::StaticOrder, true, true, true>(L + RING_OFF, g, S, E, wave);
    }
#endif
    GRID_BAR(7);
#if (PH_MASK >> 8) & 1
    if (IN(8)) {
        PHASE_WS bf16 *HB = WSP(WS_HB), *W4 = WSP(WS_W4), *ACT = WSP(WS_ACT); float* RSQ3 = WSF(WS_RSQ3);
        pg8::Gemm g{ACT, W4, M, D, FF / 2}; pg8::StaticOrder S; S.init(M, D, G, bx);
        pg8::EpiResid<false, true, true, true> E{nullptr, HB, RSQ3, (unsigned char*)(wsl + WS_X8)};
        pg8::gemm_phase<pg8::EpiResid<false, true, true, true>, pg8::StaticOrder, true, true, true>(L + RING_OFF, g, S, E, wave);
    }
#endif
    GRID_BAR(8);
#if (PH_MASK >> 9) & 1
    if (IN(9)) {
        PHASE_WS bf16 *HB = WSP(WS_HB), *PB = WSP(WS_PB), *WP = WSP(WS_WP), *WG = WSP(WS_WG), *PP = WSP(WS_PP); float *RSQ3 = WSF(WS_RSQ3), *RSQ4 = WSF(WS_RSQ4); float* out = as_global(args.out);
        { pg8::Gemm g{PB, WP, M, D, DPLE / 2}; pg8::StaticOrder S; S.init(M, D, G, bx);
          pg8::EpiGate<0, true, true> E{PP, nullptr, 0, nullptr};
          pg8::gemm_phase<pg8::EpiGate<0, true, true>, pg8::StaticOrder, true, true, true>(L + RING_OFF, g, S, E, wave); }
        VM_WAIT(); __syncthreads();
        { pg8::Gemm g{WSP(WS_X8), WG, M, D, D / 2}; pg8::StaticOrder S; S.init(M, D, G, bx);
          { LANE_TID pg8::stage_rs(L, S, RSQ3, tid, 1.0f); }
          pg8::EpiPle<true> E{L, HB, PP, out, RSQ4, (unsigned*)(wsl + WS_CTL) + 32768, as_global(args.in[17])};
          pg8::gemm_phase<pg8::EpiPle<true>, pg8::StaticOrder, true, true, true>(L + RING_OFF, g, S, E, wave); }
    }
#endif
#undef IN
#undef GRID_BAR
}


#ifndef MK_SINGLE
#define MK_SINGLE 1
#endif
extern "C" void kernel_launch(void* const* d_in, const int* in_sizes, int n_in, void* d_out, int out_size, void* d_ws, size_t ws_size, hipStream_t stream) {
    static int grid = 0;
    if (grid == 0) {
        int dev = 0, cus = 0;
        if (ws_size < WS_END || hipGetDevice(&dev) != hipSuccess || hipDeviceGetAttribute(&cus, hipDeviceAttributeMultiprocessorCount, dev) != hipSuccess) { fprintf(stderr, "kernel_launch: setup failed (ws %zu)\n", ws_size); grid = -1; return; }
        if (hipFuncSetAttribute((const void*)mega, hipFuncAttributeMaxDynamicSharedMemorySize, LDS_BYTES) != hipSuccess) { fprintf(stderr, "kernel_launch: hipFuncSetAttribute failed\n"); grid = -1; return; }
        grid = cus;
    }
    if (grid < 0) return;
    (void)hipMemsetAsync((char*)d_ws + WS_CTL, 0, CTL_ZERO_BYTES, stream);
    Args a{};
    for (int i = 0; i < 18; ++i) a.in[i] = (const float*)d_in[i];
    a.out = (float*)d_out; a.ws = (unsigned char*)d_ws;
    if (MK_SINGLE) { a.use_bar = 1; a.ph_lo = 0; a.ph_hi = 10; hipLaunchKernelGGL(mega, dim3(grid), dim3(NWAVES * 64), LDS_BYTES, stream, a); }
    else { a.use_bar = 0;
#ifndef REP_MASK
#define REP_MASK 0
#endif
        for (int ph = 0; ph < 10; ++ph) { const int reps = 1 + ((REP_MASK >> ph) & 1); for (int r = 0; r < reps; ++r) { a.ph_lo = ph; a.ph_hi = ph + 1; hipLaunchKernelGGL(mega, dim3(grid), dim3(NWAVES * 64), LDS_BYTES, stream, a); } } }
}
```

```cpp
#include <hip/hip_runtime.h>
#include <cstdio>
#include <cstdint>

namespace pg8 {
#define PG8_LAS __attribute__((address_space(3)))
typedef unsigned short bf16_t;
typedef short bf16x8 __attribute__((ext_vector_type(8)));
typedef float f32x4 __attribute__((ext_vector_type(4)));
typedef unsigned u32x4 __attribute__((ext_vector_type(4)));
typedef unsigned u32x2 __attribute__((ext_vector_type(2)));
constexpr int BM = 256, BK = 64, HALF = 128, HTB = HALF * BK * 2, STAGE_BYTES = 8 * HTB, NXCD = 8, WGM = 8;

__host__ __device__ __forceinline__ int lds_byte(int r, int c) { const int st = (r >> 4) * 2 + (c >> 5), rr = r & 15, cc = c & 31, ob = rr * 64 + cc * 2; return st * 1024 + (ob ^ (((ob >> 9) & 1) << 5)); }
__host__ __device__ __forceinline__ void stage_rc(int b, int& R, int& C) { const int st = b / 1024, sb = b % 1024, swz = sb ^ (((sb >> 9) & 1) << 5); R = (st >> 1) * 16 + swz / 64; C = (st & 1) * 32 + (swz % 64) / 2; }
__host__ __device__ __forceinline__ int perm32(int rho) { const int n = rho >> 4, i = rho & 15; return 8 * (i >> 2) + 4 * n + (i & 3); }

struct Unit { int pm, pn, ord; };
struct Gemm { const bf16_t* A; const bf16_t* Bt; int M, N, K; };

struct StaticOrder {
    int nM, nN, nwg, G, c;
    __host__ __device__ void init(int M, int N, int G_, int c_) { nM = M / BM; nN = N / BM; nwg = nM * nN; G = G_; c = c_; }
    __host__ __device__ bool next(int i, Unit& u) const {
        const long L = (long)i * G + c; if (L >= nwg) return false;
        int wgid = (int)L; { const int q = nwg / NXCD, r = nwg % NXCD, xcd = wgid % NXCD, off = wgid / NXCD; wgid = (xcd < r ? xcd * (q + 1) : r * (q + 1) + (xcd - r) * q) + off; }
        const int nig = WGM * nN, gid = wgid / nig, fm = gid * WGM, gsz = (nM - fm) < WGM ? (nM - fm) : WGM;
        u.pm = fm + ((wgid % nig) % gsz); u.pn = (wgid % nig) / gsz; return true;
    }
    __device__ __forceinline__ void a_ready(const Unit&) const {}
    __device__ __forceinline__ void done(const Unit&) const {}
};

__device__ __forceinline__ unsigned cvt_pk_bf16(float lo, float hi) { unsigned r; asm volatile("v_cvt_pk_bf16_f32 %0, %1, %2" : "=v"(r) : "v"(lo), "v"(hi)); return r; }
__device__ __forceinline__ float bf_lo(unsigned w) { return __uint_as_float(w << 16); }
__device__ __forceinline__ float bf_hi(unsigned w) { return __uint_as_float(w & 0xffff0000u); }
__device__ __forceinline__ float fsigmoid(float x) { return __builtin_amdgcn_rcpf(1.0f + __builtin_amdgcn_exp2f(-1.4426950408889634f * x)); }
__device__ __forceinline__ float rs_of(const float* rsq, int row) {
    const f32x4* p = (const f32x4*)(rsq + (size_t)row * 16);
    const f32x4 a = p[0], b = p[1], c = p[2], d = p[3];
    const float s = ((a[0] + a[1]) + (a[2] + a[3])) + ((b[0] + b[1]) + (b[2] + b[3])) + ((c[0] + c[1]) + (c[2] + c[3])) + ((d[0] + d[1]) + (d[2] + d[3]));
    return __builtin_amdgcn_rsqf(s * (1.0f / 1024.0f) + 1e-6f);
}
__device__ __forceinline__ void rs8_of(const float* rsq, int row0, int fq, float (&rs)[2][4]) {
    f32x4 p[2][4];
#pragma unroll
    for (int ai = 0; ai < 2; ++ai)
#pragma unroll
        for (int m = 0; m < 4; ++m) p[ai][m] = *(const f32x4*)(rsq + (size_t)(row0 + ai * HALF + m * 16) * 16 + 4 * fq);
#pragma unroll
    for (int ai = 0; ai < 2; ++ai)
#pragma unroll
        for (int m = 0; m < 4; ++m) { float s = (p[ai][m][0] + p[ai][m][1]) + (p[ai][m][2] + p[ai][m][3]); s += __shfl_xor(s, 16); s += __shfl_xor(s, 32); rs[ai][m] = __builtin_amdgcn_rsqf(s * (1.0f / 1024.0f) + 1e-6f); }
}
constexpr int RS_LDS_OFF = 131072, RS_LDS_MAXU = 12;
template <class Sched> __device__ __forceinline__ void stage_rs(PG8_LAS unsigned char* lds0, const Sched& S, const float* rsq, int tid, float mul) {
    PG8_LAS float* tab = (PG8_LAS float*)(lds0 + RS_LDS_OFF);
    Unit u;
    for (int i = 0; i < RS_LDS_MAXU && S.next(i, u); ++i) if (tid < 256) tab[i * 256 + tid] = rs_of(rsq, u.pm * BM + tid) * mul;
    asm volatile("s_waitcnt lgkmcnt(0)" ::: "memory"); __builtin_amdgcn_s_barrier(); asm volatile("" ::: "memory");
}
__device__ __forceinline__ void rs8_lds(PG8_LAS unsigned char* lds0, int ord, int wr, int fr, float (&rs)[2][4]) {
    const PG8_LAS float* tab = (const PG8_LAS float*)(lds0 + RS_LDS_OFF) + ord * 256 + wr * 64 + fr;
#pragma unroll
    for (int ai = 0; ai < 2; ++ai)
#pragma unroll
        for (int m = 0; m < 4; ++m) rs[ai][m] = tab[ai * HALF + m * 16];
}
__device__ __forceinline__ u32x4 pack8(const f32x4 v0, const f32x4 v1) { u32x4 w; w.x = cvt_pk_bf16(v0[0], v0[1]); w.y = cvt_pk_bf16(v0[2], v0[3]); w.z = cvt_pk_bf16(v1[0], v1[1]); w.w = cvt_pk_bf16(v1[2], v1[3]); return w; }
__device__ __forceinline__ void unpack8(const u32x4 w, f32x4& v0, f32x4& v1) { v0 = (f32x4){bf_lo(w.x), bf_hi(w.x), bf_lo(w.y), bf_hi(w.y)}; v1 = (f32x4){bf_lo(w.z), bf_hi(w.z), bf_lo(w.w), bf_hi(w.w)}; }
__device__ __forceinline__ float sq8(const f32x4 a, const f32x4 b) { return ((a[0] * a[0] + a[1] * a[1]) + (a[2] * a[2] + a[3] * a[3])) + ((b[0] * b[0] + b[1] * b[1]) + (b[2] * b[2] + b[3] * b[3])); }

typedef float f32x2_ __attribute__((ext_vector_type(2)));
__device__ __forceinline__ void unpack8_f8(const u32x2 w, f32x4& v0, f32x4& v1) {
    const f32x2_ a = __builtin_amdgcn_cvt_pk_f32_fp8((int)w.x, false), b = __builtin_amdgcn_cvt_pk_f32_fp8((int)w.x, true), c = __builtin_amdgcn_cvt_pk_f32_fp8((int)w.y, false), d = __builtin_amdgcn_cvt_pk_f32_fp8((int)w.y, true);
    v0 = (f32x4){a[0], a[1], b[0], b[1]}; v1 = (f32x4){c[0], c[1], d[0], d[1]};
}
constexpr float F8_WSCALE = 64.0f;
__device__ __forceinline__ unsigned pack4_fp8(float a, float b, float c, float d) { int p = __builtin_amdgcn_cvt_pk_fp8_f32(a, b, 0, false); p = __builtin_amdgcn_cvt_pk_fp8_f32(c, d, p, true); return (unsigned)p; }
template <bool HAS_RS, bool F8, bool F8OUT = F8> struct EpiSwiglu {
    static constexpr bool PERM = true, AFTER_DRAIN = false;
    bf16_t* O; PG8_LAS unsigned char* lds0;
    __device__ __forceinline__ void operator()(const f32x4 (&acc)[2][2][4][2], const Unit& u, int wr, int wc, int fr, int fq) const {
        const int row0 = u.pm * BM + wr * 64 + fr, oc = u.pn * 128 + wc * 32 + 8 * fq;
        float rs8[2][4]; if (HAS_RS) rs8_lds(lds0, u.ord, wr, fr, rs8);
#pragma unroll
        for (int ai = 0; ai < 2; ++ai)
#pragma unroll
            for (int m = 0; m < 4; ++m) {
                const int row = row0 + ai * HALF + m * 16;
                float rs = F8 ? (1.0f / F8_WSCALE) : 1.f; if (HAS_RS) rs *= rs8[ai][m];
                const float rsl = -1.4426950408889634f * rs, rs2 = rs * rs;
                f32x4 o0, o1;
#pragma unroll
                for (int j = 0; j < 4; ++j) {
                    const float A0 = acc[ai][0][m][0][j], A1 = acc[ai][0][m][1][j];
                    const float r0 = __builtin_amdgcn_rcpf(1.0f + __builtin_amdgcn_exp2f(A0 * rsl)), r1 = __builtin_amdgcn_rcpf(1.0f + __builtin_amdgcn_exp2f(A1 * rsl));
                    o0[j] = (A0 * acc[ai][1][m][0][j]) * (r0 * rs2); o1[j] = (A1 * acc[ai][1][m][1][j]) * (r1 * rs2);
                }
                if (F8OUT) { u32x2 w; w.x = pack4_fp8(o0[0], o0[1], o0[2], o0[3]); w.y = pack4_fp8(o1[0], o1[1], o1[2], o1[3]); *(u32x2*)((unsigned char*)O + (size_t)row * 2816 + oc) = w; }
                else *(u32x4*)(O + (size_t)row * 2816 + oc) = pack8(o0, o1);
            }
    }
};
template <bool SRC_F32, bool HALF_ALPHA, bool F8IN, bool F8COPY> struct EpiResid {
    static constexpr bool PERM = true, AFTER_DRAIN = false;
    const float* X; bf16_t* H; float* rsq_out; unsigned char* H8;
    __device__ __forceinline__ void operator()(const f32x4 (&acc)[2][2][4][2], const Unit& u, int wr, int wc, int fr, int fq) const {
        const int row0 = u.pm * BM + wr * 64 + fr, c0 = u.pn * BM + wc * 32 + 8 * fq;
        const float alpha = (HALF_ALPHA ? 0.5f : 1.0f) * (F8IN ? (1.0f / F8_WSCALE) : 1.0f);
#pragma unroll
        for (int ai = 0; ai < 2; ++ai) {
            u32x4 rb[4][2]; f32x4 rf[SRC_F32 ? 4 : 1][2][2];
            if (!SRC_F32) {
#pragma unroll
                for (int m = 0; m < 4; ++m)
#pragma unroll
                    for (int bj = 0; bj < 2; ++bj) rb[m][bj] = *(const u32x4*)(H + (size_t)(row0 + ai * HALF + m * 16) * 1024 + c0 + bj * HALF);
            }
#pragma unroll
            for (int mh = 0; mh < 2; ++mh) {
                if (SRC_F32) {
#pragma unroll
                    for (int m2 = 0; m2 < 2; ++m2)
#pragma unroll
                        for (int bj = 0; bj < 2; ++bj) { const float* xp = X + (size_t)(row0 + ai * HALF + (2 * mh + m2) * 16) * 1024 + c0 + bj * HALF; rf[2 * mh + m2][bj][0] = *(const f32x4*)xp; rf[2 * mh + m2][bj][1] = *(const f32x4*)(xp + 4); }
                }
#pragma unroll
                for (int m2 = 0; m2 < 2; ++m2) {
                    const int m = 2 * mh + m2, row = row0 + ai * HALF + m * 16; float sq = 0.f;
#pragma unroll
                    for (int bj = 0; bj < 2; ++bj) {
                        const size_t off = (size_t)row * 1024 + c0 + bj * HALF; f32x4 r0, r1;
                        if (SRC_F32) { r0 = rf[m][bj][0]; r1 = rf[m][bj][1]; } else unpack8(rb[m][bj], r0, r1);
                        const f32x4 v0 = r0 + alpha * acc[ai][bj][m][0], v1 = r1 + alpha * acc[ai][bj][m][1];
                        sq += sq8(v0, v1);
                        *(u32x4*)(H + off) = pack8(v0, v1);
                        if (F8COPY) { u32x2 w8; w8.x = pack4_fp8(v0[0], v0[1], v0[2], v0[3]); w8.y = pack4_fp8(v1[0], v1[1], v1[2], v1[3]); *(u32x2*)(H8 + off) = w8; }
                    }
                    sq += __shfl_xor(sq, 16); sq += __shfl_xor(sq, 32);
                    if (fq == 0) rsq_out[(size_t)row * 16 + u.pn * 4 + wc] = sq;
                }
                asm volatile("" ::: "memory");
            }
        }
    }
};
constexpr size_t PJ_MiB = 1u << 20, PJ_AQ = 336 * PJ_MiB, PJ_BQ = 368 * PJ_MiB, PJ_IQ = 400 * PJ_MiB, PJ_AK = 432 * PJ_MiB, PJ_AVT = 440 * PJ_MiB, PJ_BK = 448 * PJ_MiB, PJ_BV = 452 * PJ_MiB, PJ_IK = 456 * PJ_MiB, PJ_IW = 9 * PJ_MiB;
struct EpiProj {
    static constexpr bool PERM = true, AFTER_DRAIN = false;
    PG8_LAS unsigned char* lds0; unsigned char* wsb; bf16_t* SG;
    __device__ __forceinline__ void dest(int pn, int cw, bf16_t*& base, int& stride, int& col0, int& kind) const {
        kind = 0; base = SG; stride = 2048; col0 = 0;
        if (pn < 2) { base = (bf16_t*)(wsb + PJ_AQ); stride = 512; col0 = pn * 256 + cw; }
        else if (pn == 2) { if (cw < 128) { base = (bf16_t*)(wsb + PJ_AK); stride = 128; col0 = cw; } else { kind = 2; base = (bf16_t*)(wsb + PJ_AVT); col0 = cw - 128; } }
        else if (pn < 5) { base = (bf16_t*)(wsb + PJ_BQ); stride = 512; col0 = (pn - 3) * 256 + cw; }
        else if (pn == 5) { stride = 64;
            if (cw < 64) { base = (bf16_t*)(wsb + PJ_BK); col0 = cw; } else if (cw < 128) { base = (bf16_t*)(wsb + PJ_BV); col0 = cw - 64; } else if (cw < 192) { base = (bf16_t*)(wsb + PJ_IK); col0 = cw - 128; }
            else if (cw == 192) { kind = 3; base = (bf16_t*)(wsb + PJ_IW); } else kind = 4; }
        else if (pn < 8) { base = (bf16_t*)(wsb + PJ_IQ); stride = 512; col0 = (pn - 6) * 256 + cw; }
        else { kind = 1; col0 = (pn - 8) * 256 + cw; }
    }
    __device__ __forceinline__ void operator()(const f32x4 (&acc)[2][2][4][2], const Unit& u, int wr, int wc, int fr, int fq) const {
        const int row0 = u.pm * BM + wr * 64 + fr;
        bf16_t *base0, *base1; int st0, st1, c00, c01, k0, k1;
        dest(u.pn, wc * 32, base0, st0, c00, k0); dest(u.pn, HALF + wc * 32, base1, st1, c01, k1);
        float rs8[2][4]; rs8_lds(lds0, u.ord, wr, fr, rs8);
#pragma unroll
        for (int ai = 0; ai < 2; ++ai)
#pragma unroll
            for (int m = 0; m < 4; ++m) {
                const int row = row0 + ai * HALF + m * 16; const float rs = rs8[ai][m];
#pragma unroll
                for (int bj = 0; bj < 2; ++bj) {
                    bf16_t* base = bj ? base1 : base0; const int stride = bj ? st1 : st0, col0 = bj ? c01 : c00, kind = bj ? k1 : k0;
                    f32x4 v0 = acc[ai][bj][m][0] * rs, v1 = acc[ai][bj][m][1] * rs;
                    if (kind == 1) {
#pragma unroll
                        for (int j = 0; j < 4; ++j) { v0[j] = fsigmoid(v0[j]); v1[j] = fsigmoid(v1[j]); }
                    }
                    if (kind <= 1) { *(u32x4*)(base + (size_t)row * stride + col0 + 8 * fq) = pack8(v0, v1); }
                    else if (kind == 2) { const int i = col0 + 8 * fq, g = i >> 6, d = i & 63, b = row >> 13, t = row & 8191; bf16_t* p = base + ((size_t)((b * 2 + g) * 64 + d)) * 8192 + t; const u32x4 w = pack8(v0, v1);
                        p[0] = (bf16_t)(w.x & 0xffffu); p[8192] = (bf16_t)(w.x >> 16); p[2 * 8192] = (bf16_t)(w.y & 0xffffu); p[3 * 8192] = (bf16_t)(w.y >> 16);
                        p[4 * 8192] = (bf16_t)(w.z & 0xffffu); p[5 * 8192] = (bf16_t)(w.z >> 16); p[6 * 8192] = (bf16_t)(w.w & 0xffffu); p[7 * 8192] = (bf16_t)(w.w >> 16); }
                    else if (kind == 3) { if (fq == 0) { float* iw = (float*)base + (size_t)row * 8; *(f32x4*)iw = v0; *(f32x4*)(iw + 4) = v1; } }
                }
                asm volatile("" ::: "memory");
            }
    }
};
struct EpiSig {
    static constexpr bool PERM = true, AFTER_DRAIN = false;
    PG8_LAS unsigned char* lds0; bf16_t* SG;
    __device__ __forceinline__ void operator()(const f32x4 (&acc)[2][2][4][2], const Unit& u, int wr, int wc, int fr, int fq) const {
        const int row0 = u.pm * BM + wr * 64 + fr, c0 = u.pn * BM + wc * 32 + 8 * fq;
        float rs8[2][4]; rs8_lds(lds0, u.ord, wr, fr, rs8);
#pragma unroll
        for (int ai = 0; ai < 2; ++ai)
#pragma unroll
            for (int m = 0; m < 4; ++m) {
                const int row = row0 + ai * HALF + m * 16; const float rs = rs8[ai][m] * (1.0f / F8_WSCALE);
#pragma unroll
                for (int bj = 0; bj < 2; ++bj) {
                    f32x4 v0 = acc[ai][bj][m][0] * rs, v1 = acc[ai][bj][m][1] * rs;
#pragma unroll
                    for (int j = 0; j < 4; ++j) { v0[j] = fsigmoid(v0[j]); v1[j] = fsigmoid(v1[j]); }
                    { u32x2 w8; w8.x = pack4_fp8(v0[0], v0[1], v0[2], v0[3]); w8.y = pack4_fp8(v1[0], v1[1], v1[2], v1[3]); *(u32x2*)((unsigned char*)SG + (size_t)row * 2048 + c0 + bj * HALF) = w8; }
                }
            }
    }
};
template <int MODE, bool F8OUT = false, bool F8IN = false> struct EpiGate {
    static constexpr bool PERM = true, AFTER_DRAIN = false;
    bf16_t* O; const bf16_t* G; int gofs; const bf16_t* P;
    __device__ __forceinline__ void operator()(const f32x4 (&acc)[2][2][4][2], const Unit& u, int wr, int wc, int fr, int fq) const {
        const int row0 = u.pm * BM + wr * 64 + fr, c0 = u.pn * BM + wc * 32 + 8 * fq;
#pragma unroll
        for (int ai = 0; ai < 2; ++ai) {
            u32x2 gv[4][2], pv[4][2];
            if (MODE >= 1) {
#pragma unroll
                for (int m = 0; m < 4; ++m)
#pragma unroll
                    for (int bj = 0; bj < 2; ++bj) gv[m][bj] = *(const u32x2*)((const unsigned char*)G + (size_t)(row0 + ai * HALF + m * 16) * 2048 + gofs + c0 + bj * HALF);
            }
            if (MODE == 2) {
#pragma unroll
                for (int m = 0; m < 4; ++m)
#pragma unroll
                    for (int bj = 0; bj < 2; ++bj) pv[m][bj] = *(const u32x2*)((const unsigned char*)P + (size_t)(row0 + ai * HALF + m * 16) * 1024 + c0 + bj * HALF);
            }
#pragma unroll
            for (int m = 0; m < 4; ++m) {
                const int row = row0 + ai * HALF + m * 16;
#pragma unroll
                for (int bj = 0; bj < 2; ++bj) {
                    const int col = c0 + bj * HALF; f32x4 v0 = acc[ai][bj][m][0], v1 = acc[ai][bj][m][1];
                    if (F8IN) { v0 = v0 * (1.0f / F8_WSCALE); v1 = v1 * (1.0f / F8_WSCALE); }
                    if (MODE >= 1) { f32x4 g0, g1; unpack8_f8(gv[m][bj], g0, g1); v0 = v0 * g0; v1 = v1 * g1; }
                    if (MODE == 2) { f32x4 p0, p1; unpack8_f8(pv[m][bj], p0, p1); v0 = v0 + p0; v1 = v1 + p1; }
                    if (F8OUT) { u32x2 w8; w8.x = pack4_fp8(v0[0], v0[1], v0[2], v0[3]); w8.y = pack4_fp8(v1[0], v1[1], v1[2], v1[3]); *(u32x2*)((unsigned char*)O + (size_t)row * 1024 + col) = w8; }
                    else *(u32x4*)(O + (size_t)row * 1024 + col) = pack8(v0, v1);
                }
            }
            asm volatile("" ::: "memory");
        }
    }
};
template <bool F8IN> struct EpiPle {
    static constexpr bool PERM = true, AFTER_DRAIN = false;
    PG8_LAS unsigned char* lds0; const bf16_t* H; const bf16_t* PP; float* out; float* rsq_out; unsigned* cnt; const float* gfin;
    __device__ __forceinline__ void operator()(f32x4 (&acc)[2][2][4][2], const Unit& u, int wr, int wc, int fr, int fq) const {
        const int row0 = u.pm * BM + wr * 64 + fr, c0 = u.pn * BM + wc * 32 + 8 * fq;
        float rs8[2][4]; rs8_lds(lds0, u.ord, wr, fr, rs8);
#pragma unroll
        for (int aim = 0; aim < 4; ++aim) {
            const int ai = aim >> 1;
            u32x4 hv[2][2]; u32x2 qv[2][2];
#pragma unroll
            for (int m2 = 0; m2 < 2; ++m2)
#pragma unroll
                for (int bj = 0; bj < 2; ++bj) { const size_t off = (size_t)(row0 + ai * HALF + (2 * (aim & 1) + m2) * 16) * 1024 + c0 + bj * HALF; hv[m2][bj] = *(const u32x4*)(H + off); qv[m2][bj] = *(const u32x2*)((const unsigned char*)PP + off); }
#pragma unroll
            for (int m2 = 0; m2 < 2; ++m2) {
                const int m = 2 * (aim & 1) + m2;
                const int row = row0 + ai * HALF + m * 16; const float rs = rs8[ai][m] * (F8IN ? (1.0f / F8_WSCALE) : 1.0f); float sq = 0.f;
#pragma unroll
                for (int bj = 0; bj < 2; ++bj) {
                    f32x4 h0, h1, p0, p1; unpack8(hv[m2][bj], h0, h1); unpack8_f8(qv[m2][bj], p0, p1);
                    f32x4 v0 = acc[ai][bj][m][0] * rs, v1 = acc[ai][bj][m][1] * rs;
#pragma unroll
                    for (int j = 0; j < 4; ++j) { v0[j] = h0[j] + fsigmoid(v0[j]) * p0[j]; v1[j] = h1[j] + fsigmoid(v1[j]) * p1[j]; }
                    sq += sq8(v0, v1);
                    acc[ai][bj][m][0] = v0; acc[ai][bj][m][1] = v1;
                }
                sq += __shfl_xor(sq, 16); sq += __shfl_xor(sq, 32);
                if (fq == 0) __hip_atomic_store((unsigned*)(rsq_out + (size_t)row * 16 + u.pn * 4 + wc), __float_as_uint(sq), __ATOMIC_RELAXED, __HIP_MEMORY_SCOPE_AGENT);
            }
            asm volatile("" ::: "memory");
        }
        asm volatile("s_waitcnt vmcnt(0)" ::: "memory");
        unsigned* pc = cnt + 64 * u.pm;
        if ((fr | fq) == 0) __hip_atomic_fetch_add(pc, 1u, __ATOMIC_RELAXED, __HIP_MEMORY_SCOPE_AGENT);
        { unsigned spins = 0;
          while ((unsigned)__builtin_amdgcn_readfirstlane(__hip_atomic_load(pc, __ATOMIC_RELAXED, __HIP_MEMORY_SCOPE_AGENT)) < 32u) { __builtin_amdgcn_s_sleep(2); if (++spins > (1u << 22)) break; } }
        __builtin_amdgcn_fence(__ATOMIC_ACQUIRE, "agent");
        asm volatile("s_waitcnt vmcnt(0)" ::: "memory");
        f32x4 g00 = *(const f32x4*)(gfin + c0), g01 = *(const f32x4*)(gfin + c0 + 4), g10 = *(const f32x4*)(gfin + c0 + HALF), g11 = *(const f32x4*)(gfin + c0 + HALF + 4);
        float rf8[2][4]; rs8_of(rsq_out, row0, fq, rf8);
#pragma unroll
        for (int ai = 0; ai < 2; ++ai)
#pragma unroll
            for (int m = 0; m < 4; ++m) {
                const int row = row0 + ai * HALF + m * 16; const float rs = rf8[ai][m];
                const size_t off = (size_t)row * 1024 + c0;
                *(f32x4*)(out + off) = acc[ai][0][m][0] * rs * g00; *(f32x4*)(out + off + 4) = acc[ai][0][m][1] * rs * g01;
                *(f32x4*)(out + off + HALF) = acc[ai][1][m][0] * rs * g10; *(f32x4*)(out + off + HALF + 4) = acc[ai][1][m][1] * rs * g11;
                asm volatile("" ::: "memory");
            }
    }
};

template <class Epi, class Sched, bool ALIGN_EPI = false, bool SP2 = false, bool F8 = false>
__device__ __forceinline__ void gemm_phase(PG8_LAS unsigned char* lds, const Gemm g, const Sched& S, const Epi& E, int wid_s) {
    int lane_o; asm volatile("v_mbcnt_lo_u32_b32 %0, -1, 0\n\tv_mbcnt_hi_u32_b32 %0, -1, %0" : "=v"(lane_o)); const int tid = wid_s * 64 + lane_o;
    const int wid = __builtin_amdgcn_readfirstlane(tid >> 6), lane = tid & 63, wr = wid >> 2, wc = wid & 3, fr = lane & 15, fq = lane >> 4;
    int f8scale_ = 0x7f7f7f7f; if constexpr (F8) asm volatile("" : "+v"(f8scale_));     (void)f8scale_;
    const int K = g.K, nt = K / BK;
    unsigned voffA[2], voffB[2];
#pragma unroll
    for (int i = 0; i < 2; ++i) { int R, C; stage_rc(tid * 16 + i * 8192, R, C); const int Rb = Epi::PERM ? ((R & ~31) + perm32(R & 31)) : R;
        voffA[i] = (unsigned)(R * K + C) * 2u; voffB[i] = (unsigned)(Rb * K + C) * 2u; }
    const size_t kstep = (size_t)(BK * 2);
    const size_t hstep = (size_t)HALF * K * 2;
    const size_t tstep = 2 * hstep;
    const unsigned ldsw = (unsigned)wid * 1024u;
    const int aoff = lds_byte(wr * 64 + fr, fq * 8), boff = lds_byte(wc * 32 + fr, fq * 8);
#define PG8_SA(b, h) (((b) * 2 + (h)) * HTB)
#define PG8_SB(b, h) ((4 + (b) * 2 + (h)) * HTB)
#define PG8_STAGE(bufoff, gbase, voff) do { _Pragma("unroll") for (int _i = 0; _i < 2; ++_i) \
        __builtin_amdgcn_global_load_lds((const unsigned*)((const char*)(gbase) + (voff)[_i]), (PG8_LAS unsigned*)(lds + (bufoff) + ldsw + _i * 8192), 16, 0, 0); } while (0)
#define PG8_LDA(dst, b, h) do { _Pragma("unroll") for (int m = 0; m < 4; ++m) _Pragma("unroll") for (int k = 0; k < 2; ++k) dst[m][k] = *(const PG8_LAS bf16x8*)(lds + PG8_SA(b, h) + aoff + m * 2048 + k * 1024); } while (0)
#define PG8_LDB(dst, b, h) do { _Pragma("unroll") for (int n = 0; n < 2; ++n) _Pragma("unroll") for (int k = 0; k < 2; ++k) dst[n][k] = *(const PG8_LAS bf16x8*)(lds + PG8_SB(b, h) + boff + n * 2048 + k * 1024); } while (0)
#define PG8_MMA(ai, bj, At, Bt) do { __builtin_amdgcn_s_setprio(1); \
        if constexpr (F8) { typedef int v8i_ __attribute__((ext_vector_type(8))); typedef int v4i_ __attribute__((ext_vector_type(4))); \
            _Pragma("unroll") for (int m = 0; m < 4; ++m) _Pragma("unroll") for (int n = 0; n < 2; ++n) { \
                const v4i_ b0_ = __builtin_bit_cast(v4i_, Bt[n][0]), b1_ = __builtin_bit_cast(v4i_, Bt[n][1]), a0_ = __builtin_bit_cast(v4i_, At[m][0]), a1_ = __builtin_bit_cast(v4i_, At[m][1]); \
                const v8i_ bb_ = {b0_[0], b0_[1], b0_[2], b0_[3], b1_[0], b1_[1], b1_[2], b1_[3]}, aa_ = {a0_[0], a0_[1], a0_[2], a0_[3], a1_[0], a1_[1], a1_[2], a1_[3]}; \
                asm volatile("v_mfma_scale_f32_16x16x128_f8f6f4 %0, %1, %2, %0, %3, %3 op_sel_hi:[0,0,0]" : "+v"(acc[ai][bj][m][n]) : "v"(bb_), "v"(aa_), "v"(f8scale_)); } } \
        else { _Pragma("unroll") for (int m = 0; m < 4; ++m) _Pragma("unroll") for (int n = 0; n < 2; ++n) _Pragma("unroll") for (int k = 0; k < 2; ++k) \
            acc[ai][bj][m][n] = __builtin_amdgcn_mfma_f32_16x16x32_bf16(Bt[n][k], At[m][k], acc[ai][bj][m][n], 0, 0, 0); } \
        __builtin_amdgcn_s_setprio(0); } while (0)
#define PG8_WAIT_V(n) asm volatile("s_waitcnt vmcnt(" #n ")" ::: "memory")
#define PG8_WAIT_L(n) asm volatile("s_waitcnt lgkmcnt(" #n ")" ::: "memory")
#define PG8_BAR __builtin_amdgcn_s_barrier()
#define PG8_SCHED __builtin_amdgcn_sched_barrier(0)
    Unit cur, nxt; int ui = 0;
    if (!S.next(0, cur)) return;
    cur.ord = 0;
    f32x4 acc[2][2][4][2];
#pragma unroll
    for (int a = 0; a < 2; ++a)
#pragma unroll
        for (int b = 0; b < 2; ++b)
#pragma unroll
            for (int m = 0; m < 4; ++m)
#pragma unroll
                for (int n = 0; n < 2; ++n) acc[a][b][m][n] = (f32x4){0.f, 0.f, 0.f, 0.f};
    bf16x8 At[4][2], B0[2][2], B1[2][2];
    const char* cA = (const char*)g.A + (size_t)cur.pm * tstep; const char* cB = (const char*)g.Bt + (size_t)cur.pn * tstep;
    S.a_ready(cur);
    if constexpr (SP2) {
        PG8_STAGE(PG8_SB(0, 0), cB, voffB); PG8_STAGE(PG8_SB(0, 1), cB + hstep, voffB); PG8_STAGE(PG8_SA(0, 0), cA, voffA); PG8_STAGE(PG8_SA(0, 1), cA + hstep, voffA);
        if (wr == 1) PG8_BAR;
        PG8_WAIT_V(2); PG8_BAR;
        PG8_STAGE(PG8_SB(1, 0), cB + kstep, voffB); PG8_STAGE(PG8_SA(1, 0), cA + kstep, voffA); PG8_STAGE(PG8_SB(1, 1), cB + hstep + kstep, voffB);
        PG8_WAIT_V(6); PG8_BAR;
    } else {
        PG8_STAGE(PG8_SB(0, 0), cB, voffB); PG8_STAGE(PG8_SA(0, 0), cA, voffA); PG8_STAGE(PG8_SB(0, 1), cB + hstep, voffB); PG8_STAGE(PG8_SA(0, 1), cA + hstep, voffA);
        if (wr == 1) PG8_BAR;
        PG8_WAIT_V(4); PG8_BAR;
        PG8_STAGE(PG8_SB(1, 0), cB + kstep, voffB); PG8_STAGE(PG8_SA(1, 0), cA + kstep, voffA); PG8_STAGE(PG8_SB(1, 1), cB + hstep + kstep, voffB);
        PG8_WAIT_V(6); PG8_BAR;
    }
    for (;;) {
        const bool has_next = S.next(ui + 1, nxt); nxt.ord = ui + 1;
        const char* nA = has_next ? (const char*)g.A + (size_t)nxt.pm * tstep : cA; const char* nB = has_next ? (const char*)g.Bt + (size_t)nxt.pn * tstep : cB;
        for (int t = 0; t < nt; t += 2) {
            const bool last = (t == nt - 2);
            const char* a1 = cA + (size_t)(t + 1) * kstep;
            const char* a2 = last ? nA : cA + (size_t)(t + 2) * kstep; const char* b2 = last ? nB : cB + (size_t)(t + 2) * kstep;
            const char* a3 = a2 + kstep; const char* b3 = b2 + kstep;
            if (last && has_next) S.a_ready(nxt);
            if constexpr (SP2) {
            PG8_LDB(B0, 0, 0); PG8_LDB(B1, 0, 1); PG8_SCHED; PG8_LDA(At, 0, 0); PG8_STAGE(PG8_SA(1, 1), a1 + hstep, voffA);
            PG8_WAIT_V(8); PG8_WAIT_L(0); PG8_BAR; PG8_MMA(0, 0, At, B0); PG8_MMA(0, 1, At, B1); PG8_BAR; PG8_SCHED;
            PG8_LDA(At, 0, 1); PG8_STAGE(PG8_SB(0, 0), b2, voffB); PG8_STAGE(PG8_SB(0, 1), b2 + hstep, voffB); PG8_STAGE(PG8_SA(0, 0), a2, voffA);
            PG8_WAIT_V(8); PG8_WAIT_L(0); PG8_BAR; PG8_MMA(1, 0, At, B0); PG8_MMA(1, 1, At, B1); PG8_BAR; PG8_SCHED;
            PG8_LDB(B0, 1, 0); PG8_LDB(B1, 1, 1); PG8_SCHED; PG8_LDA(At, 1, 0); PG8_STAGE(PG8_SA(0, 1), a2 + hstep, voffA);
            PG8_WAIT_V(8); PG8_WAIT_L(0); PG8_BAR; PG8_MMA(0, 0, At, B0); PG8_MMA(0, 1, At, B1); PG8_BAR; PG8_SCHED;
            PG8_LDA(At, 1, 1); PG8_STAGE(PG8_SB(1, 0), b3, voffB); PG8_STAGE(PG8_SB(1, 1), b3 + hstep, voffB); PG8_STAGE(PG8_SA(1, 0), a3, voffA);
            PG8_WAIT_V(8); PG8_WAIT_L(0); PG8_BAR; PG8_MMA(1, 0, At, B0); PG8_MMA(1, 1, At, B1); PG8_BAR; PG8_SCHED;
            } else {
            PG8_LDB(B0, 0, 0); PG8_SCHED; PG8_LDA(At, 0, 0); PG8_STAGE(PG8_SA(1, 1), a1 + hstep, voffA);
            PG8_WAIT_L(8); PG8_BAR; PG8_WAIT_L(0); PG8_MMA(0, 0, At, B0); PG8_BAR; PG8_SCHED;
            PG8_LDB(B1, 0, 1); PG8_STAGE(PG8_SB(0, 0), b2, voffB);
            PG8_BAR; PG8_WAIT_L(0); PG8_MMA(0, 1, At, B1); PG8_BAR;
            PG8_LDA(At, 0, 1); PG8_STAGE(PG8_SA(0, 0), a2, voffA);
            PG8_BAR; PG8_WAIT_L(0); PG8_MMA(1, 0, At, B0); PG8_BAR; PG8_SCHED;
            PG8_STAGE(PG8_SB(0, 1), b2 + hstep, voffB);
            PG8_WAIT_V(6); PG8_BAR; PG8_MMA(1, 1, At, B1); PG8_BAR;
            PG8_LDB(B0, 1, 0); PG8_SCHED; PG8_LDA(At, 1, 0); PG8_STAGE(PG8_SA(0, 1), a2 + hstep, voffA);
            PG8_WAIT_L(8); PG8_BAR; PG8_WAIT_L(0); PG8_MMA(0, 0, At, B0); PG8_BAR; PG8_SCHED;
            PG8_LDB(B1, 1, 1); PG8_STAGE(PG8_SB(1, 0), b3, voffB);
            PG8_BAR; PG8_WAIT_L(0); PG8_MMA(0, 1, At, B1); PG8_BAR;
            PG8_LDA(At, 1, 1); PG8_STAGE(PG8_SA(1, 0), a3, voffA);
            PG8_BAR; PG8_WAIT_L(0); PG8_MMA(1, 0, At, B0); PG8_BAR; PG8_SCHED;
            PG8_STAGE(PG8_SB(1, 1), b3 + hstep, voffB);
            PG8_WAIT_V(6); PG8_BAR; PG8_MMA(1, 1, At, B1); PG8_BAR;
            }
        }
        if constexpr (F8) asm volatile("s_nop 15\n\ts_nop 15" ::: "memory");
        if constexpr (ALIGN_EPI) { if (wr == 0) PG8_BAR; }
        if constexpr (!Epi::AFTER_DRAIN) { E(acc, cur, wr, wc, fr, fq); S.done(cur); }
        if (!has_next) break;
#pragma unroll
        for (int a = 0; a < 2; ++a)
#pragma unroll
            for (int b = 0; b < 2; ++b)
#pragma unroll
                for (int m = 0; m < 4; ++m)
#pragma unroll
                    for (int n = 0; n < 2; ++n) acc[a][b][m][n] = (f32x4){0.f, 0.f, 0.f, 0.f};
        cur = nxt; cA = nA; cB = nB; ++ui;
        if constexpr (ALIGN_EPI) { if (wr == 1) PG8_BAR; }
    }
    PG8_WAIT_V(0);
    if constexpr (!ALIGN_EPI) { if (wr == 0) PG8_BAR; }
    PG8_BAR;
    if constexpr (Epi::AFTER_DRAIN) { E.fused(acc, cur, wr, wc, fr, fq, lds, wid, lane); S.done(cur); }
#undef PG8_SA
#undef PG8_SB
#undef PG8_STAGE
#undef PG8_LDA
#undef PG8_LDB
#undef PG8_MMA
#undef PG8_WAIT_V
#undef PG8_WAIT_L
#undef PG8_BAR
#undef PG8_SCHED
}
}

#define GAS __attribute__((address_space(1)))
#define LAS __attribute__((address_space(3)))
typedef unsigned short bf16;
typedef unsigned v4u __attribute__((ext_vector_type(4)));
typedef float f32x4 __attribute__((ext_vector_type(4)));
typedef short bf16x8 __attribute__((ext_vector_type(8)));
typedef GAS unsigned gu32;
typedef GAS unsigned long long gu64;
#define RLX_AGENT __ATOMIC_RELAXED, __HIP_MEMORY_SCOPE_AGENT

#define XB_TMO      128
#define XB_XCNT(j)  (256  + 64 * (j))
#define XB_XSUB(j)  (1280 + 64 * (j))
#define XB_XGEN(j)  (2304 + 64 * (j))
#define XB_TOP      3328
#define XB_TOPGEN   3392
#define XCD_BAR_WORDS 3456
#define XB_SPIN_CAP (1u << 18)

__device__ __forceinline__ unsigned xb_ld(unsigned* p)              { return __hip_atomic_load(p, __ATOMIC_RELAXED, __HIP_MEMORY_SCOPE_AGENT); }
__device__ __forceinline__ unsigned xb_add(unsigned* p, unsigned v) { return __hip_atomic_fetch_add(p, v, __ATOMIC_RELAXED, __HIP_MEMORY_SCOPE_AGENT); }
__device__ __forceinline__ unsigned xb_xcc_id() { return (unsigned)__builtin_amdgcn_s_getreg((3 << 11) | 20) & 0xFu; }
#define XB_SPIN(cond, bar) do { unsigned _sp = 0; while (cond) { __builtin_amdgcn_s_sleep(1); \
    if ((++_sp & 255u) == 0u) { if (xb_ld(&(bar)[XB_TMO])) break; if (_sp > XB_SPIN_CAP) { atomicAdd(&(bar)[XB_TMO], 1u); break; } } } } while (0)

struct XcdBarrier {
    unsigned* bar; unsigned x;
    volatile LAS unsigned* st;
};

__device__ __forceinline__ XcdBarrier xcd_barrier_post(unsigned* bar, volatile LAS unsigned* st) {
    XcdBarrier b; b.bar = bar; b.x = xb_xcc_id(); b.st = st;
    if (threadIdx.x == 0) (void)xb_add(&bar[XB_XCNT(b.x)], 1u);
    return b;
}
__device__ __forceinline__ void xcd_barrier_complete(unsigned* bar, unsigned x, unsigned& nloc, unsigned& nx) {
    const unsigned G = gridDim.x * gridDim.y * gridDim.z;
    unsigned sum, cnt, mine, sp = 0u;
    for (;;) {
        sum = 0u; cnt = 0u; mine = 0u;
#pragma unroll
        for (unsigned j = 0; j < 16; ++j) { const unsigned c = xb_ld(&bar[XB_XCNT(j)]); sum += c; cnt += (c > 0u) ? 1u : 0u; mine = (j == x) ? c : mine; }
        if (sum == G) break;
        __builtin_amdgcn_s_sleep(1);
        if ((++sp & 255u) == 0u) { if (xb_ld(&bar[XB_TMO])) break; if (sp > XB_SPIN_CAP) { atomicAdd(&bar[XB_TMO], 1u); break; } }
    }
    nloc = mine > 0u ? mine : 1u; nx = cnt > 0u ? cnt : 1u;
}

__device__ __forceinline__ void xcd_barrier(const XcdBarrier& b) {
    asm volatile("s_waitcnt vmcnt(0)" ::: "memory");
    __syncthreads();
    if (threadIdx.x == 0) {
        unsigned* bar = b.bar;
        __builtin_amdgcn_s_waitcnt(0);
        unsigned nloc = b.st[0], nx = b.st[1];
        if (nloc == 0u) { xcd_barrier_complete(bar, b.x, nloc, nx); b.st[0] = nloc; b.st[1] = nx; }
        const unsigned old = xb_add(&bar[XB_XSUB(b.x)], 1u);
        const unsigned gen = old / nloc;
        if (old + 1u == (gen + 1u) * nloc) {
            __builtin_amdgcn_fence(__ATOMIC_RELEASE, "agent");
            asm volatile("s_waitcnt vmcnt(0)" ::: "memory");
            const unsigned og = xb_add(&bar[XB_TOP], 1u);
            const unsigned tg = og / nx;
            if (og + 1u == (tg + 1u) * nx) xb_add(&bar[XB_TOPGEN], 1u);
            else XB_SPIN(xb_ld(&bar[XB_TOPGEN]) == tg, bar);
            __builtin_amdgcn_fence(__ATOMIC_ACQUIRE, "agent");
            xb_add(&bar[XB_XGEN(b.x)], 1u);
            asm volatile("s_waitcnt vmcnt(0)" ::: "memory");
        } else {
            XB_SPIN(xb_ld(&bar[XB_XGEN(b.x)]) == gen, bar);
            __builtin_amdgcn_fence(__ATOMIC_ACQUIRE, "agent");
            asm volatile("s_waitcnt vmcnt(0)" ::: "memory");
        }
    }
    __syncthreads();
}

constexpr int BATCH = 4, T = 8192, D = 1024, M = BATCH * T, FF = 2816, DPLE = 256, DIN = 4040;
constexpr int NWAVES = 8;
constexpr size_t MiB = 1u << 20;
constexpr size_t WS_CTL = 0, CTL_ZERO_BYTES = 1 * MiB;
constexpr size_t WS_RSQ1 = 1 * MiB, WS_RSQ2 = 3 * MiB, WS_RSQ3 = 5 * MiB, WS_RSQ4 = 7 * MiB, WS_IW = 9 * MiB;
constexpr size_t WS_W1 = 10 * MiB, WS_W2 = 21 * MiB, WS_WIN = 27 * MiB, WS_WA = 35 * MiB, WS_WB = 36 * MiB, WS_WO = 37 * MiB, WS_W3 = 39 * MiB, WS_W4 = 50 * MiB, WS_WG = 56 * MiB, WS_WP = 58 * MiB;
constexpr size_t WS_HB = 64 * MiB, WS_ACT = 128 * MiB, WS_TA = WS_ACT, WS_MIX = 368 * MiB  , WS_PP = 400 * MiB  ;
constexpr size_t WS_X8 = 304 * MiB, WS_SEL = WS_X8, WS_AQ = 336 * MiB, WS_BQ = 368 * MiB, WS_IQ = 400 * MiB, WS_AK = 432 * MiB, WS_AVT = 440 * MiB, WS_BK = 448 * MiB, WS_BV = 452 * MiB, WS_IK = 456 * MiB, WS_PB = 460 * MiB, WS_YA8 = 476 * MiB, WS_YB8 = 492 * MiB, WS_END = 508 * MiB;
constexpr int CW_BAR = 4096;
static_assert(pg8::PJ_AQ == WS_AQ && pg8::PJ_BQ == WS_BQ && pg8::PJ_IQ == WS_IQ && pg8::PJ_AK == WS_AK && pg8::PJ_AVT == WS_AVT && pg8::PJ_BK == WS_BK && pg8::PJ_BV == WS_BV && pg8::PJ_IK == WS_IK && pg8::PJ_IW == WS_IW, "EpiProj offsets");
constexpr int RING_OFF = 0, RING_BYTES = 131072;
constexpr int LDSCTL_OFF = 159744, MISC_OFF = LDSCTL_OFF + 320;
constexpr int LDS_BYTES = 160256;

#define LDS_WAIT() asm volatile("s_waitcnt lgkmcnt(0)" ::: "memory")
#define VM_WAIT() asm volatile("s_waitcnt vmcnt(0)" ::: "memory")
__device__ __forceinline__ unsigned f2bf(float f) { unsigned u = __builtin_bit_cast(unsigned, f); return (u + 0x7fffu + ((u >> 16) & 1u)) >> 16; }
__device__ __forceinline__ unsigned pk2(float lo, float hi) { return f2bf(lo) | (f2bf(hi) << 16); }
__device__ __forceinline__ float wave_sum(float v) {
#pragma unroll
    for (int o = 1; o < 64; o <<= 1) v += __shfl_xor(v, o);
    return v;
}

struct MapId { __device__ __forceinline__ void operator()(int n, int& sc, float& cs) const { sc = n; cs = 1.f; } };
struct MapFfnIn { __device__ __forceinline__ void operator()(int n, int& sc, float& cs) const { const int pn = n >> 8, bj = (n >> 7) & 1, i = n & 127; sc = bj * FF + 128 * pn + i; cs = 1.f; } };
struct MapWin { __device__ __forceinline__ void operator()(int n, int& sc, float& cs) const {
    const float CQ = 0.125f * 1.4426950408889634f; cs = 1.f;
    if (n < 1280) { sc = n; if (n < 512 || n >= 768) cs = CQ; }
    else if (n < 1536) { const int i = n - 1280; if (i < 128) sc = 1280 + i; else if (i < 192) sc = 1920 + (i - 128); else if (i < 200) { sc = 1984 + (i - 192); cs = 0.35355339059327373f; } else sc = -1; }
    else if (n < 2048) { sc = 1408 + (n - 1536); cs = 0.125f; }
    else if (n < 3072) sc = 1992 + (n - 2048);
    else sc = 3016 + (n - 3072);
} };
struct MapGate { __device__ __forceinline__ void operator()(int n, int& sc, float& cs) const { sc = 1992 + n; cs = 1.f; } };
template <class MAP>
__device__ __forceinline__ void tr_item(const float* W, int Nsrc, int K, bf16* WT, const float* gain, LAS float* scr, int item, int nblk, int lane, MAP map) {
    const int kb = item / nblk, nb = item % nblk, k0 = 64 * kb, n0 = 32 * nb;
    int sc; float cs; map(n0 + (lane & 7) * 4, sc, cs);
    {
        f32x4 ld[8];
#pragma unroll
        for (int i = 0; i < 8; ++i) { const int kk = 8 * i + (lane >> 3); ld[i] = (f32x4){0.f, 0.f, 0.f, 0.f}; if (sc >= 0) ld[i] = *(const GAS f32x4*)(W + (size_t)(k0 + kk) * Nsrc + sc); }
#pragma unroll
        for (int i = 0; i < 8; ++i) { const int kk = 8 * i + (lane >> 3); float gk = cs; if (gain) gk *= gain[k0 + kk]; LAS float* d = scr + kk * 33 + (lane & 7) * 4; d[0] = ld[i][0] * gk; d[1] = ld[i][1] * gk; d[2] = ld[i][2] * gk; d[3] = ld[i][3] * gk; }
    }
    LDS_WAIT(); asm volatile("" ::: "memory");
    const int c = lane & 7;
#pragma unroll
    for (int j = 0; j < 4; ++j) { const int n = (lane >> 3) + 8 * j; const LAS float* s = scr + (8 * c) * 33 + n;
        v4u o; o.x = pk2(s[0 * 33], s[1 * 33]); o.y = pk2(s[2 * 33], s[3 * 33]); o.z = pk2(s[4 * 33], s[5 * 33]); o.w = pk2(s[6 * 33], s[7 * 33]);
        *(GAS v4u*)(WT + (size_t)(n0 + n) * K + k0 + 8 * c) = o; }
    LDS_WAIT(); asm volatile("" ::: "memory");
}

template <class MAP>
__device__ __forceinline__ void tr_item8(const float* W, int Nsrc, int K, unsigned char* WT, const float* gain, LAS float* scr, int item, int nblk, int lane, MAP map, float scale) {
    const int kb = item / nblk, nb = item % nblk, k0 = 64 * kb, n0 = 32 * nb;
    int sc; float cs; map(n0 + (lane & 7) * 4, sc, cs); cs *= scale;
    {
        f32x4 ld[8];
#pragma unroll
        for (int i = 0; i < 8; ++i) { const int kk = 8 * i + (lane >> 3); ld[i] = (f32x4){0.f, 0.f, 0.f, 0.f}; if (sc >= 0) ld[i] = *(const GAS f32x4*)(W + (size_t)(k0 + kk) * Nsrc + sc); }
#pragma unroll
        for (int i = 0; i < 8; ++i) { const int kk = 8 * i + (lane >> 3); float gk = cs; if (gain) gk *= gain[k0 + kk]; LAS float* d = scr + kk * 33 + (lane & 7) * 4; d[0] = ld[i][0] * gk; d[1] = ld[i][1] * gk; d[2] = ld[i][2] * gk; d[3] = ld[i][3] * gk; }
    }
    LDS_WAIT(); asm volatile("" ::: "memory");
    const int c = lane & 3;
#pragma unroll
    for (int j = 0; j < 2; ++j) { const int n = (lane >> 2) + 16 * j; const LAS float* s = scr + (16 * c) * 33 + n;
        v4u o; o.x = pg8::pack4_fp8(s[0 * 33], s[1 * 33], s[2 * 33], s[3 * 33]); o.y = pg8::pack4_fp8(s[4 * 33], s[5 * 33], s[6 * 33], s[7 * 33]);
        o.z = pg8::pack4_fp8(s[8 * 33], s[9 * 33], s[10 * 33], s[11 * 33]); o.w = pg8::pack4_fp8(s[12 * 33], s[13 * 33], s[14 * 33], s[15 * 33]);
        *(GAS v4u*)(WT + (size_t)(n0 + n) * K + k0 + 16 * c) = o; }
    LDS_WAIT(); asm volatile("" ::: "memory");
}

__device__ __forceinline__ void tr_generic(const float* W, int Nsrc, int K, unsigned char* dst, const float* gain, int mapid, int f8, LAS float* scr, int item, int nblk, int lane) {
    const int kb = item / nblk, nb = item % nblk, k0 = 64 * kb, n0 = 32 * nb;
    int sc; float cs; { const int n = n0 + (lane & 7) * 4;
        if (mapid == 0) MapId()(n, sc, cs); else if (mapid == 1) MapFfnIn()(n, sc, cs); else if (mapid == 2) MapWin()(n, sc, cs); else MapGate()(n, sc, cs); }
    if (f8) cs *= pg8::F8_WSCALE;
    {
        f32x4 ld[8];
#pragma unroll
        for (int i = 0; i < 8; ++i) { const int kk = 8 * i + (lane >> 3); ld[i] = (f32x4){0.f, 0.f, 0.f, 0.f}; if (sc >= 0) ld[i] = *(const GAS f32x4*)(W + (size_t)(k0 + kk) * Nsrc + sc); }
#pragma unroll
        for (int i = 0; i < 8; ++i) { const int kk = 8 * i + (lane >> 3); float gk = cs; if (gain) gk *= gain[k0 + kk]; LAS float* d = scr + kk * 33 + (lane & 7) * 4; d[0] = ld[i][0] * gk; d[1] = ld[i][1] * gk; d[2] = ld[i][2] * gk; d[3] = ld[i][3] * gk; }
    }
    LDS_WAIT(); asm volatile("" ::: "memory");
    if (f8) {
        const int c = lane & 3;
#pragma unroll
        for (int j = 0; j < 2; ++j) { const int n = (lane >> 2) + 16 * j; const LAS float* s = scr + (16 * c) * 33 + n;
            v4u o; o.x = pg8::pack4_fp8(s[0 * 33], s[1 * 33], s[2 * 33], s[3 * 33]); o.y = pg8::pack4_fp8(s[4 * 33], s[5 * 33], s[6 * 33], s[7 * 33]);
            o.z = pg8::pack4_fp8(s[8 * 33], s[9 * 33], s[10 * 33], s[11 * 33]); o.w = pg8::pack4_fp8(s[12 * 33], s[13 * 33], s[14 * 33], s[15 * 33]);
            *(GAS v4u*)(dst + (size_t)(n0 + n) * K + k0 + 16 * c) = o; }
    } else {
        const int c = lane & 7;
#pragma unroll
        for (int j = 0; j < 4; ++j) { const int n = (lane >> 3) + 8 * j; const LAS float* s = scr + (8 * c) * 33 + n;
            v4u o; o.x = pk2(s[0 * 33], s[1 * 33]); o.y = pk2(s[2 * 33], s[3 * 33]); o.z = pk2(s[4 * 33], s[5 * 33]); o.w = pk2(s[6 * 33], s[7 * 33]);
            *(GAS v4u*)(dst + ((size_t)(n0 + n) * K + k0 + 8 * c) * 2) = o; }
    }
    LDS_WAIT(); asm volatile("" ::: "memory");
}

#ifndef PH_MASK
#define PH_MASK 0x7ff
#endif
template <class T_> __device__ __forceinline__ T_* as_global(T_* p) { return (T_*)(GAS T_*)p; }


namespace att {
typedef float f32x16 __attribute__((ext_vector_type(16)));
typedef short s16x4 __attribute__((ext_vector_type(4)));
typedef unsigned long long u64;
constexpr float LOG2E = 1.4426950408889634f;
__device__ __forceinline__ int crow(int r, int hi) { return (r & 3) + 8 * (r >> 2) + 4 * hi; }
__device__ __forceinline__ unsigned cvtpk(float lo, float hi) { unsigned r; asm volatile("v_cvt_pk_bf16_f32 %0, %1, %2" : "=v"(r) : "v"(lo), "v"(hi)); return r; }

constexpr int SWA_K = 0, SWA_V = 32768, SWA_VROW = 520;
__device__ __forceinline__ void swa_unit(int b, int n, int g, unsigned char* wsb, const float* sink, LAS unsigned char* L, int wid, int lane, int tid, size_t dst_off) {
    { GAS unsigned char* wg_ = (GAS unsigned char*)wsb; asm volatile("" : "+s"(wg_)); wsb = (unsigned char*)wg_; } const bf16* AQ = (const bf16*)(wsb + WS_AQ); const bf16* AK = (const bf16*)(wsb + WS_AK); const bf16* AVT = (const bf16*)(wsb + WS_AVT);
    const int hh = wid >> 1, qh = wid & 1, head = 4 * g + hh, r32 = lane & 31, hi = lane >> 5;
    const float slope2 = __builtin_amdgcn_exp2f(-0.5f * (float)(head + 1)) * LOG2E, sink2 = sink[head] * LOG2E;
    const size_t rowb = (size_t)b * T;
    const int kt0 = 128 * n - 128;
#pragma unroll
    for (int i = 0; i < 4; ++i) {
        const int row = (tid >> 3) + 64 * i, ch = tid & 7; int key = kt0 + row; if (key < 0) key = 0;
        const v4u v = *(const v4u*)(AK + (rowb + key) * 128 + g * 64 + ch * 8);
        *(LAS v4u*)(L + SWA_K + row * 128 + ((ch ^ ((row >> 1) & 7)) << 4)) = v;
    }
#pragma unroll
    for (int i = 0; i < 4; ++i) {
        const int d = (tid >> 5) + 16 * i, ch = tid & 31; int key0 = kt0 + 8 * ch; if (key0 < 0) key0 = 0;
        const v4u v = *(const v4u*)(AVT + ((size_t)((b * 2 + g) * 64 + d)) * T + key0);
        LAS u64* dp = (LAS u64*)(L + SWA_V + d * SWA_VROW + ch * 16);
        dp[0] = (u64)v.x | ((u64)v.y << 32); dp[1] = (u64)v.z | ((u64)v.w << 32);
    }
    __syncthreads();
    for (int qs = 0; qs < 2; ++qs) {
        const int qq0 = 128 * n + 64 * qh + 32 * qs, kbase = qq0 - 128, lrow0 = 64 * qh + 32 * qs;
        const bf16* qp = AQ + (rowb + qq0 + r32) * 512 + head * 64;
        bf16x8 qf[4];
#pragma unroll
        for (int ks = 0; ks < 4; ++ks) qf[ks] = *(const bf16x8*)(qp + 8 * hi + 16 * ks);
        float mrun = sink2, lrun = 1.0f;
        f32x16 O0 = {}, O1 = {};
#pragma unroll
        for (int kb = 0; kb < 5; ++kb) {
            const int row = lrow0 + 32 * kb + r32, sw = (row >> 1) & 7;
            f32x16 acc = {};
#pragma unroll
            for (int ks = 0; ks < 4; ++ks) acc = __builtin_amdgcn_mfma_f32_32x32x16_bf16(*(const LAS bf16x8*)(L + SWA_K + row * 128 + (((2 * ks + hi) ^ sw) << 4)), qf[ks], acc, 0, 0, 0);
            float bm = -__builtin_inff();
            int dist0 = r32 + 128 - 32 * kb - 4 * hi; asm volatile("" : "+v"(dist0));
            const bool bvalid = (kbase + 32 * kb) >= 0;
#pragma unroll
            for (int r = 0; r < 16; ++r) {
                const int dist = dist0 - ((r & 3) + 8 * (r >> 2));
                const bool valid = bvalid && ((unsigned)dist < 128u);
                const float l = valid ? (acc[r] - slope2 * (float)dist) : -__builtin_inff();
                acc[r] = l; bm = fmaxf(bm, l);
            }
            bm = fmaxf(bm, __shfl_xor(bm, 32));
            const float mnew = fmaxf(mrun, bm), alpha = __builtin_amdgcn_exp2f(mrun - mnew);
            float bs = 0.f;
#pragma unroll
            for (int r = 0; r < 16; ++r) { const float e = __builtin_amdgcn_exp2f(acc[r] - mnew); acc[r] = e; bs += e; }
            bs += __shfl_xor(bs, 32);
            lrun = lrun * alpha + bs; mrun = mnew;
#pragma unroll
            for (int r = 0; r < 16; ++r) { O0[r] *= alpha; O1[r] *= alpha; }
#pragma unroll
            for (int s2 = 0; s2 < 2; ++s2) {
                v4u pw; pw.x = cvtpk(acc[8 * s2 + 0], acc[8 * s2 + 1]); pw.y = cvtpk(acc[8 * s2 + 2], acc[8 * s2 + 3]);
                pw.z = cvtpk(acc[8 * s2 + 4], acc[8 * s2 + 5]); pw.w = cvtpk(acc[8 * s2 + 6], acc[8 * s2 + 7]);
                const bf16x8 pf = __builtin_bit_cast(bf16x8, pw);
                const int tb = lrow0 + 32 * kb + 16 * s2 + 4 * hi;
                const LAS unsigned char* vp = L + SWA_V + r32 * SWA_VROW + 2 * tb;
                typedef u64 u64x2 __attribute__((ext_vector_type(2)));
                u64x2 v0, v1; v0.x = *(const LAS u64*)vp; v0.y = *(const LAS u64*)(vp + 16); v1.x = *(const LAS u64*)(vp + 32 * SWA_VROW); v1.y = *(const LAS u64*)(vp + 32 * SWA_VROW + 16);
                O0 = __builtin_amdgcn_mfma_f32_32x32x16_bf16(__builtin_bit_cast(bf16x8, v0), pf, O0, 0, 0, 0);
                O1 = __builtin_amdgcn_mfma_f32_32x32x16_bf16(__builtin_bit_cast(bf16x8, v1), pf, O1, 0, 0, 0);
            }
        }
        { const float inv = 1.0f / lrun;
#pragma unroll
          for (int r = 0; r < 16; ++r) { O0[r] *= inv; O1[r] *= inv; } }
#pragma unroll
        for (int rg = 0; rg < 4; ++rg) {
            const int d = 8 * rg + 4 * hi;
            const unsigned w0 = pg8::pack4_fp8(O0[4 * rg], O0[4 * rg + 1], O0[4 * rg + 2], O0[4 * rg + 3]);
            const unsigned w1 = pg8::pack4_fp8(O1[4 * rg], O1[4 * rg + 1], O1[4 * rg + 2], O1[4 * rg + 3]);
            unsigned char* op = (unsigned char*)(wsb + dst_off) + (rowb + qq0 + r32) * 512 + head * 64; *(unsigned*)(op + d) = w0; *(unsigned*)(op + 32 + d) = w1;
        }
    }
    __syncthreads();
}

constexpr int CB = 448;
constexpr int L_KT = 0, L_BUF = 32768, L_HIST = 32768, L_QINFO = L_BUF + 64 * CB * 4, L_WSCR = L_QINFO + 2048, L_END = L_WSCR + 8 * 1024, L_VBUF = 0;
__device__ __forceinline__ float relu_i(float x) { const int b = __builtin_bit_cast(int, x); return __builtin_bit_cast(float, b > 0 ? b : 0); }
template <int PASS>
__device__ __forceinline__ void idx_post(const f32x16& acc, int rb, int kb, int s, int t0, LAS unsigned char* L, const float (&wq)[2][2][8], const int (&qa)[2][2], const int (&qb)[2][2], int (&eqseen)[2][2], int (&cnt)[2][2], unsigned (&cw)[2][2][2], int wid, int r32, int hi) {
    LAS unsigned* hist = (LAS unsigned*)(L + L_HIST);
    LAS unsigned* buf = (LAS unsigned*)(L + L_BUF);
#pragma unroll
    for (int g2 = 0; g2 < 2; ++g2) {
        float sc = relu_i(acc[8 * g2]) * wq[rb][g2][0];
#pragma unroll
        for (int hd = 1; hd < 8; ++hd) sc = fmaf(relu_i(acc[8 * g2 + hd]), wq[rb][g2][hd], sc);
        const int ql = 8 * wid + 4 * rb + 2 * g2 + hi, tq = t0 + ql;
        const bool valid = s <= tq;
        const _Float16 hf = (_Float16)sc; const int hb = (int)__builtin_bit_cast(short, hf);
        const unsigned u = (unsigned)(hb ^ ((hb >> 16) | 0x8000)) & 0xffffu;
        if (PASS == 1 || PASS == 4) { if (PASS == 1) __hip_atomic_fetch_add(hist + ql * 256 + (u >> 8), valid ? (1u << ((u >> 3) & 16u)) : 0u, __ATOMIC_RELAXED, __HIP_MEMORY_SCOPE_WORKGROUP);
            cw[rb][g2][kb >> 1] |= (valid ? u : 0u) << (16 * (kb & 1)); }
        else if (PASS == 2) { const bool c = valid && (int)(u >> 7) == qa[rb][g2]; if (__ballot(c) != 0ull) __hip_atomic_fetch_add(hist + ql * 256 + (u & 127u), c ? 1u : 0u, __ATOMIC_RELAXED, __HIP_MEMORY_SCOPE_WORKGROUP); }
        else {
            const bool gt = valid && ((int)u > qa[rb][g2]), eq = valid && ((int)u == qa[rb][g2]);
            const unsigned ltm = (1u << r32) - 1u;
            const u64 em = __ballot(eq);
            const unsigned mh = hi ? (unsigned)(em >> 32) : (unsigned)em;
            const bool keep = gt || (eq && (eqseen[rb][g2] + __popc(mh & ltm)) < qb[rb][g2]);
            eqseen[rb][g2] += __popc(mh);
            const u64 km = __ballot(keep);
            const unsigned kh = hi ? (unsigned)(km >> 32) : (unsigned)km;
            const int pos = cnt[rb][g2] + __popc(kh & ltm);
            if (keep && pos < CB) buf[ql * CB + pos] = (u << 16) | (unsigned)s;
            cnt[rb][g2] += __popc(kh);
        }
    }
}
template <int PASS>
__device__ __forceinline__ void idx_tile(int t0, int kt, const LAS unsigned char* kbuf, LAS unsigned char* L, const bf16x8 (&af)[2][4], const float (&wq)[2][2][8], const int (&qa)[2][2], const int (&qb)[2][2], int (&eqseen)[2][2], int (&cnt)[2][2], unsigned short* codes, int cstride, int wid, int r32, int hi) {
    unsigned cw[2][2][2];
#pragma unroll
    for (int rb = 0; rb < 2; ++rb)
#pragma unroll
        for (int g2 = 0; g2 < 2; ++g2) { cw[rb][g2][0] = 0u; cw[rb][g2][1] = 0u; }
#pragma unroll
    for (int kb = 0; kb < 4; ++kb) {
        bf16x8 bfr[4];
        const int lrow = 32 * kb + r32;
#pragma unroll
        for (int ks = 0; ks < 4; ++ks) bfr[ks] = *(const LAS bf16x8*)(kbuf + lrow * 128 + (((2 * ks + hi) ^ ((lrow >> 1) & 7)) << 4));
        const int s = 128 * kt + 4 * r32 + kb;
        f32x16 acc0 = {}, acc1 = {};
#pragma unroll
        for (int ks = 0; ks < 4; ++ks) acc0 = __builtin_amdgcn_mfma_f32_32x32x16_bf16(af[0][ks], bfr[ks], acc0, 0, 0, 0);
#pragma unroll
        for (int ks = 0; ks < 4; ++ks) acc1 = __builtin_amdgcn_mfma_f32_32x32x16_bf16(af[1][ks], bfr[ks], acc1, 0, 0, 0);
        idx_post<PASS>(acc0, 0, kb, s, t0, L, wq, qa, qb, eqseen, cnt, cw, wid, r32, hi);
        idx_post<PASS>(acc1, 1, kb, s, t0, L, wq, qa, qb, eqseen, cnt, cw, wid, r32, hi);
    }
    if (PASS == 1 || PASS == 4) {
#pragma unroll
        for (int rb = 0; rb < 2; ++rb)
#pragma unroll
            for (int g2 = 0; g2 < 2; ++g2) { const int ql = 8 * wid + 4 * rb + 2 * g2 + hi;
                *(u64*)(codes + (size_t)ql * cstride + 128 * kt + 4 * r32) = (u64)cw[rb][g2][0] | ((u64)cw[rb][g2][1] << 32); }
    }
}
template <int PASS>
__device__ __forceinline__ void idx_pass(int b, int t0, int kt0, int nt, unsigned char* wsb, unsigned short* codes, int cstride, LAS unsigned char* L, const bf16x8 (&af)[2][4], const float (&wq)[2][2][8], int wid, int lane, int tid) {
    { GAS unsigned char* wg_ = (GAS unsigned char*)wsb; asm volatile("" : "+s"(wg_)); wsb = (unsigned char*)wg_; } const bf16* IK = (const bf16*)(wsb + WS_IK);
    const int r32 = lane & 31, hi = lane >> 5;
    LAS int* qinfo = (LAS int*)(L + L_QINFO);
    int qa[2][2], qb[2][2], eqseen[2][2], cnt[2][2];
#pragma unroll
    for (int rb = 0; rb < 2; ++rb)
#pragma unroll
        for (int g2 = 0; g2 < 2; ++g2) { const int ql = 8 * wid + 4 * rb + 2 * g2 + hi; eqseen[rb][g2] = 0; cnt[rb][g2] = 0;
            if (PASS == 2) { qa[rb][g2] = qinfo[ql]; qb[rb][g2] = 0; } else if (PASS == 3) { qa[rb][g2] = qinfo[128 + ql]; qb[rb][g2] = qinfo[192 + ql]; cnt[rb][g2] = qinfo[256 + ql]; eqseen[rb][g2] = qinfo[384 + ql]; } else { qa[rb][g2] = 0; qb[rb][g2] = 0; } }
    const int skey = tid >> 2, sc0 = (tid & 3) * 2;
    const bf16* src = IK + ((size_t)b * T + skey) * 64 + sc0 * 8;
    const int srow = (skey & 3) * 32 + (skey >> 2);
    const int sd0 = srow * 128 + ((sc0 ^ ((srow >> 1) & 7)) << 4), sd1 = srow * 128 + (((sc0 + 1) ^ ((srow >> 1) & 7)) << 4);
    v4u A0, A1, B0, B1;
#define IDX_LOAD(R0, R1, tile) do { const bf16* s_ = src + (size_t)(tile) * (128 * 64); R0 = *(const v4u*)s_; R1 = *(const v4u*)(s_ + 8); } while (0)
#define IDX_WRITE(R0, R1, buf) do { *(LAS v4u*)(L + L_KT + (buf) * 16384 + sd0) = R0; *(LAS v4u*)(L + L_KT + (buf) * 16384 + sd1) = R1; } while (0)
    IDX_LOAD(A0, A1, kt0); IDX_LOAD(B0, B1, (kt0 + 1 < nt ? kt0 + 1 : kt0));
    IDX_WRITE(A0, A1, 0);
    __syncthreads();
    for (int kt = kt0; kt < nt; kt += 2) {
        { const int tn = (kt + 2 < nt) ? kt + 2 : nt - 1; IDX_LOAD(A0, A1, tn); }
        idx_tile<PASS>(t0, kt, L + L_KT, L, af, wq, qa, qb, eqseen, cnt, codes, cstride, wid, r32, hi);
        IDX_WRITE(B0, B1, 1);
        __syncthreads();
        if (kt + 1 >= nt) break;
        { const int tn = (kt + 3 < nt) ? kt + 3 : nt - 1; IDX_LOAD(B0, B1, tn); }
        idx_tile<PASS>(t0, kt + 1, L + L_KT + 16384, L, af, wq, qa, qb, eqseen, cnt, codes, cstride, wid, r32, hi);
        IDX_WRITE(A0, A1, 0);
        __syncthreads();
    }
#undef IDX_LOAD
#undef IDX_WRITE
    if (PASS == 3) {
#pragma unroll
        for (int rb = 0; rb < 2; ++rb)
#pragma unroll
            for (int g2 = 0; g2 < 2; ++g2) if (r32 == 0) qinfo[256 + 8 * wid + 4 * rb + 2 * g2 + hi] = cnt[rb][g2];
    }
}
template <bool NB16>
__device__ __forceinline__ void find_bin(const LAS unsigned* hq, int K, int lane, int& bin, int& above, int& incnt) {
    const v4u w = *(const LAS v4u*)(hq + 4 * lane);
    int c[8];
    if (NB16) { c[0] = w.x & 0xffffu; c[1] = w.x >> 16; c[2] = w.y & 0xffffu; c[3] = w.y >> 16; c[4] = w.z & 0xffffu; c[5] = w.z >> 16; c[6] = w.w & 0xffffu; c[7] = w.w >> 16; }
    else { c[0] = (int)w.x; c[1] = (int)w.y; c[2] = (int)w.z; c[3] = (int)w.w; c[4] = 0; c[5] = 0; c[6] = 0; c[7] = 0; }
    constexpr int NC = NB16 ? 8 : 4;
    int tot = 0;
#pragma unroll
    for (int i = 0; i < NC; ++i) tot += c[i];
    int S = tot;
#pragma unroll
    for (int o = 1; o < 64; o <<= 1) { const int t = __shfl_down(S, o); if (lane + o < 64) S += t; }
    const int ab = S - tot;
    const bool here = (S >= K) && (ab < K);
    const u64 bm = __ballot(here);
    int mybin = NC * lane, myab = ab, myc = c[0]; bool found = false;
#pragma unroll
    for (int i = NC - 1; i >= 0; --i) { if (!found) { if (myab + c[i] >= K || i == 0) { mybin = NC * lane + i; myc = c[i]; found = true; } else myab += c[i]; } }
    const int Ls = (bm == 0ull) ? 0 : (__ffsll((long long)bm) - 1);
    bin = __shfl(mybin, Ls); above = __shfl(myab, Ls); incnt = __shfl(myc, Ls);
}
__device__ __forceinline__ int prune256(LAS unsigned* buf, int n, LAS unsigned* wh, int lane) {
    const unsigned ltm_lo = (lane < 32) ? ((1u << lane) - 1u) : 0xffffffffu, ltm_hi = (lane < 32) ? 0u : ((1u << (lane - 32)) - 1u);
#pragma unroll
    for (int i = 0; i < 4; ++i) wh[i * 64 + lane] = 0u;
    LDS_WAIT();
    for (int i = lane; i < n; i += 64) __hip_atomic_fetch_add(wh + (buf[i] >> 24), 1u, __ATOMIC_RELAXED, __HIP_MEMORY_SCOPE_WORKGROUP);
    LDS_WAIT();
    int b1, ab1, c1; find_bin<false>(wh, 256, lane, b1, ab1, c1);
#pragma unroll
    for (int i = 0; i < 4; ++i) wh[i * 64 + lane] = 0u;
    LDS_WAIT();
    for (int i = lane; i < n; i += 64) { const unsigned e = buf[i]; if ((int)(e >> 24) == b1) __hip_atomic_fetch_add(wh + ((e >> 16) & 255u), 1u, __ATOMIC_RELAXED, __HIP_MEMORY_SCOPE_WORKGROUP); }
    LDS_WAIT();
    int b2, ab2, c2; find_bin<false>(wh, 256 - ab1, lane, b2, ab2, c2);
    const int Tc = (b1 << 8) | b2, need = 256 - ab1 - ab2;
    int eqseen = 0, outc = 0;
    for (int c0 = 0; c0 < n; c0 += 64) {
        const int i = c0 + lane; const unsigned e = (i < n) ? buf[i] : 0u; const int code = (int)(e >> 16);
        const bool gt = (i < n) && code > Tc, eq = (i < n) && code == Tc;
        const u64 em = __ballot(eq);
        const int rank = eqseen + __popc((unsigned)em & ltm_lo) + __popc((unsigned)(em >> 32) & ltm_hi);
        const bool keep = gt || (eq && rank < need);
        eqseen += __popcll(em);
        const u64 km = __ballot(keep);
        const int pos = outc + __popc((unsigned)km & ltm_lo) + __popc((unsigned)(km >> 32) & ltm_hi);
        LDS_WAIT();
        if (keep) buf[pos] = e;
        outc += __popcll(km);
    }
    LDS_WAIT();
    return Tc;
}

__device__ __forceinline__ unsigned scan_hits(const v4u cur, int T) {
    const unsigned c0 = cur.x & 0xffffu, c1 = cur.x >> 16, c2 = cur.y & 0xffffu, c3 = cur.y >> 16, c4 = cur.z & 0xffffu, c5 = cur.z >> 16, c6 = cur.w & 0xffffu, c7 = cur.w >> 16;
    return ((int)c0 > T ? 1u : 0u) | ((int)c1 > T ? 2u : 0u) | ((int)c2 > T ? 4u : 0u) | ((int)c3 > T ? 8u : 0u) | ((int)c4 > T ? 16u : 0u) | ((int)c5 > T ? 32u : 0u) | ((int)c6 > T ? 64u : 0u) | ((int)c7 > T ? 128u : 0u);
}
__device__ __forceinline__ void scan_block(const v4u cur, int kk, int& T, LAS unsigned* buf, int& cnt, LAS unsigned* wh, int lane, u64 ltm) {
    unsigned keep = scan_hits(cur, T);
    int kc = __popc(keep);
    u64 b0 = __ballot(kc & 1), b1 = __ballot(kc & 2), b2 = __ballot(kc & 4), b3 = __ballot(kc & 8);
    int tot = __popcll(b0) + 2 * __popcll(b1) + 4 * __popcll(b2) + 8 * __popcll(b3);
    if (cnt + tot > CB && cnt > 256) {
        LDS_WAIT();
        T = prune256(buf, cnt, wh, lane); cnt = 256;
        keep = scan_hits(cur, T); kc = __popc(keep);
        b0 = __ballot(kc & 1); b1 = __ballot(kc & 2); b2 = __ballot(kc & 4); b3 = __ballot(kc & 8);
        tot = __popcll(b0) + 2 * __popcll(b1) + 4 * __popcll(b2) + 8 * __popcll(b3);
    }
    int pos = cnt + __popcll(b0 & ltm) + 2 * __popcll(b1 & ltm) + 4 * __popcll(b2 & ltm) + 8 * __popcll(b3 & ltm);
    cnt += tot;
    const u64 lo64 = (u64)cur.x | ((u64)cur.y << 32), hi64 = (u64)cur.z | ((u64)cur.w << 32);
    while (keep) {
        const int e = __ffs((int)keep) - 1; keep &= keep - 1u;
        const unsigned code = (unsigned)(((e & 4) ? hi64 : lo64) >> (16 * (e & 3))) & 0xffffu;
        if (pos < CB) buf[pos] = (code << 16) | (unsigned)(kk + e);
        ++pos;
    }
}
__device__ __forceinline__ void scan_codes(const unsigned short* crow, int nkeys, int T, LAS unsigned* buf, int& cnt_io, LAS unsigned* wh, int lane) {
    int cnt = cnt_io;
    const u64 ltm = (lane == 0) ? 0ull : (~0ull >> (64 - lane));
    v4u w0, w1, w2, w3;
#define SC_LOAD(R, kq) do { const int kq_ = (kq) + 8 * lane; R = (kq_ < nkeys) ? *(const v4u*)(crow + kq_) : (v4u){0u, 0u, 0u, 0u}; } while (0)
    SC_LOAD(w0, 0); SC_LOAD(w1, 512); SC_LOAD(w2, 1024); SC_LOAD(w3, 1536);
    for (int k0 = 0; k0 < nkeys; k0 += 2048) {
        { const v4u cur = w0; SC_LOAD(w0, k0 + 2048); scan_block(cur, k0 + 8 * lane, T, buf, cnt, wh, lane, ltm); }
        if (k0 + 512 >= nkeys) break;
        { const v4u cur = w1; SC_LOAD(w1, k0 + 2560); scan_block(cur, k0 + 512 + 8 * lane, T, buf, cnt, wh, lane, ltm); }
        if (k0 + 1024 >= nkeys) break;
        { const v4u cur = w2; SC_LOAD(w2, k0 + 3072); scan_block(cur, k0 + 1024 + 8 * lane, T, buf, cnt, wh, lane, ltm); }
        if (k0 + 1536 >= nkeys) break;
        { const v4u cur = w3; SC_LOAD(w3, k0 + 3584); scan_block(cur, k0 + 1536 + 8 * lane, T, buf, cnt, wh, lane, ltm); }
    }
#undef SC_LOAD
    cnt_io = cnt;
}

__device__ __forceinline__ void sparse_query(int b, int t, const LAS unsigned* idx, unsigned char* wsb, LAS unsigned char* L, int wid, int lane, size_t dst_off) {
    { GAS unsigned char* wg_ = (GAS unsigned char*)wsb; asm volatile("" : "+s"(wg_)); wsb = (unsigned char*)wg_; } bf16* BQ = (bf16*)(wsb + WS_BQ); const bf16* BK = (const bf16*)(wsb + WS_BK); const bf16* BV = (const bf16*)(wsb + WS_BV);
    const int fr = lane & 15, fq = lane >> 4;
    LAS unsigned char* vbuf = L + L_VBUF + wid * 4096;
    const size_t rowb = (size_t)b * T;
    bf16* qrow = BQ + (rowb + t) * 512;
    bf16x8 qf0 = {}, qf1 = {};
    if (fr < 8) { qf0 = *(const bf16x8*)(qrow + fr * 64 + 8 * fq); qf1 = *(const bf16x8*)(qrow + fr * 64 + 32 + 8 * fq); }
    f32x4 S[16];
    {
        v4u kreg[4][4];
#pragma unroll
        for (int c8 = 0; c8 < 4; ++c8)
#pragma unroll
            for (int i = 0; i < 4; ++i) {
                const int row = 8 * i + (lane >> 3), ch = lane & 7;
                unsigned ki = idx[32 * c8 + row] & 0xffffu; if (ki == 0xffffu) ki = 0u;
                kreg[c8][i] = *(const v4u*)(BK + (rowb + ki) * 64 + ch * 8);
            }
#pragma unroll
        for (int c8 = 0; c8 < 8; ++c8) {
#pragma unroll
            for (int i = 0; i < 4; ++i) {
                const int row = 8 * i + (lane >> 3), ch = lane & 7;
                *(LAS v4u*)(vbuf + row * 128 + ((ch ^ (((row >> 1) & 3) << 1)) << 4)) = kreg[c8 & 3][i];
            }
            if (c8 + 4 < 8) {
#pragma unroll
                for (int i = 0; i < 4; ++i) {
                    const int row = 8 * i + (lane >> 3), ch = lane & 7;
                    unsigned ki = idx[32 * (c8 + 4) + row] & 0xffffu; if (ki == 0xffffu) ki = 0u;
                    kreg[c8 & 3][i] = *(const v4u*)(BK + (rowb + ki) * 64 + ch * 8);
                }
            }
            LDS_WAIT();
#pragma unroll
            for (int kbl = 0; kbl < 2; ++kbl) {
                const int row = 16 * kbl + fr, sw = ((row >> 1) & 3) << 1;
                const bf16x8 a0 = *(const LAS bf16x8*)(vbuf + row * 128 + ((fq ^ sw) << 4)), a1 = *(const LAS bf16x8*)(vbuf + row * 128 + (((fq + 4) ^ sw) << 4));
                f32x4 acc = {0.f, 0.f, 0.f, 0.f};
                acc = __builtin_amdgcn_mfma_f32_16x16x32_bf16(a0, qf0, acc, 0, 0, 0);
                acc = __builtin_amdgcn_mfma_f32_16x16x32_bf16(a1, qf1, acc, 0, 0, 0);
                S[2 * c8 + kbl] = acc;
            }
            LDS_WAIT();
        }
    }
    v4u vreg[4][4];
#pragma unroll
    for (int c8 = 0; c8 < 4; ++c8)
#pragma unroll
        for (int i = 0; i < 4; ++i) {
            const int row = 8 * i + (lane >> 3), ch = lane & 7;
            unsigned ki = idx[32 * c8 + row] & 0xffffu; if (ki == 0xffffu) ki = 0u;
            vreg[c8][i] = *(const v4u*)(BV + (rowb + ki) * 64 + ch * 8);
        }
    const float slope2 = __builtin_amdgcn_exp2f(-0.5f * (float)((fr & 7) + 9)) * LOG2E;
    float mx = -__builtin_inff();
#pragma unroll
    for (int kb = 0; kb < 16; ++kb) {
        const v4u i4 = *(const LAS v4u*)(idx + 16 * kb + 4 * fq);
        const unsigned k0 = i4.x & 0xffffu, k1 = i4.y & 0xffffu, k2 = i4.z & 0xffffu, k3 = i4.w & 0xffffu;
        { const float l = (k0 != 0xffffu) ? (S[kb][0] - slope2 * (float)(t - (int)k0)) : -__builtin_inff(); S[kb][0] = l; mx = fmaxf(mx, l); }
        { const float l = (k1 != 0xffffu) ? (S[kb][1] - slope2 * (float)(t - (int)k1)) : -__builtin_inff(); S[kb][1] = l; mx = fmaxf(mx, l); }
        { const float l = (k2 != 0xffffu) ? (S[kb][2] - slope2 * (float)(t - (int)k2)) : -__builtin_inff(); S[kb][2] = l; mx = fmaxf(mx, l); }
        { const float l = (k3 != 0xffffu) ? (S[kb][3] - slope2 * (float)(t - (int)k3)) : -__builtin_inff(); S[kb][3] = l; mx = fmaxf(mx, l); }
    }
    mx = fmaxf(mx, __shfl_xor(mx, 16)); mx = fmaxf(mx, __shfl_xor(mx, 32));
    float sum = 0.f;
#pragma unroll
    for (int kb = 0; kb < 16; ++kb)
#pragma unroll
        for (int r = 0; r < 4; ++r) { const float e = __builtin_amdgcn_exp2f(S[kb][r] - mx); S[kb][r] = e; sum += e; }
    sum += __shfl_xor(sum, 16); sum += __shfl_xor(sum, 32);
    const float inv = 1.0f / sum;
    f32x4 O[4];
#pragma unroll
    for (int db = 0; db < 4; ++db) O[db] = (f32x4){0.f, 0.f, 0.f, 0.f};
#pragma unroll
    for (int c8 = 0; c8 < 8; ++c8) {
#pragma unroll
        for (int i = 0; i < 4; ++i) {
            const int row = 8 * i + (lane >> 3), ch = lane & 7;
            *(LAS v4u*)(vbuf + row * 128 + ((ch ^ (((row >> 1) & 3) << 1)) << 4)) = vreg[c8 & 3][i];
        }
        if (c8 + 4 < 8) {
#pragma unroll
            for (int i = 0; i < 4; ++i) {
                const int row = 8 * i + (lane >> 3), ch = lane & 7;
                unsigned ki = idx[32 * (c8 + 4) + row] & 0xffffu; if (ki == 0xffffu) ki = 0u;
                vreg[c8 & 3][i] = *(const v4u*)(BV + (rowb + ki) * 64 + ch * 8);
            }
        }
        LDS_WAIT();
        v4u pw; pw.x = cvtpk(S[2 * c8][0] * inv, S[2 * c8][1] * inv); pw.y = cvtpk(S[2 * c8][2] * inv, S[2 * c8][3] * inv);
        pw.z = cvtpk(S[2 * c8 + 1][0] * inv, S[2 * c8 + 1][1] * inv); pw.w = cvtpk(S[2 * c8 + 1][2] * inv, S[2 * c8 + 1][3] * inv);
        const bf16x8 pa = __builtin_bit_cast(bf16x8, pw);
        const int row0 = 4 * fq + (fr >> 2), row1 = row0 + 16;
#pragma unroll
        for (int db = 0; db < 4; ++db) {
            const int chunk = 2 * db + ((fr & 3) >> 1), sub = (fr & 1) * 8;
            const s16x4 lo = __builtin_bit_cast(s16x4, __builtin_amdgcn_ds_read_tr16_b64_v4i16((LAS s16x4*)(vbuf + row0 * 128 + ((chunk ^ (((row0 >> 1) & 3) << 1)) << 4) + sub)));
            const s16x4 hi4 = __builtin_bit_cast(s16x4, __builtin_amdgcn_ds_read_tr16_b64_v4i16((LAS s16x4*)(vbuf + row1 * 128 + ((chunk ^ (((row1 >> 1) & 3) << 1)) << 4) + sub)));
            const bf16x8 vb = (bf16x8){lo[0], lo[1], lo[2], lo[3], hi4[0], hi4[1], hi4[2], hi4[3]};
            O[db] = __builtin_amdgcn_mfma_f32_16x16x32_bf16(pa, vb, O[db], 0, 0, 0);
        }
    }
    if (fq < 2) {
#pragma unroll
        for (int db = 0; db < 4; ++db)
#pragma unroll
            for (int r = 0; r < 4; ++r) ((unsigned char*)(wsb + dst_off))[(rowb + t) * 512 + (4 * fq + r) * 64 + 16 * db + fr] = (unsigned char)(pg8::pack4_fp8(O[db][r], 0.f, 0.f, 0.f) & 0xffu);
    }
}

__device__ __forceinline__ void sparse_unit(int b, int j, unsigned short* codes, int cstride, unsigned char* wsb, LAS unsigned char* L, int wid, int lane, int tid) {
    { GAS unsigned char* wg_ = (GAS unsigned char*)wsb; asm volatile("" : "+s"(wg_)); wsb = (unsigned char*)wg_; } const bf16* IQ = (const bf16*)(wsb + WS_IQ); const float* IW = (const float*)(wsb + WS_IW);
    const int t0 = 64 * j, ntiles = (j >> 1) + 1, r32 = lane & 31, hi = lane >> 5;
    const size_t rowb = (size_t)b * T;
    LAS unsigned* hist = (LAS unsigned*)(L + L_HIST);
    LAS unsigned* cbuf = (LAS unsigned*)(L + L_BUF);
    LAS int* qinfo = (LAS int*)(L + L_QINFO);
    bf16x8 af[2][4];
    { const int a = r32 >> 3, hp = (r32 >> 2) & 1, bb = r32 & 3, qi = 2 * (a >> 1) + hp, hd = 4 * (a & 1) + bb;
#pragma unroll
      for (int rb = 0; rb < 2; ++rb) { const bf16* ap = IQ + (rowb + t0 + 8 * wid + 4 * rb + qi) * 512 + hd * 64 + 8 * hi;
#pragma unroll
          for (int ks = 0; ks < 4; ++ks) af[rb][ks] = *(const bf16x8*)(ap + 16 * ks); } }
    float wq[2][2][8];
#pragma unroll
    for (int rb = 0; rb < 2; ++rb)
#pragma unroll
        for (int g2 = 0; g2 < 2; ++g2) { const float* wp = IW + (rowb + t0 + 8 * wid + 4 * rb + 2 * g2 + hi) * 8; const f32x4 w0 = *(const f32x4*)wp, w1 = *(const f32x4*)(wp + 4);
            wq[rb][g2][0] = w0[0]; wq[rb][g2][1] = w0[1]; wq[rb][g2][2] = w0[2]; wq[rb][g2][3] = w0[3]; wq[rb][g2][4] = w1[0]; wq[rb][g2][5] = w1[1]; wq[rb][g2][6] = w1[2]; wq[rb][g2][7] = w1[3]; }
#ifndef REP_P1
#define REP_P1 1
#endif
    for (int rp1_ = 0; rp1_ < REP_P1; ++rp1_) {
#pragma unroll
    for (int i = 0; i < 32; ++i) hist[(8 * wid) * 256 + i * 64 + lane] = 0u;
    __syncthreads();
    idx_pass<1>(b, t0, 0, ntiles, wsb, codes, cstride, L, af, wq, wid, lane, tid);
    }
    for (int i = 0; i < 8; ++i) {
        const int ql = 8 * wid + i, t = t0 + ql; int bin = 0, above = 0, inc = 0;
        if (t + 1 > 256) find_bin<true>(hist + ql * 256, 256, lane, bin, above, inc);
        if (lane == 0) qinfo[128 + ql] = (t + 1 > 256) ? ((bin << 7) - 1) : 0;
    }
    LDS_WAIT();
    __syncthreads();
    VM_WAIT();
    __builtin_amdgcn_fence(__ATOMIC_ACQUIRE, "agent"); VM_WAIT();
#ifndef REP_SCAN
#define REP_SCAN 1
#endif
#ifndef REP_SCPR
#define REP_SCPR 1
#endif
    LAS unsigned* wh = (LAS unsigned*)(L + L_WSCR + wid * 1024);
    for (int rsp_ = 0; rsp_ < REP_SCPR; ++rsp_) {
    for (int rsc_ = 0; rsc_ < REP_SCAN; ++rsc_)
    { const int nstored = ntiles * 128;
      for (int i = 0; i < 8; ++i) {
        const int ql = 8 * wid + i; int c = 0;
        scan_codes(codes + (size_t)ql * cstride, nstored, qinfo[128 + ql], cbuf + ql * CB, c, wh, lane);
        if (lane == 0) qinfo[256 + ql] = c;
      } }
    LDS_WAIT();
    for (int i = 0; i < 8; ++i) {
        const int ql = 8 * wid + i; int n = qinfo[256 + ql]; if (n > CB) n = CB;
        LAS unsigned* qb_ = cbuf + ql * CB;
        if (n > 256) (void)prune256(qb_, n, wh, lane);
        else { for (int p = n + lane; p < 256; p += 64) qb_[p] = 0xffffffffu; LDS_WAIT(); }
    }
    }
    __syncthreads();
#ifndef REP_ATT
#define REP_ATT 1
#endif
    for (int ra_ = 0; ra_ < REP_ATT; ++ra_)
    for (int i = 0; i < 8; ++i) sparse_query(b, t0 + 8 * wid + i, cbuf + (8 * wid + i) * CB, wsb, L, wid, lane, WS_YB8);
    __syncthreads();
}
}

struct Args { const float* in[18]; float* out; unsigned char* ws; int ph_lo, ph_hi, use_bar, pad; };

__global__ void __launch_bounds__(NWAVES * 64, 2) mega(Args args) {
    extern __shared__ __attribute__((aligned(16))) unsigned char lds[];
    LAS unsigned char* L = (LAS unsigned char*)lds;
    volatile LAS unsigned* MISC = (volatile LAS unsigned*)(L + MISC_OFF);
    const int wave = __builtin_amdgcn_readfirstlane((int)threadIdx.x >> 6);
#define LANE_TID int lane; asm volatile("v_mbcnt_lo_u32_b32 %0, -1, 0\n\tv_mbcnt_hi_u32_b32 %0, -1, %0" : "=v"(lane)); const int tid = wave * 64 + lane; (void)tid;
    const int G = gridDim.x; const int bx = blockIdx.x; const int vcu = (G % 8 == 0) ? (bx % 8) * (G / 8) + bx / 8 : bx;
    { LANE_TID for (int u = tid; u < (LDS_BYTES - LDSCTL_OFF) / 4; u += NWAVES * 64) ((LAS unsigned*)(L + LDSCTL_OFF))[u] = 0u; }
    __syncthreads();
    if (args.use_bar) (void)xcd_barrier_post((unsigned*)((gu32*)(args.ws + WS_CTL) + CW_BAR), MISC + 8);
    if (args.use_bar && threadIdx.x == 0) {
        unsigned* bar_ = (unsigned*)((gu32*)(args.ws + WS_CTL) + CW_BAR); const unsigned x_ = xb_xcc_id() + 1u; unsigned exp_ = 0u;
        const bool first_ = __hip_atomic_compare_exchange_strong(&bar_[9216 + 64 * (bx & 7)], &exp_, x_, __ATOMIC_RELAXED, __ATOMIC_RELAXED, __HIP_MEMORY_SCOPE_AGENT);
        if ((!first_ && exp_ != x_) || (G & 7) != 0) (void)__hip_atomic_fetch_or(&bar_[10240], 1u, __ATOMIC_RELAXED, __HIP_MEMORY_SCOPE_AGENT);
    }
    const int lo = args.ph_lo, hi = args.ph_hi;
#define IN(k) (lo <= (k) && (k) < hi)
#define WSP(off) ((bf16*)(wsl + (off)))
#define WSF(off) ((float*)(wsl + (off)))
#define PHASE_WS GAS unsigned char* wsg_ = (GAS unsigned char*)args.ws; asm volatile("" : "+s"(wsg_)); unsigned char* wsl = (unsigned char*)wsg_;
#define PHASE_PTRS LANE_TID GAS unsigned char* wsg_ = (GAS unsigned char*)args.ws; asm volatile("" : "+s"(wsg_)); unsigned char* wsl = (unsigned char*)wsg_;
#define GRID_BAR(k) do { if (IN(k) && IN((k) + 1)) { XcdBarrier bb_; bb_.bar = (unsigned*)((gu32*)(args.ws + WS_CTL) + CW_BAR); bb_.x = xb_xcc_id(); bb_.st = (volatile LAS unsigned*)(L + MISC_OFF) + 8; xcd_barrier(bb_); } } while (0)
#define GROUP_MODE_INIT() do { if (args.use_bar && IN(0) && IN(1)) { if (threadIdx.x == 0) ((volatile LAS unsigned*)(L + MISC_OFF))[10] = (xb_ld((unsigned*)((gu32*)(args.ws + WS_CTL) + CW_BAR) + 10240) == 0u) ? 1u : 0u; __syncthreads(); } } while (0)
#define GROUP_BAR(k) do { if (IN(k) && IN((k) + 1)) { \
    if (((volatile LAS unsigned*)(L + MISC_OFF))[10] != 0u) { \
        asm volatile("s_waitcnt vmcnt(0)" ::: "memory"); __syncthreads();                         \
        if (threadIdx.x == 0) { unsigned* bar_ = (unsigned*)((gu32*)(args.ws + WS_CTL) + CW_BAR); const unsigned n_ = (unsigned)G >> 3; \
            __builtin_amdgcn_s_waitcnt(0); const unsigned old_ = xb_add(&bar_[8192 + 64 * (bx & 7)], 1u); const unsigned tgt_ = (old_ / n_ + 1u) * n_; \
            XB_SPIN(xb_ld(&bar_[8192 + 64 * (bx & 7)]) < tgt_, bar_); \
            __builtin_amdgcn_fence(__ATOMIC_ACQUIRE, "agent"); asm volatile("s_waitcnt vmcnt(0)" ::: "memory"); }     \
        __syncthreads(); \
    } else { XcdBarrier bb_; bb_.bar = (unsigned*)((gu32*)(args.ws + WS_CTL) + CW_BAR); bb_.x = xb_xcc_id(); bb_.st = (volatile LAS unsigned*)(L + MISC_OFF) + 8; xcd_barrier(bb_); } } } while (0)
    const int gw = vcu * NWAVES + wave, NGW = G * NWAVES;

#if (PH_MASK >> 0) & 1
    if (IN(0)) {
        PHASE_PTRS
        const float* x = as_global(args.in[0]); const float* pin = as_global(args.in[1]); const float* ln_ffn1 = as_global(args.in[2]); const float* w_ffn1_in = as_global(args.in[3]); const float* w_ffn1_out = as_global(args.in[4]); const float* ln_mix = as_global(args.in[5]); const float* w_in = as_global(args.in[6]);
        const float* w_br_a = as_global(args.in[8]); const float* w_br_b = as_global(args.in[9]); const float* w_out = as_global(args.in[10]); const float* ln_ffn2 = as_global(args.in[11]); const float* w_ffn2_in = as_global(args.in[12]); const float* w_ffn2_out = as_global(args.in[13]); const float* ln_ple = as_global(args.in[14]); const float* w_ple_gate = as_global(args.in[15]); const float* w_ple_proj = as_global(args.in[16]);
        bf16 *W1 = WSP(WS_W1), *W2 = WSP(WS_W2), *WIN = WSP(WS_WIN), *WA = WSP(WS_WA), *WB = WSP(WS_WB), *WO = WSP(WS_WO), *W3 = WSP(WS_W3), *W4 = WSP(WS_W4), *WG = WSP(WS_WG), *WP = WSP(WS_WP), *HB = WSP(WS_HB), *PB = WSP(WS_PB);
        LAS float* scr = (LAS float*)(L + RING_OFF + wave * 16384);
        constexpr int I_W1 = 16 * 176, I_W2 = 44 * 32, I_WIN = 16 * 64, I_WA = 8 * 32, I_WO = 16 * 32, I_WP = 4 * 32;
        constexpr int NITEMS = 2 * I_W1 + 2 * I_W2 + 2 * I_WIN + 2 * I_WA + 2 * I_WO + I_WP;
        const int n_it = (NITEMS - gw + NGW - 1) / NGW, n_x = (M / 2 - gw + NGW - 1) / NGW;
        for (int st = 0; st < (n_it > n_x ? n_it : n_x); ++st) {
            const int m0 = (gw + st * NGW) * 2; const bool has_x = st < n_x;
            f32x4 v[2][4];
            if (has_x) {
#pragma unroll
                for (int r = 0; r < 2; ++r) { const GAS f32x4* xr = (const GAS f32x4*)(x + (size_t)(m0 + r) * D) + lane;
#pragma unroll
                    for (int j = 0; j < 4; ++j) v[r][j] = xr[64 * j]; }
            }
            const int it = gw + st * NGW;
            if (it < NITEMS) {
                int r = it; const float* Wp_ = w_ffn1_in; int Ns = 2 * FF, Kk = D, nblk = 176, mapid = 1, f8 = 1; unsigned char* dst = (unsigned char*)W1; const float* gn = ln_ffn1;
                if (r >= I_W1) { r -= I_W1; Wp_ = w_ffn2_in; dst = (unsigned char*)W3; gn = ln_ffn2; f8 = 1;
                  if (r >= I_W1) { r -= I_W1; Wp_ = w_ffn1_out; Ns = D; Kk = FF; nblk = 32; mapid = 0; f8 = 1; dst = (unsigned char*)W2; gn = nullptr;
                    if (r >= I_W2) { r -= I_W2; Wp_ = w_ffn2_out; dst = (unsigned char*)W4; f8 = 1;
                      if (r >= I_W2) { r -= I_W2; Wp_ = w_in; Ns = DIN; Kk = D; nblk = 64; mapid = 2; f8 = 0; dst = (unsigned char*)WIN; gn = ln_mix;
                        if (r >= I_WIN) { r -= I_WIN; mapid = 3; f8 = 1; dst = (unsigned char*)WIN + 4 * MiB;
                          if (r >= I_WIN) { r -= I_WIN; Wp_ = w_br_a; Ns = D; Kk = 512; nblk = 32; mapid = 0; dst = (unsigned char*)WA; gn = nullptr;
                            if (r >= I_WA) { r -= I_WA; Wp_ = w_br_b; dst = (unsigned char*)WB;
                              if (r >= I_WA) { r -= I_WA; Wp_ = w_out; Kk = D; dst = (unsigned char*)WO;
                                if (r >= I_WO) { r -= I_WO; Wp_ = w_ple_gate; dst = (unsigned char*)WG; gn = ln_ple;
                                  if (r >= I_WO) { r -= I_WO; Wp_ = w_ple_proj; Kk = DPLE; dst = (unsigned char*)WP; gn = nullptr; } } } } } } } } } }
                tr_generic(Wp_, Ns, Kk, dst, gn, mapid, f8, scr, r, nblk, lane);
            }
            if (has_x) {
#pragma unroll
                for (int r = 0; r < 2; ++r) { float s = 0.f;
#pragma unroll
                    for (int j = 0; j < 4; ++j) s += (v[r][j].x * v[r][j].x + v[r][j].y * v[r][j].y) + (v[r][j].z * v[r][j].z + v[r][j].w * v[r][j].w);
                    const float rs = __builtin_amdgcn_rsqf(wave_sum(s) * (1.f / D) + 1e-6f);
                    GAS unsigned* o8 = (GAS unsigned*)(wsl + WS_X8 + (size_t)(m0 + r) * D) + lane;
#pragma unroll
                    for (int j = 0; j < 4; ++j) o8[64 * j] = pg8::pack4_fp8(v[r][j].x * rs, v[r][j].y * rs, v[r][j].z * rs, v[r][j].w * rs); }
            }
        }
        { const size_t NV = (size_t)M * DPLE / 4, stride = (size_t)G * 512;
          for (size_t i = (size_t)(bx * 512 + tid); i < NV; i += 4 * stride) {
            f32x4 v[4];
#pragma unroll
            for (int u = 0; u < 4; ++u) { const size_t ii = i + u * stride; v[u] = (ii < NV) ? ((const GAS f32x4*)pin)[ii] : (f32x4){0.f, 0.f, 0.f, 0.f}; }
#pragma unroll
            for (int u = 0; u < 4; ++u) { const size_t ii = i + u * stride; if (ii < NV) ((GAS unsigned*)PB)[ii] = pg8::pack4_fp8(v[u].x, v[u].y, v[u].z, v[u].w); }
          } }
    }
#endif
    GRID_BAR(0);
    GROUP_MODE_INIT();
#if (PH_MASK >> 1) & 1
    if (IN(1)) {
        PHASE_WS bf16 *HB = WSP(WS_HB), *W1 = WSP(WS_W1), *ACT = WSP(WS_ACT);
        pg8::Gemm g{WSP(WS_X8), W1, M, 2 * FF, D / 2}; pg8::StaticOrder S; S.init(M, 2 * FF, G, bx);
        pg8::EpiSwiglu<false, true, true> E{ACT, L};
        pg8::gemm_phase<pg8::EpiSwiglu<false, true, true>, pg8::StaticOrder, true, true, true>(L + RING_OFF, g, S, E, wave);
    }
#endif
    GROUP_BAR(1);
#if (PH_MASK >> 2) & 1
    if (IN(2)) {
        PHASE_WS bf16 *HB = WSP(WS_HB), *W2 = WSP(WS_W2), *ACT = WSP(WS_ACT); float* RSQ1 = WSF(WS_RSQ1); const float* x = as_global(args.in[0]);
        pg8::Gemm g{ACT, W2, M, D, FF / 2}; pg8::StaticOrder S; S.init(M, D, G, bx);
        pg8::EpiResid<true, true, true, true> E{x, HB, RSQ1, (unsigned char*)(wsl + WS_X8)};
        pg8::gemm_phase<pg8::EpiResid<true, true, true, true>, pg8::StaticOrder, true, true, true>(L + RING_OFF, g, S, E, wave);
    }
#endif
    GROUP_BAR(2);
#if (PH_MASK >> 3) & 1
    if (IN(3)) {
        PHASE_WS bf16 *HB = WSP(WS_HB), *WIN = WSP(WS_WIN); float *RSQ1 = WSF(WS_RSQ1); bf16* SG = (bf16*)as_global(args.out);
        { pg8::Gemm g{HB, WIN, M, 2048, D}; pg8::StaticOrder S; S.init(M, 2048, G, bx);
          { LANE_TID pg8::stage_rs(L, S, RSQ1, tid, 1.0f); }
          pg8::EpiProj E{L, wsl, SG};
          pg8::gemm_phase<pg8::EpiProj, pg8::StaticOrder, true, true>(L + RING_OFF, g, S, E, wave); }
        { pg8::Gemm g{WSP(WS_X8), (bf16*)((unsigned char*)WIN + 4 * MiB), M, 2048, D / 2}; pg8::StaticOrder S; S.init(M, 2048, G, bx);
          { LANE_TID pg8::stage_rs(L, S, RSQ1, tid, 1.0f); }
          pg8::EpiSig E{L, SG};
          pg8::gemm_phase<pg8::EpiSig, pg8::StaticOrder, true, true, true>(L + RING_OFF, g, S, E, wave); }
    }
#endif
    GRID_BAR(3);
#if (PH_MASK >> 4) & 1
    if (IN(4)) {
                LANE_TID unsigned char* wsl = as_global(args.ws); const float* a_sink = as_global(args.in[7]);
#ifndef NO_SWA
#ifndef REP_SWA
#define REP_SWA 1
#endif
        for (int rs_ = 0; rs_ < REP_SWA; ++rs_)
        for (int i = 0; i < 2; ++i) { const int su = vcu + 256 * i; if (su < 512) att::swa_unit(su >> 7, (su >> 1) & 63, su & 1, wsl, a_sink, L, wave, lane, tid, (rs_ + 1 < REP_SWA) ? WS_ACT : WS_YA8); }
#endif
#ifndef NO_SP
        if (vcu < 256) { const int sb = vcu >> 6, sj = vcu & 63, mh = sj >> 1;
            const int pre = 64 * sj - (mh * (mh - 1) + ((sj & 1) ? mh : 0)) + sb * 3104, cstride = (64 - mh) * 128;
            unsigned short* codes = (unsigned short*)(wsl + WS_ACT + (size_t)pre * 16384);
            att::sparse_unit(sb, sj, codes, cstride, wsl, L, wave, lane, tid);
            att::sparse_unit(sb, 127 - sj, codes, cstride, wsl, L, wave, lane, tid); }
#endif


    }
#endif
    GRID_BAR(4);
#if (PH_MASK >> 5) & 1
    if (IN(5)) {
        PHASE_WS bf16 *AQ = WSP(WS_AQ), *BQ = WSP(WS_BQ), *WA = WSP(WS_WA), *WB = WSP(WS_WB), *TA = WSP(WS_TA), *MIX = WSP(WS_MIX); bf16* SG = (bf16*)as_global(args.out);
        { pg8::Gemm g{WSP(WS_YA8), WA, M, D, 256}; pg8::StaticOrder S; S.init(M, D, G, bx);
          pg8::EpiGate<1, true, true> E{TA, SG, 0, nullptr};
          pg8::gemm_phase<pg8::EpiGate<1, true, true>, pg8::StaticOrder, true, true, true>(L + RING_OFF, g, S, E, wave); }
        VM_WAIT(); __syncthreads();
        { pg8::Gemm g{WSP(WS_YB8), WB, M, D, 256}; pg8::StaticOrder S; S.init(M, D, G, bx);
          pg8::EpiGate<2, true, true> E{MIX, SG, 1024, TA};
          pg8::gemm_phase<pg8::EpiGate<2, true, true>, pg8::StaticOrder, true, true, true>(L + RING_OFF, g, S, E, wave); }
    }
#endif
    GRID_BAR(5);
#if (PH_MASK >> 6) & 1
    if (IN(6)) {
        PHASE_WS bf16 *HB = WSP(WS_HB), *WO = WSP(WS_WO), *MIX = WSP(WS_MIX); float* RSQ2 = WSF(WS_RSQ2);
        pg8::Gemm g{MIX, WO, M, D, D / 2}; pg8::StaticOrder S; S.init(M, D, G, bx);
        pg8::EpiResid<false, false, true, true> E{nullptr, HB, RSQ2, (unsigned char*)(wsl + WS_X8)};
        pg8::gemm_phase<pg8::EpiResid<false, false, true, true>, pg8::StaticOrder, true, true, true>(L + RING_OFF, g, S, E, wave);
    }
#endif
    GROUP_BAR(6);
#if (PH_MASK >> 7) & 1
    if (IN(7)) {
        PHASE_WS bf16 *HB = WSP(WS_HB), *W3 = WSP(WS_W3), *ACT = WSP(WS_ACT); float* RSQ2 = WSF(WS_RSQ2);
        pg8::Gemm g{WSP(WS_X8), W3, M, 2 * FF, D / 2}; pg8::StaticOrder S; S.init(M, 2 * FF, G, bx);
        { LANE_TID pg8::stage_rs(L, S, RSQ2, tid, 1.0f); }
        pg8::EpiSwiglu<true, true> E{ACT, L};
        pg8::gemm_phase<pg8::EpiSwiglu<true, true>, pg8::StaticOrder, true, true, true>(L + RING_OFF, g, S, E, wave);
    }
#endif
    GROUP_BAR(7);
#if (PH_MASK >> 8) & 1
    if (IN(8)) {
        PHASE_WS bf16 *HB = WSP(WS_HB), *W4 = WSP(WS_W4), *ACT = WSP(WS_ACT); float* RSQ3 = WSF(WS_RSQ3);
        pg8::Gemm g{ACT, W4, M, D, FF / 2}; pg8::StaticOrder S; S.init(M, D, G, bx);
        pg8::EpiResid<false, true, true, true> E{nullptr, HB, RSQ3, (unsigned char*)(wsl + WS_X8)};
        pg8::gemm_phase<pg8::EpiResid<false, true, true, true>, pg8::StaticOrder, true, true, true>(L + RING_OFF, g, S, E, wave);
    }
#endif
    GROUP_BAR(8);
#if (PH_MASK >> 9) & 1
    if (IN(9)) {
        PHASE_WS bf16 *HB = WSP(WS_HB), *PB = WSP(WS_PB), *WP = WSP(WS_WP), *WG = WSP(WS_WG), *PP = WSP(WS_PP); float *RSQ3 = WSF(WS_RSQ3), *RSQ4 = WSF(WS_RSQ4); float* out = as_global(args.out);
        { pg8::Gemm g{PB, WP, M, D, DPLE / 2}; pg8::StaticOrder S; S.init(M, D, G, bx);
          pg8::EpiGate<0, true, true> E{PP, nullptr, 0, nullptr};
          pg8::gemm_phase<pg8::EpiGate<0, true, true>, pg8::StaticOrder, true, true, true>(L + RING_OFF, g, S, E, wave); }
        VM_WAIT(); __syncthreads();
        { pg8::Gemm g{WSP(WS_X8), WG, M, D, D / 2}; pg8::StaticOrder S; S.init(M, D, G, bx);
          { LANE_TID pg8::stage_rs(L, S, RSQ3, tid, 1.0f); }
          pg8::EpiPle<true> E{L, HB, PP, out, RSQ4, (unsigned*)(wsl + WS_CTL) + 32768, as_global(args.in[17])};
          pg8::gemm_phase<pg8::EpiPle<true>, pg8::StaticOrder, true, true, true>(L + RING_OFF, g, S, E, wave); }
    }
#endif
#undef IN
#undef GRID_BAR
}


#ifndef MK_SINGLE
#define MK_SINGLE 1
#endif
extern "C" void kernel_launch(void* const* d_in, const int* in_sizes, int n_in, void* d_out, int out_size, void* d_ws, size_t ws_size, hipStream_t stream) {
    static int grid = 0;
    if (grid == 0) {
        int dev = 0, cus = 0;
        if (ws_size < WS_END || hipGetDevice(&dev) != hipSuccess || hipDeviceGetAttribute(&cus, hipDeviceAttributeMultiprocessorCount, dev) != hipSuccess) { fprintf(stderr, "kernel_launch: setup failed (ws %zu)\n", ws_size); grid = -1; return; }
        if (hipFuncSetAttribute((const void*)mega, hipFuncAttributeMaxDynamicSharedMemorySize, LDS_BYTES) != hipSuccess) { fprintf(stderr, "kernel_launch: hipFuncSetAttribute failed\n"); grid = -1; return; }
        grid = cus;
    }
    if (grid < 0) return;
    (void)hipMemsetAsync((char*)d_ws + WS_CTL, 0, CTL_ZERO_BYTES, stream);
    Args a{};
    for (int i = 0; i < 18; ++i) a.in[i] = (const float*)d_in[i];
    a.out = (float*)d_out; a.ws = (unsigned char*)d_ws;
    if (MK_SINGLE) { a.use_bar = 1; a.ph_lo = 0; a.ph_hi = 10; hipLaunchKernelGGL(mega, dim3(grid), dim3(NWAVES * 64), LDS_BYTES, stream, a); }
    else { a.use_bar = 0;
#ifndef REP_MASK
#define REP_MASK 0
#endif
        for (int ph = 0; ph < 10; ++ph) { const int reps = 1 + ((REP_MASK >> ph) & 1); for (int r = 0; r < reps; ++r) { a.ph_lo = ph; a.ph_hi = ph + 1; hipLaunchKernelGGL(mega, dim3(grid), dim3(NWAVES * 64), LDS_BYTES, stream, a); } } }
}
```

```cpp
#include <hip/hip_runtime.h>
#include <cstdio>
#include <cstdint>

namespace pg8 {
#define PG8_LAS __attribute__((address_space(3)))
typedef unsigned short bf16_t;
typedef short bf16x8 __attribute__((ext_vector_type(8)));
typedef float f32x4 __attribute__((ext_vector_type(4)));
typedef unsigned u32x4 __attribute__((ext_vector_type(4)));
typedef unsigned u32x2 __attribute__((ext_vector_type(2)));
constexpr int BM = 256, BK = 64, HALF = 128, HTB = HALF * BK * 2, STAGE_BYTES = 8 * HTB, NXCD = 8, WGM = 8;

__host__ __device__ __forceinline__ int lds_byte(int r, int c) { const int st = (r >> 4) * 2 + (c >> 5), rr = r & 15, cc = c & 31, ob = rr * 64 + cc * 2; return st * 1024 + (ob ^ (((ob >> 9) & 1) << 5)); }
__host__ __device__ __forceinline__ void stage_rc(int b, int& R, int& C) { const int st = b / 1024, sb = b % 1024, swz = sb ^ (((sb >> 9) & 1) << 5); R = (st >> 1) * 16 + swz / 64; C = (st & 1) * 32 + (swz % 64) / 2; }
__host__ __device__ __forceinline__ int perm32(int rho) { const int n = rho >> 4, i = rho & 15; return 8 * (i >> 2) + 4 * n + (i & 3); }

struct Unit { int pm, pn, ord; };
struct Gemm { const bf16_t* A; const bf16_t* Bt; int M, N, K; };

struct StaticOrder {
    int nM, nN, nwg, G, c;
    __host__ __device__ void init(int M, int N, int G_, int c_) { nM = M / BM; nN = N / BM; nwg = nM * nN; G = G_; c = c_; }
    __host__ __device__ bool next(int i, Unit& u) const {
        const long L = (long)i * G + c; if (L >= nwg) return false;
        int wgid = (int)L; { const int q = nwg / NXCD, r = nwg % NXCD, xcd = wgid % NXCD, off = wgid / NXCD; wgid = (xcd < r ? xcd * (q + 1) : r * (q + 1) + (xcd - r) * q) + off; }
        const int nig = WGM * nN, gid = wgid / nig, fm = gid * WGM, gsz = (nM - fm) < WGM ? (nM - fm) : WGM;
        u.pm = fm + ((wgid % nig) % gsz); u.pn = (wgid % nig) / gsz; return true;
    }
    __device__ __forceinline__ void a_ready(const Unit&) const {}
    __device__ __forceinline__ void done(const Unit&) const {}
};

__device__ __forceinline__ unsigned cvt_pk_bf16(float lo, float hi) { unsigned r; asm volatile("v_cvt_pk_bf16_f32 %0, %1, %2" : "=v"(r) : "v"(lo), "v"(hi)); return r; }
__device__ __forceinline__ float bf_lo(unsigned w) { return __uint_as_float(w << 16); }
__device__ __forceinline__ float bf_hi(unsigned w) { return __uint_as_float(w & 0xffff0000u); }
__device__ __forceinline__ float fsigmoid(float x) { return __builtin_amdgcn_rcpf(1.0f + __builtin_amdgcn_exp2f(-1.4426950408889634f * x)); }
__device__ __forceinline__ float rs_of(const float* rsq, int row) {
    const f32x4* p = (const f32x4*)(rsq + (size_t)row * 16);
    const f32x4 a = p[0], b = p[1], c = p[2], d = p[3];
    const float s = ((a[0] + a[1]) + (a[2] + a[3])) + ((b[0] + b[1]) + (b[2] + b[3])) + ((c[0] + c[1]) + (c[2] + c[3])) + ((d[0] + d[1]) + (d[2] + d[3]));
    return __builtin_amdgcn_rsqf(s * (1.0f / 1024.0f) + 1e-6f);
}
__device__ __forceinline__ void rs8_of(const float* rsq, int row0, int fq, float (&rs)[2][4]) {
    f32x4 p[2][4];
#pragma unroll
    for (int ai = 0; ai < 2; ++ai)
#pragma unroll
        for (int m = 0; m < 4; ++m) p[ai][m] = *(const f32x4*)(rsq + (size_t)(row0 + ai * HALF + m * 16) * 16 + 4 * fq);
#pragma unroll
    for (int ai = 0; ai < 2; ++ai)
#pragma unroll
        for (int m = 0; m < 4; ++m) { float s = (p[ai][m][0] + p[ai][m][1]) + (p[ai][m][2] + p[ai][m][3]); s += __shfl_xor(s, 16); s += __shfl_xor(s, 32); rs[ai][m] = __builtin_amdgcn_rsqf(s * (1.0f / 1024.0f) + 1e-6f); }
}
constexpr int RS_LDS_OFF = 131072, RS_LDS_MAXU = 12;
template <class Sched> __device__ __forceinline__ void stage_rs(PG8_LAS unsigned char* lds0, const Sched& S, const float* rsq, int tid, float mul) {
    PG8_LAS float* tab = (PG8_LAS float*)(lds0 + RS_LDS_OFF);
    Unit u;
    for (int i = 0; i < RS_LDS_MAXU && S.next(i, u); ++i) if (tid < 256) tab[i * 256 + tid] = rs_of(rsq, u.pm * BM + tid) * mul;
    asm volatile("s_waitcnt lgkmcnt(0)" ::: "memory"); __builtin_amdgcn_s_barrier(); asm volatile("" ::: "memory");
}
__device__ __forceinline__ void rs8_lds(PG8_LAS unsigned char* lds0, int ord, int wr, int fr, float (&rs)[2][4]) {
    const PG8_LAS float* tab = (const PG8_LAS float*)(lds0 + RS_LDS_OFF) + ord * 256 + wr * 64 + fr;
#pragma unroll
    for (int ai = 0; ai < 2; ++ai)
#pragma unroll
        for (int m = 0; m < 4; ++m) rs[ai][m] = tab[ai * HALF + m * 16];
}
__device__ __forceinline__ u32x4 pack8(const f32x4 v0, const f32x4 v1) { u32x4 w; w.x = cvt_pk_bf16(v0[0], v0[1]); w.y = cvt_pk_bf16(v0[2], v0[3]); w.z = cvt_pk_bf16(v1[0], v1[1]); w.w = cvt_pk_bf16(v1[2], v1[3]); return w; }
__device__ __forceinline__ void unpack8(const u32x4 w, f32x4& v0, f32x4& v1) { v0 = (f32x4){bf_lo(w.x), bf_hi(w.x), bf_lo(w.y), bf_hi(w.y)}; v1 = (f32x4){bf_lo(w.z), bf_hi(w.z), bf_lo(w.w), bf_hi(w.w)}; }
__device__ __forceinline__ float sq8(const f32x4 a, const f32x4 b) { return ((a[0] * a[0] + a[1] * a[1]) + (a[2] * a[2] + a[3] * a[3])) + ((b[0] * b[0] + b[1] * b[1]) + (b[2] * b[2] + b[3] * b[3])); }

typedef float f32x2_ __attribute__((ext_vector_type(2)));
__device__ __forceinline__ void unpack8_f8(const u32x2 w, f32x4& v0, f32x4& v1) {
    const f32x2_ a = __builtin_amdgcn_cvt_pk_f32_fp8((int)w.x, false), b = __builtin_amdgcn_cvt_pk_f32_fp8((int)w.x, true), c = __builtin_amdgcn_cvt_pk_f32_fp8((int)w.y, false), d = __builtin_amdgcn_cvt_pk_f32_fp8((int)w.y, true);
    v0 = (f32x4){a[0], a[1], b[0], b[1]}; v1 = (f32x4){c[0], c[1], d[0], d[1]};
}
constexpr float F8_WSCALE = 64.0f;
__device__ __forceinline__ unsigned pack4_fp8(float a, float b, float c, float d) { int p = __builtin_amdgcn_cvt_pk_fp8_f32(a, b, 0, false); p = __builtin_amdgcn_cvt_pk_fp8_f32(c, d, p, true); return (unsigned)p; }
template <bool HAS_RS, bool F8, bool F8OUT = F8> struct EpiSwiglu {
    static constexpr bool PERM = true, AFTER_DRAIN = false;
    bf16_t* O; PG8_LAS unsigned char* lds0;
    __device__ __forceinline__ void operator()(const f32x4 (&acc)[2][2][4][2], const Unit& u, int wr, int wc, int fr, int fq) const {
        const int row0 = u.pm * BM + wr * 64 + fr, oc = u.pn * 128 + wc * 32 + 8 * fq;
        float rs8[2][4]; if (HAS_RS) rs8_lds(lds0, u.ord, wr, fr, rs8);
#pragma unroll
        for (int ai = 0; ai < 2; ++ai)
#pragma unroll
            for (int m = 0; m < 4; ++m) {
                const int row = row0 + ai * HALF + m * 16;
                float rs = F8 ? (1.0f / F8_WSCALE) : 1.f; if (HAS_RS) rs *= rs8[ai][m];
                const float rsl = -1.4426950408889634f * rs, rs2 = rs * rs;
                f32x4 o0, o1;
#pragma unroll
                for (int j = 0; j < 4; ++j) {
                    const float A0 = acc[ai][0][m][0][j], A1 = acc[ai][0][m][1][j];
                    const float r0 = __builtin_amdgcn_rcpf(1.0f + __builtin_amdgcn_exp2f(A0 * rsl)), r1 = __builtin_amdgcn_rcpf(1.0f + __builtin_amdgcn_exp2f(A1 * rsl));
                    o0[j] = (A0 * acc[ai][1][m][0][j]) * (r0 * rs2); o1[j] = (A1 * acc[ai][1][m][1][j]) * (r1 * rs2);
                }
                if (F8OUT) { u32x2 w; w.x = pack4_fp8(o0[0], o0[1], o0[2], o0[3]); w.y = pack4_fp8(o1[0], o1[1], o1[2], o1[3]); *(u32x2*)((unsigned char*)O + (size_t)row * 2816 + oc) = w; }
                else *(u32x4*)(O + (size_t)row * 2816 + oc) = pack8(o0, o1);
            }
    }
};
template <bool SRC_F32, bool HALF_ALPHA, bool F8IN, bool F8COPY> struct EpiResid {
    static constexpr bool PERM = true, AFTER_DRAIN = false;
    const float* X; bf16_t* H; float* rsq_out; unsigned char* H8;
    __device__ __forceinline__ void operator()(const f32x4 (&acc)[2][2][4][2], const Unit& u, int wr, int wc, int fr, int fq) const {
        const int row0 = u.pm * BM + wr * 64 + fr, c0 = u.pn * BM + wc * 32 + 8 * fq;
        const float alpha = (HALF_ALPHA ? 0.5f : 1.0f) * (F8IN ? (1.0f / F8_WSCALE) : 1.0f);
#pragma unroll
        for (int ai = 0; ai < 2; ++ai) {
            u32x4 rb[4][2]; f32x4 rf[SRC_F32 ? 4 : 1][2][2];
            if (!SRC_F32) {
#pragma unroll
                for (int m = 0; m < 4; ++m)
#pragma unroll
                    for (int bj = 0; bj < 2; ++bj) rb[m][bj] = *(const u32x4*)(H + (size_t)(row0 + ai * HALF + m * 16) * 1024 + c0 + bj * HALF);
            }
#pragma unroll
            for (int mh = 0; mh < 2; ++mh) {
                if (SRC_F32) {
#pragma unroll
                    for (int m2 = 0; m2 < 2; ++m2)
#pragma unroll
                        for (int bj = 0; bj < 2; ++bj) { const float* xp = X + (size_t)(row0 + ai * HALF + (2 * mh + m2) * 16) * 1024 + c0 + bj * HALF; rf[2 * mh + m2][bj][0] = *(const f32x4*)xp; rf[2 * mh + m2][bj][1] = *(const f32x4*)(xp + 4); }
                }
#pragma unroll
                for (int m2 = 0; m2 < 2; ++m2) {
                    const int m = 2 * mh + m2, row = row0 + ai * HALF + m * 16; float sq = 0.f;
#pragma unroll
                    for (int bj = 0; bj < 2; ++bj) {
                        const size_t off = (size_t)row * 1024 + c0 + bj * HALF; f32x4 r0, r1;
                        if (SRC_F32) { r0 = rf[m][bj][0]; r1 = rf[m][bj][1]; } else unpack8(rb[m][bj], r0, r1);
                        const f32x4 v0 = r0 + alpha * acc[ai][bj][m][0], v1 = r1 + alpha * acc[ai][bj][m][1];
                        sq += sq8(v0, v1);
                        *(u32x4*)(H + off) = pack8(v0, v1);
                        if (F8COPY) { u32x2 w8; w8.x = pack4_fp8(v0[0], v0[1], v0[2], v0[3]); w8.y = pack4_fp8(v1[0], v1[1], v1[2], v1[3]); *(u32x2*)(H8 + off) = w8; }
                    }
                    sq += __shfl_xor(sq, 16); sq += __shfl_xor(sq, 32);
                    if (fq == 0) rsq_out[(size_t)row * 16 + u.pn * 4 + wc] = sq;
                }
                asm volatile("" ::: "memory");
            }
        }
    }
};
constexpr size_t PJ_MiB = 1u << 20, PJ_AQ = 336 * PJ_MiB, PJ_BQ = 368 * PJ_MiB, PJ_IQ = 400 * PJ_MiB, PJ_AK = 432 * PJ_MiB, PJ_AVT = 440 * PJ_MiB, PJ_BK = 448 * PJ_MiB, PJ_BV = 452 * PJ_MiB, PJ_IK = 456 * PJ_MiB, PJ_IW = 9 * PJ_MiB;
struct EpiProj {
    static constexpr bool PERM = true, AFTER_DRAIN = false;
    PG8_LAS unsigned char* lds0; unsigned char* wsb; bf16_t* SG;
    __device__ __forceinline__ void dest(int pn, int cw, bf16_t*& base, int& stride, int& col0, int& kind) const {
        kind = 0; base = SG; stride = 2048; col0 = 0;
        if (pn < 2) { base = (bf16_t*)(wsb + PJ_AQ); stride = 512; col0 = pn * 256 + cw; }
        else if (pn == 2) { if (cw < 128) { base = (bf16_t*)(wsb + PJ_AK); stride = 128; col0 = cw; } else { kind = 2; base = (bf16_t*)(wsb + PJ_AVT); col0 = cw - 128; } }
        else if (pn < 5) { base = (bf16_t*)(wsb + PJ_BQ); stride = 512; col0 = (pn - 3) * 256 + cw; }
        else if (pn == 5) { stride = 64;
            if (cw < 64) { base = (bf16_t*)(wsb + PJ_BK); col0 = cw; } else if (cw < 128) { base = (bf16_t*)(wsb + PJ_BV); col0 = cw - 64; } else if (cw < 192) { base = (bf16_t*)(wsb + PJ_IK); col0 = cw - 128; }
            else if (cw == 192) { kind = 3; base = (bf16_t*)(wsb + PJ_IW); } else kind = 4; }
        else if (pn < 8) { base = (bf16_t*)(wsb + PJ_IQ); stride = 512; col0 = (pn - 6) * 256 + cw; }
        else { kind = 1; col0 = (pn - 8) * 256 + cw; }
    }
    __device__ __forceinline__ void operator()(const f32x4 (&acc)[2][2][4][2], const Unit& u, int wr, int wc, int fr, int fq) const {
        const int row0 = u.pm * BM + wr * 64 + fr;
        bf16_t *base0, *base1; int st0, st1, c00, c01, k0, k1;
        dest(u.pn, wc * 32, base0, st0, c00, k0); dest(u.pn, HALF + wc * 32, base1, st1, c01, k1);
        float rs8[2][4]; rs8_lds(lds0, u.ord, wr, fr, rs8);
#pragma unroll
        for (int ai = 0; ai < 2; ++ai)
#pragma unroll
            for (int m = 0; m < 4; ++m) {
                const int row = row0 + ai * HALF + m * 16; const float rs = rs8[ai][m];
#pragma unroll
                for (int bj = 0; bj < 2; ++bj) {
                    bf16_t* base = bj ? base1 : base0; const int stride = bj ? st1 : st0, col0 = bj ? c01 : c00, kind = bj ? k1 : k0;
                    f32x4 v0 = acc[ai][bj][m][0] * rs, v1 = acc[ai][bj][m][1] * rs;
                    if (kind == 1) {
#pragma unroll
                        for (int j = 0; j < 4; ++j) { v0[j] = fsigmoid(v0[j]); v1[j] = fsigmoid(v1[j]); }
                    }
                    if (kind <= 1) { *(u32x4*)(base + (size_t)row * stride + col0 + 8 * fq) = pack8(v0, v1); }
                    else if (kind == 2) { const int i = col0 + 8 * fq, g = i >> 6, d = i & 63, b = row >> 13, t = row & 8191; bf16_t* p = base + ((size_t)((b * 2 + g) * 64 + d)) * 8192 + t; const u32x4 w = pack8(v0, v1);
                        p[0] = (bf16_t)(w.x & 0xffffu); p[8192] = (bf16_t)(w.x >> 16); p[2 * 8192] = (bf16_t)(w.y & 0xffffu); p[3 * 8192] = (bf16_t)(w.y >> 16);
                        p[4 * 8192] = (bf16_t)(w.z & 0xffffu); p[5 * 8192] = (bf16_t)(w.z >> 16); p[6 * 8192] = (bf16_t)(w.w & 0xffffu); p[7 * 8192] = (bf16_t)(w.w >> 16); }
                    else if (kind == 3) { if (fq == 0) { float* iw = (float*)base + (size_t)row * 8; *(f32x4*)iw = v0; *(f32x4*)(iw + 4) = v1; } }
                }
                asm volatile("" ::: "memory");
            }
    }
};
struct EpiSig {
    static constexpr bool PERM = true, AFTER_DRAIN = false;
    PG8_LAS unsigned char* lds0; bf16_t* SG;
    __device__ __forceinline__ void operator()(const f32x4 (&acc)[2][2][4][2], const Unit& u, int wr, int wc, int fr, int fq) const {
        const int row0 = u.pm * BM + wr * 64 + fr, c0 = u.pn * BM + wc * 32 + 8 * fq;
        float rs8[2][4]; rs8_lds(lds0, u.ord, wr, fr, rs8);
#pragma unroll
        for (int ai = 0; ai < 2; ++ai)
#pragma unroll
            for (int m = 0; m < 4; ++m) {
                const int row = row0 + ai * HALF + m * 16; const float rs = rs8[ai][m] * (1.0f / F8_WSCALE);
#pragma unroll
                for (int bj = 0; bj < 2; ++bj) {
                    f32x4 v0 = acc[ai][bj][m][0] * rs, v1 = acc[ai][bj][m][1] * rs;
#pragma unroll
                    for (int j = 0; j < 4; ++j) { v0[j] = fsigmoid(v0[j]); v1[j] = fsigmoid(v1[j]); }
                    { u32x2 w8; w8.x = pack4_fp8(v0[0], v0[1], v0[2], v0[3]); w8.y = pack4_fp8(v1[0], v1[1], v1[2], v1[3]); *(u32x2*)((unsigned char*)SG + (size_t)row * 2048 + c0 + bj * HALF) = w8; }
                }
            }
    }
};
template <int MODE, bool F8OUT = false, bool F8IN = false> struct EpiGate {
    static constexpr bool PERM = true, AFTER_DRAIN = false;
    bf16_t* O; const bf16_t* G; int gofs; const bf16_t* P;
    __device__ __forceinline__ void operator()(const f32x4 (&acc)[2][2][4][2], const Unit& u, int wr, int wc, int fr, int fq) const {
        const int row0 = u.pm * BM + wr * 64 + fr, c0 = u.pn * BM + wc * 32 + 8 * fq;
#pragma unroll
        for (int ai = 0; ai < 2; ++ai) {
            u32x2 gv[4][2], pv[4][2];
            if (MODE >= 1) {
#pragma unroll
                for (int m = 0; m < 4; ++m)
#pragma unroll
                    for (int bj = 0; bj < 2; ++bj) gv[m][bj] = *(const u32x2*)((const unsigned char*)G + (size_t)(row0 + ai * HALF + m * 16) * 2048 + gofs + c0 + bj * HALF);
            }
            if (MODE == 2) {
#pragma unroll
                for (int m = 0; m < 4; ++m)
#pragma unroll
                    for (int bj = 0; bj < 2; ++bj) pv[m][bj] = *(const u32x2*)((const unsigned char*)P + (size_t)(row0 + ai * HALF + m * 16) * 1024 + c0 + bj * HALF);
            }
#pragma unroll
            for (int m = 0; m < 4; ++m) {
                const int row = row0 + ai * HALF + m * 16;
#pragma unroll
                for (int bj = 0; bj < 2; ++bj) {
                    const int col = c0 + bj * HALF; f32x4 v0 = acc[ai][bj][m][0], v1 = acc[ai][bj][m][1];
                    if (F8IN) { v0 = v0 * (1.0f / F8_WSCALE); v1 = v1 * (1.0f / F8_WSCALE); }
                    if (MODE >= 1) { f32x4 g0, g1; unpack8_f8(gv[m][bj], g0, g1); v0 = v0 * g0; v1 = v1 * g1; }
                    if (MODE == 2) { f32x4 p0, p1; unpack8_f8(pv[m][bj], p0, p1); v0 = v0 + p0; v1 = v1 + p1; }
                    if (F8OUT) { u32x2 w8; w8.x = pack4_fp8(v0[0], v0[1], v0[2], v0[3]); w8.y = pack4_fp8(v1[0], v1[1], v1[2], v1[3]); *(u32x2*)((unsigned char*)O + (size_t)row * 1024 + col) = w8; }
                    else *(u32x4*)(O + (size_t)row * 1024 + col) = pack8(v0, v1);
                }
            }
            asm volatile("" ::: "memory");
        }
    }
};
template <bool F8IN> struct EpiPle {
    static constexpr bool PERM = true, AFTER_DRAIN = false;
    PG8_LAS unsigned char* lds0; const bf16_t* H; const bf16_t* PP; float* out; float* rsq_out; unsigned* cnt; const float* gfin;
    __device__ __forceinline__ void operator()(f32x4 (&acc)[2][2][4][2], const Unit& u, int wr, int wc, int fr, int fq) const {
        const int row0 = u.pm * BM + wr * 64 + fr, c0 = u.pn * BM + wc * 32 + 8 * fq;
        float rs8[2][4]; rs8_lds(lds0, u.ord, wr, fr, rs8);
#pragma unroll
        for (int aim = 0; aim < 4; ++aim) {
            const int ai = aim >> 1;
            u32x4 hv[2][2]; u32x2 qv[2][2];
#pragma unroll
            for (int m2 = 0; m2 < 2; ++m2)
#pragma unroll
                for (int bj = 0; bj < 2; ++bj) { const size_t off = (size_t)(row0 + ai * HALF + (2 * (aim & 1) + m2) * 16) * 1024 + c0 + bj * HALF; hv[m2][bj] = *(const u32x4*)(H + off); qv[m2][bj] = *(const u32x2*)((const unsigned char*)PP + off); }
#pragma unroll
            for (int m2 = 0; m2 < 2; ++m2) {
                const int m = 2 * (aim & 1) + m2;
                const int row = row0 + ai * HALF + m * 16; const float rs = rs8[ai][m] * (F8IN ? (1.0f / F8_WSCALE) : 1.0f); float sq = 0.f;
#pragma unroll
                for (int bj = 0; bj < 2; ++bj) {
                    f32x4 h0, h1, p0, p1; unpack8(hv[m2][bj], h0, h1); unpack8_f8(qv[m2][bj], p0, p1);
                    f32x4 v0 = acc[ai][bj][m][0] * rs, v1 = acc[ai][bj][m][1] * rs;
#pragma unroll
                    for (int j = 0; j < 4; ++j) { v0[j] = h0[j] + fsigmoid(v0[j]) * p0[j]; v1[j] = h1[j] + fsigmoid(v1[j]) * p1[j]; }
                    sq += sq8(v0, v1);
                    acc[ai][bj][m][0] = v0; acc[ai][bj][m][1] = v1;
                }
                sq += __shfl_xor(sq, 16); sq += __shfl_xor(sq, 32);
                if (fq == 0) __hip_atomic_store((unsigned*)(rsq_out + (size_t)row * 16 + u.pn * 4 + wc), __float_as_uint(sq), __ATOMIC_RELAXED, __HIP_MEMORY_SCOPE_AGENT);
            }
            asm volatile("" ::: "memory");
        }
        asm volatile("s_waitcnt vmcnt(0)" ::: "memory");
        unsigned* pc = cnt + 64 * u.pm;
        if ((fr | fq) == 0) __hip_atomic_fetch_add(pc, 1u, __ATOMIC_RELAXED, __HIP_MEMORY_SCOPE_AGENT);
        { unsigned spins = 0;
          while ((unsigned)__builtin_amdgcn_readfirstlane(__hip_atomic_load(pc, __ATOMIC_RELAXED, __HIP_MEMORY_SCOPE_AGENT)) < 32u) { __builtin_amdgcn_s_sleep(2); if (++spins > (1u << 22)) break; } }
        __builtin_amdgcn_fence(__ATOMIC_ACQUIRE, "agent");
        asm volatile("s_waitcnt vmcnt(0)" ::: "memory");
        f32x4 g00 = *(const f32x4*)(gfin + c0), g01 = *(const f32x4*)(gfin + c0 + 4), g10 = *(const f32x4*)(gfin + c0 + HALF), g11 = *(const f32x4*)(gfin + c0 + HALF + 4);
        float rf8[2][4]; rs8_of(rsq_out, row0, fq, rf8);
#pragma unroll
        for (int ai = 0; ai < 2; ++ai)
#pragma unroll
            for (int m = 0; m < 4; ++m) {
                const int row = row0 + ai * HALF + m * 16; const float rs = rf8[ai][m];
                const size_t off = (size_t)row * 1024 + c0;
                *(f32x4*)(out + off) = acc[ai][0][m][0] * rs * g00; *(f32x4*)(out + off + 4) = acc[ai][0][m][1] * rs * g01;
                *(f32x4*)(out + off + HALF) = acc[ai][1][m][0] * rs * g10; *(f32x4*)(out + off + HALF + 4) = acc[ai][1][m][1] * rs * g11;
                asm volatile("" ::: "memory");
            }
    }
};

template <class Epi, class Sched, bool ALIGN_EPI = false, bool SP2 = false, bool F8 = false>
__device__ __forceinline__ void gemm_phase(PG8_LAS unsigned char* lds, const Gemm g, const Sched& S, const Epi& E, int wid_s) {
    int lane_o; asm volatile("v_mbcnt_lo_u32_b32 %0, -1, 0\n\tv_mbcnt_hi_u32_b32 %0, -1, %0" : "=v"(lane_o)); const int tid = wid_s * 64 + lane_o;
    const int wid = __builtin_amdgcn_readfirstlane(tid >> 6), lane = tid & 63, wr = wid >> 2, wc = wid & 3, fr = lane & 15, fq = lane >> 4;
    int f8scale_ = 0x7f7f7f7f; if constexpr (F8) asm volatile("" : "+v"(f8scale_));     (void)f8scale_;
    const int K = g.K, nt = K / BK;
    unsigned voffA[2], voffB[2];
#pragma unroll
    for (int i = 0; i < 2; ++i) { int R, C; stage_rc(tid * 16 + i * 8192, R, C); const int Rb = Epi::PERM ? ((R & ~31) + perm32(R & 31)) : R;
        voffA[i] = (unsigned)(R * K + C) * 2u; voffB[i] = (unsigned)(Rb * K + C) * 2u; }
    const size_t kstep = (size_t)(BK * 2);
    const size_t hstep = (size_t)HALF * K * 2;
    const size_t tstep = 2 * hstep;
    const unsigned ldsw = (unsigned)wid * 1024u;
    const int aoff = lds_byte(wr * 64 + fr, fq * 8), boff = lds_byte(wc * 32 + fr, fq * 8);
#define PG8_SA(b, h) (((b) * 2 + (h)) * HTB)
#define PG8_SB(b, h) ((4 + (b) * 2 + (h)) * HTB)
#define PG8_STAGE(bufoff, gbase, voff) do { _Pragma("unroll") for (int _i = 0; _i < 2; ++_i) \
        __builtin_amdgcn_global_load_lds((const unsigned*)((const char*)(gbase) + (voff)[_i]), (PG8_LAS unsigned*)(lds + (bufoff) + ldsw + _i * 8192), 16, 0, 0); } while (0)
#define PG8_LDA(dst, b, h) do { _Pragma("unroll") for (int m = 0; m < 4; ++m) _Pragma("unroll") for (int k = 0; k < 2; ++k) dst[m][k] = *(const PG8_LAS bf16x8*)(lds + PG8_SA(b, h) + aoff + m * 2048 + k * 1024); } while (0)
#define PG8_LDB(dst, b, h) do { _Pragma("unroll") for (int n = 0; n < 2; ++n) _Pragma("unroll") for (int k = 0; k < 2; ++k) dst[n][k] = *(const PG8_LAS bf16x8*)(lds + PG8_SB(b, h) + boff + n * 2048 + k * 1024); } while (0)
#define PG8_MMA(ai, bj, At, Bt) do { __builtin_amdgcn_s_setprio(1); \
        if constexpr (F8) { typedef int v8i_ __attribute__((ext_vector_type(8))); typedef int v4i_ __attribute__((ext_vector_type(4))); \
            _Pragma("unroll") for (int m = 0; m < 4; ++m) _Pragma("unroll") for (int n = 0; n < 2; ++n) { \
                const v4i_ b0_ = __builtin_bit_cast(v4i_, Bt[n][0]), b1_ = __builtin_bit_cast(v4i_, Bt[n][1]), a0_ = __builtin_bit_cast(v4i_, At[m][0]), a1_ = __builtin_bit_cast(v4i_, At[m][1]); \
                const v8i_ bb_ = {b0_[0], b0_[1], b0_[2], b0_[3], b1_[0], b1_[1], b1_[2], b1_[3]}, aa_ = {a0_[0], a0_[1], a0_[2], a0_[3], a1_[0], a1_[1], a1_[2], a1_[3]}; \
                asm volatile("v_mfma_scale_f32_16x16x128_f8f6f4 %0, %1, %2, %0, %3, %3 op_sel_hi:[0,0,0]" : "+v"(acc[ai][bj][m][n]) : "v"(bb_), "v"(aa_), "v"(f8scale_)); } } \
        else { _Pragma("unroll") for (int m = 0; m < 4; ++m) _Pragma("unroll") for (int n = 0; n < 2; ++n) _Pragma("unroll") for (int k = 0; k < 2; ++k) \
            acc[ai][bj][m][n] = __builtin_amdgcn_mfma_f32_16x16x32_bf16(Bt[n][k], At[m][k], acc[ai][bj][m][n], 0, 0, 0); } \
        __builtin_amdgcn_s_setprio(0); } while (0)
#define PG8_WAIT_V(n) asm volatile("s_waitcnt vmcnt(" #n ")" ::: "memory")
#define PG8_WAIT_L(n) asm volatile("s_waitcnt lgkmcnt(" #n ")" ::: "memory")
#define PG8_BAR __builtin_amdgcn_s_barrier()
#define PG8_SCHED __builtin_amdgcn_sched_barrier(0)
    Unit cur, nxt; int ui = 0;
    if (!S.next(0, cur)) return;
    cur.ord = 0;
    f32x4 acc[2][2][4][2];
#pragma unroll
    for (int a = 0; a < 2; ++a)
#pragma unroll
        for (int b = 0; b < 2; ++b)
#pragma unroll
            for (int m = 0; m < 4; ++m)
#pragma unroll
                for (int n = 0; n < 2; ++n) acc[a][b][m][n] = (f32x4){0.f, 0.f, 0.f, 0.f};
    bf16x8 At[4][2], B0[2][2], B1[2][2];
    const char* cA = (const char*)g.A + (size_t)cur.pm * tstep; const char* cB = (const char*)g.Bt + (size_t)cur.pn * tstep;
    S.a_ready(cur);
    if constexpr (SP2) {
        PG8_STAGE(PG8_SB(0, 0), cB, voffB); PG8_STAGE(PG8_SB(0, 1), cB + hstep, voffB); PG8_STAGE(PG8_SA(0, 0), cA, voffA); PG8_STAGE(PG8_SA(0, 1), cA + hstep, voffA);
        if (wr == 1) PG8_BAR;
        PG8_WAIT_V(2); PG8_BAR;
        PG8_STAGE(PG8_SB(1, 0), cB + kstep, voffB); PG8_STAGE(PG8_SA(1, 0), cA + kstep, voffA); PG8_STAGE(PG8_SB(1, 1), cB + hstep + kstep, voffB);
        PG8_WAIT_V(6); PG8_BAR;
    } else {
        PG8_STAGE(PG8_SB(0, 0), cB, voffB); PG8_STAGE(PG8_SA(0, 0), cA, voffA); PG8_STAGE(PG8_SB(0, 1), cB + hstep, voffB); PG8_STAGE(PG8_SA(0, 1), cA + hstep, voffA);
        if (wr == 1) PG8_BAR;
        PG8_WAIT_V(4); PG8_BAR;
        PG8_STAGE(PG8_SB(1, 0), cB + kstep, voffB); PG8_STAGE(PG8_SA(1, 0), cA + kstep, voffA); PG8_STAGE(PG8_SB(1, 1), cB + hstep + kstep, voffB);
        PG8_WAIT_V(6); PG8_BAR;
    }
    for (;;) {
        const bool has_next = S.next(ui + 1, nxt); nxt.ord = ui + 1;
        const char* nA = has_next ? (const char*)g.A + (size_t)nxt.pm * tstep : cA; const char* nB = has_next ? (const char*)g.Bt + (size_t)nxt.pn * tstep : cB;
        for (int t = 0; t < nt; t += 2) {
            const bool last = (t == nt - 2);
            const char* a1 = cA + (size_t)(t + 1) * kstep;
            const char* a2 = last ? nA : cA + (size_t)(t + 2) * kstep; const char* b2 = last ? nB : cB + (size_t)(t + 2) * kstep;
            const char* a3 = a2 + kstep; const char* b3 = b2 + kstep;
            if (last && has_next) S.a_ready(nxt);
            if constexpr (SP2) {
            PG8_LDB(B0, 0, 0); PG8_LDB(B1, 0, 1); PG8_SCHED; PG8_LDA(At, 0, 0); PG8_STAGE(PG8_SA(1, 1), a1 + hstep, voffA);
            PG8_WAIT_V(8); PG8_WAIT_L(0); PG8_BAR; PG8_MMA(0, 0, At, B0); PG8_MMA(0, 1, At, B1); PG8_BAR; PG8_SCHED;
            PG8_LDA(At, 0, 1); PG8_STAGE(PG8_SB(0, 0), b2, voffB); PG8_STAGE(PG8_SB(0, 1), b2 + hstep, voffB); PG8_STAGE(PG8_SA(0, 0), a2, voffA);
            PG8_WAIT_V(8); PG8_WAIT_L(0); PG8_BAR; PG8_MMA(1, 0, At, B0); PG8_MMA(1, 1, At, B1); PG8_BAR; PG8_SCHED;
            PG8_LDB(B0, 1, 0); PG8_LDB(B1, 1, 1); PG8_SCHED; PG8_LDA(At, 1, 0); PG8_STAGE(PG8_SA(0, 1), a2 + hstep, voffA);
            PG8_WAIT_V(8); PG8_WAIT_L(0); PG8_BAR; PG8_MMA(0, 0, At, B0); PG8_MMA(0, 1, At, B1); PG8_BAR; PG8_SCHED;
            PG8_LDA(At, 1, 1); PG8_STAGE(PG8_SB(1, 0), b3, voffB); PG8_STAGE(PG8_SB(1, 1), b3 + hstep, voffB); PG8_STAGE(PG8_SA(1, 0), a3, voffA);
            PG8_WAIT_V(8); PG8_WAIT_L(0); PG8_BAR; PG8_MMA(1, 0, At, B0); PG8_MMA(1, 1, At, B1); PG8_BAR; PG8_SCHED;
            } else {
            PG8_LDB(B0, 0, 0); PG8_SCHED; PG8_LDA(At, 0, 0); PG8_STAGE(PG8_SA(1, 1), a1 + hstep, voffA);
            PG8_WAIT_L(8); PG8_BAR; PG8_WAIT_L(0); PG8_MMA(0, 0, At, B0); PG8_BAR; PG8_SCHED;
            PG8_LDB(B1, 0, 1); PG8_STAGE(PG8_SB(0, 0), b2, voffB);
            PG8_BAR; PG8_WAIT_L(0); PG8_MMA(0, 1, At, B1); PG8_BAR;
            PG8_LDA(At, 0, 1); PG8_STAGE(PG8_SA(0, 0), a2, voffA);
            PG8_BAR; PG8_WAIT_L(0); PG8_MMA(1, 0, At, B0); PG8_BAR; PG8_SCHED;
            PG8_STAGE(PG8_SB(0, 1), b2 + hstep, voffB);
            PG8_WAIT_V(6); PG8_BAR; PG8_MMA(1, 1, At, B1); PG8_BAR;
            PG8_LDB(B0, 1, 0); PG8_SCHED; PG8_LDA(At, 1, 0); PG8_STAGE(PG8_SA(0, 1), a2 + hstep, voffA);
            PG8_WAIT_L(8); PG8_BAR; PG8_WAIT_L(0); PG8_MMA(0, 0, At, B0); PG8_BAR; PG8_SCHED;
            PG8_LDB(B1, 1, 1); PG8_STAGE(PG8_SB(1, 0), b3, voffB);
            PG8_BAR; PG8_WAIT_L(0); PG8_MMA(0, 1, At, B1); PG8_BAR;
            PG8_LDA(At, 1, 1); PG8_STAGE(PG8_SA(1, 0), a3, voffA);
            PG8_BAR; PG8_WAIT_L(0); PG8_MMA(1, 0, At, B0); PG8_BAR; PG8_SCHED;
            PG8_STAGE(PG8_SB(1, 1), b3 + hstep, voffB);
            PG8_WAIT_V(6); PG8_BAR; PG8_MMA(1, 1, At, B1); PG8_BAR;
            }
        }
        if constexpr (F8) asm volatile("s_nop 15\n\ts_nop 15" ::: "memory");
        if constexpr (ALIGN_EPI) { if (wr == 0) PG8_BAR; }
        if constexpr (!Epi::AFTER_DRAIN) { E(acc, cur, wr, wc, fr, fq); S.done(cur); }
        if (!has_next) break;
#pragma unroll
        for (int a = 0; a < 2; ++a)
#pragma unroll
            for (int b = 0; b < 2; ++b)
#pragma unroll
                for (int m = 0; m < 4; ++m)
#pragma unroll
                    for (int n = 0; n < 2; ++n) acc[a][b][m][n] = (f32x4){0.f, 0.f, 0.f, 0.f};
        cur = nxt; cA = nA; cB = nB; ++ui;
        if constexpr (ALIGN_EPI) { if (wr == 1) PG8_BAR; }
    }
    PG8_WAIT_V(0);
    if constexpr (!ALIGN_EPI) { if (wr == 0) PG8_BAR; }
    PG8_BAR;
    if constexpr (Epi::AFTER_DRAIN) { E.fused(acc, cur, wr, wc, fr, fq, lds, wid, lane); S.done(cur); }
#undef PG8_SA
#undef PG8_SB
#undef PG8_STAGE
#undef PG8_LDA
#undef PG8_LDB
#undef PG8_MMA
#undef PG8_WAIT_V
#undef PG8_WAIT_L
#undef PG8_BAR
#undef PG8_SCHED
}
}

#define GAS __attribute__((address_space(1)))
#define LAS __attribute__((address_space(3)))
typedef unsigned short bf16;
typedef unsigned v4u __attribute__((ext_vector_type(4)));
typedef float f32x4 __attribute__((ext_vector_type(4)));
typedef short bf16x8 __attribute__((ext_vector_type(8)));
typedef GAS unsigned gu32;
typedef GAS unsigned long long gu64;
#define RLX_AGENT __ATOMIC_RELAXED, __HIP_MEMORY_SCOPE_AGENT

#define XB_TMO      128
#define XB_XCNT(j)  (256  + 64 * (j))
#define XB_XSUB(j)  (1280 + 64 * (j))
#define XB_XGEN(j)  (2304 + 64 * (j))
#define XB_TOP      3328
#define XB_TOPGEN   3392
#define XCD_BAR_WORDS 3456
#define XB_SPIN_CAP (1u << 18)

__device__ __forceinline__ unsigned xb_ld(unsigned* p)              { return __hip_atomic_load(p, __ATOMIC_RELAXED, __HIP_MEMORY_SCOPE_AGENT); }
__device__ __forceinline__ unsigned xb_add(unsigned* p, unsigned v) { return __hip_atomic_fetch_add(p, v, __ATOMIC_RELAXED, __HIP_MEMORY_SCOPE_AGENT); }
__device__ __forceinline__ unsigned xb_xcc_id() { return (unsigned)__builtin_amdgcn_s_getreg((3 << 11) | 20) & 0xFu; }
#define XB_SPIN(cond, bar) do { unsigned _sp = 0; while (cond) { __builtin_amdgcn_s_sleep(1); \
    if ((++_sp & 255u) == 0u) { if (xb_ld(&(bar)[XB_TMO])) break; if (_sp > XB_SPIN_CAP) { atomicAdd(&(bar)[XB_TMO], 1u); break; } } } } while (0)

struct XcdBarrier {
    unsigned* bar; unsigned x;
    volatile LAS unsigned* st;
};

__device__ __forceinline__ XcdBarrier xcd_barrier_post(unsigned* bar, volatile LAS unsigned* st) {
    XcdBarrier b; b.bar = bar; b.x = xb_xcc_id(); b.st = st;
    if (threadIdx.x == 0) (void)xb_add(&bar[XB_XCNT(b.x)], 1u);
    return b;
}
__device__ __forceinline__ void xcd_barrier_complete(unsigned* bar, unsigned x, unsigned& nloc, unsigned& nx) {
    const unsigned G = gridDim.x * gridDim.y * gridDim.z;
    unsigned sum, cnt, mine, sp = 0u;
    for (;;) {
        sum = 0u; cnt = 0u; mine = 0u;
#pragma unroll
        for (unsigned j = 0; j < 16; ++j) { const unsigned c = xb_ld(&bar[XB_XCNT(j)]); sum += c; cnt += (c > 0u) ? 1u : 0u; mine = (j == x) ? c : mine; }
        if (sum == G) break;
        __builtin_amdgcn_s_sleep(1);
        if ((++sp & 255u) == 0u) { if (xb_ld(&bar[XB_TMO])) break; if (sp > XB_SPIN_CAP) { atomicAdd(&bar[XB_TMO], 1u); break; } }
    }
    nloc = mine > 0u ? mine : 1u; nx = cnt > 0u ? cnt : 1u;
}

__device__ __forceinline__ void xcd_barrier(const XcdBarrier& b) {
    asm volatile("s_waitcnt vmcnt(0)" ::: "memory");
    __syncthreads();
    if (threadIdx.x == 0) {
        unsigned* bar = b.bar;
        __builtin_amdgcn_s_waitcnt(0);
        unsigned nloc = b.st[0], nx = b.st[1];
        if (nloc == 0u) { xcd_barrier_complete(bar, b.x, nloc, nx); b.st[0] = nloc; b.st[1] = nx; }
        const unsigned old = xb_add(&bar[XB_XSUB(b.x)], 1u);
        const unsigned gen = old / nloc;
        if (old + 1u == (gen + 1u) * nloc) {
            __builtin_amdgcn_fence(__ATOMIC_RELEASE, "agent");
            asm volatile("s_waitcnt vmcnt(0)" ::: "memory");
            const unsigned og = xb_add(&bar[XB_TOP], 1u);
            const unsigned tg = og / nx;
            if (og + 1u == (tg + 1u) * nx) xb_add(&bar[XB_TOPGEN], 1u);
            else XB_SPIN(xb_ld(&bar[XB_TOPGEN]) == tg, bar);
            __builtin_amdgcn_fence(__ATOMIC_ACQUIRE, "agent");
            xb_add(&bar[XB_XGEN(b.x)], 1u);
            asm volatile("s_waitcnt vmcnt(0)" ::: "memory");
        } else {
            XB_SPIN(xb_ld(&bar[XB_XGEN(b.x)]) == gen, bar);
            __builtin_amdgcn_fence(__ATOMIC_ACQUIRE, "agent");
            asm volatile("s_waitcnt vmcnt(0)" ::: "memory");
        }
    }
    __syncthreads();
}

constexpr int BATCH = 4, T = 8192, D = 1024, M = BATCH * T, FF = 2816, DPLE = 256, DIN = 4040;
constexpr int NWAVES = 8;
constexpr size_t MiB = 1u << 20;
constexpr size_t WS_CTL = 0, CTL_ZERO_BYTES = 1 * MiB;
constexpr size_t WS_RSQ1 = 1 * MiB, WS_RSQ2 = 3 * MiB, WS_RSQ3 = 5 * MiB, WS_RSQ4 = 7 * MiB, WS_IW = 9 * MiB;
constexpr size_t WS_W1 = 10 * MiB, WS_W2 = 21 * MiB, WS_WIN = 27 * MiB, WS_WA = 35 * MiB, WS_WB = 36 * MiB, WS_WO = 37 * MiB, WS_W3 = 39 * MiB, WS_W4 = 50 * MiB, WS_WG = 56 * MiB, WS_WP = 58 * MiB;
constexpr size_t WS_HB = 64 * MiB, WS_ACT = 128 * MiB, WS_TA = WS_ACT, WS_MIX = 368 * MiB  , WS_PP = 400 * MiB  ;
constexpr size_t WS_X8 = 304 * MiB, WS_SEL = WS_X8, WS_AQ = 336 * MiB, WS_BQ = 368 * MiB, WS_IQ = 400 * MiB, WS_AK = 432 * MiB, WS_AVT = 440 * MiB, WS_BK = 448 * MiB, WS_BV = 452 * MiB, WS_IK = 456 * MiB, WS_PB = 460 * MiB, WS_YA8 = 476 * MiB, WS_YB8 = 492 * MiB, WS_END = 508 * MiB;
constexpr int CW_BAR = 4096;
static_assert(pg8::PJ_AQ == WS_AQ && pg8::PJ_BQ == WS_BQ && pg8::PJ_IQ == WS_IQ && pg8::PJ_AK == WS_AK && pg8::PJ_AVT == WS_AVT && pg8::PJ_BK == WS_BK && pg8::PJ_BV == WS_BV && pg8::PJ_IK == WS_IK && pg8::PJ_IW == WS_IW, "EpiProj offsets");
constexpr int RING_OFF = 0, RING_BYTES = 131072;
constexpr int LDSCTL_OFF = 159744, MISC_OFF = LDSCTL_OFF + 320;
constexpr int LDS_BYTES = 160256;

#define LDS_WAIT() asm volatile("s_waitcnt lgkmcnt(0)" ::: "memory")
#define VM_WAIT() asm volatile("s_waitcnt vmcnt(0)" ::: "memory")
__device__ __forceinline__ unsigned f2bf(float f) { unsigned u = __builtin_bit_cast(unsigned, f); return (u + 0x7fffu + ((u >> 16) & 1u)) >> 16; }
__device__ __forceinline__ unsigned pk2(float lo, float hi) { return f2bf(lo) | (f2bf(hi) << 16); }
__device__ __forceinline__ float wave_sum(float v) {
#pragma unroll
    for (int o = 1; o < 64; o <<= 1) v += __shfl_xor(v, o);
    return v;
}

struct MapId { __device__ __forceinline__ void operator()(int n, int& sc, float& cs) const { sc = n; cs = 1.f; } };
struct MapFfnIn { __device__ __forceinline__ void operator()(int n, int& sc, float& cs) const { const int pn = n >> 8, bj = (n >> 7) & 1, i = n & 127; sc = bj * FF + 128 * pn + i; cs = 1.f; } };
struct MapWin { __device__ __forceinline__ void operator()(int n, int& sc, float& cs) const {
    const float CQ = 0.125f * 1.4426950408889634f; cs = 1.f;
    if (n < 1280) { sc = n; if (n < 512 || n >= 768) cs = CQ; }
    else if (n < 1536) { const int i = n - 1280; if (i < 128) sc = 1280 + i; else if (i < 192) sc = 1920 + (i - 128); else if (i < 200) { sc = 1984 + (i - 192); cs = 0.35355339059327373f; } else sc = -1; }
    else if (n < 2048) { sc = 1408 + (n - 1536); cs = 0.125f; }
    else if (n < 3072) sc = 1992 + (n - 2048);
    else sc = 3016 + (n - 3072);
} };
struct MapGate { __device__ __forceinline__ void operator()(int n, int& sc, float& cs) const { sc = 1992 + n; cs = 1.f; } };
template <class MAP>
__device__ __forceinline__ void tr_item(const float* W, int Nsrc, int K, bf16* WT, const float* gain, LAS float* scr, int item, int nblk, int lane, MAP map) {
    const int kb = item / nblk, nb = item % nblk, k0 = 64 * kb, n0 = 32 * nb;
    int sc; float cs; map(n0 + (lane & 7) * 4, sc, cs);
    {
        f32x4 ld[8];
#pragma unroll
        for (int i = 0; i < 8; ++i) { const int kk = 8 * i + (lane >> 3); ld[i] = (f32x4){0.f, 0.f, 0.f, 0.f}; if (sc >= 0) ld[i] = *(const GAS f32x4*)(W + (size_t)(k0 + kk) * Nsrc + sc); }
#pragma unroll
        for (int i = 0; i < 8; ++i) { const int kk = 8 * i + (lane >> 3); float gk = cs; if (gain) gk *= gain[k0 + kk]; LAS float* d = scr + kk * 33 + (lane & 7) * 4; d[0] = ld[i][0] * gk; d[1] = ld[i][1] * gk; d[2] = ld[i][2] * gk; d[3] = ld[i][3] * gk; }
    }
    LDS_WAIT(); asm volatile("" ::: "memory");
    const int c = lane & 7;
#pragma unroll
    for (int j = 0; j < 4; ++j) { const int n = (lane >> 3) + 8 * j; const LAS float* s = scr + (8 * c) * 33 + n;
        v4u o; o.x = pk2(s[0 * 33], s[1 * 33]); o.y = pk2(s[2 * 33], s[3 * 33]); o.z = pk2(s[4 * 33], s[5 * 33]); o.w = pk2(s[6 * 33], s[7 * 33]);
        *(GAS v4u*)(WT + (size_t)(n0 + n) * K + k0 + 8 * c) = o; }
    LDS_WAIT(); asm volatile("" ::: "memory");
}

template <class MAP>
__device__ __forceinline__ void tr_item8(const float* W, int Nsrc, int K, unsigned char* WT, const float* gain, LAS float* scr, int item, int nblk, int lane, MAP map, float scale) {
    const int kb = item / nblk, nb = item % nblk, k0 = 64 * kb, n0 = 32 * nb;
    int sc; float cs; map(n0 + (lane & 7) * 4, sc, cs); cs *= scale;
    {
        f32x4 ld[8];
#pragma unroll
        for (int i = 0; i < 8; ++i) { const int kk = 8 * i + (lane >> 3); ld[i] = (f32x4){0.f, 0.f, 0.f, 0.f}; if (sc >= 0) ld[i] = *(const GAS f32x4*)(W + (size_t)(k0 + kk) * Nsrc + sc); }
#pragma unroll
        for (int i = 0; i < 8; ++i) { const int kk = 8 * i + (lane >> 3); float gk = cs; if (gain) gk *= gain[k0 + kk]; LAS float* d = scr + kk * 33 + (lane & 7) * 4; d[0] = ld[i][0] * gk; d[1] = ld[i][1] * gk; d[2] = ld[i][2] * gk; d[3] = ld[i][3] * gk; }
    }
    LDS_WAIT(); asm volatile("" ::: "memory");
    const int c = lane & 3;
#pragma unroll
    for (int j = 0; j < 2; ++j) { const int n = (lane >> 2) + 16 * j; const LAS float* s = scr + (16 * c) * 33 + n;
        v4u o; o.x = pg8::pack4_fp8(s[0 * 33], s[1 * 33], s[2 * 33], s[3 * 33]); o.y = pg8::pack4_fp8(s[4 * 33], s[5 * 33], s[6 * 33], s[7 * 33]);
        o.z = pg8::pack4_fp8(s[8 * 33], s[9 * 33], s[10 * 33], s[11 * 33]); o.w = pg8::pack4_fp8(s[12 * 33], s[13 * 33], s[14 * 33], s[15 * 33]);
        *(GAS v4u*)(WT + (size_t)(n0 + n) * K + k0 + 16 * c) = o; }
    LDS_WAIT(); asm volatile("" ::: "memory");
}

__device__ __forceinline__ void tr_generic(const float* W, int Nsrc, int K, unsigned char* dst, const float* gain, int mapid, int f8, LAS float* scr, int item, int nblk, int lane) {
    const int kb = item / nblk, nb = item % nblk, k0 = 64 * kb, n0 = 32 * nb;
    int sc; float cs; { const int n = n0 + (lane & 7) * 4;
        if (mapid == 0) MapId()(n, sc, cs); else if (mapid == 1) MapFfnIn()(n, sc, cs); else if (mapid == 2) MapWin()(n, sc, cs); else MapGate()(n, sc, cs); }
    if (f8) cs *= pg8::F8_WSCALE;
    {
        f32x4 ld[8];
#pragma unroll
        for (int i = 0; i < 8; ++i) { const int kk = 8 * i + (lane >> 3); ld[i] = (f32x4){0.f, 0.f, 0.f, 0.f}; if (sc >= 0) ld[i] = *(const GAS f32x4*)(W + (size_t)(k0 + kk) * Nsrc + sc); }
#pragma unroll
        for (int i = 0; i < 8; ++i) { const int kk = 8 * i + (lane >> 3); float gk = cs; if (gain) gk *= gain[k0 + kk]; LAS float* d = scr + kk * 33 + (lane & 7) * 4; d[0] = ld[i][0] * gk; d[1] = ld[i][1] * gk; d[2] = ld[i][2] * gk; d[3] = ld[i][3] * gk; }
    }
    LDS_WAIT(); asm volatile("" ::: "memory");
    if (f8) {
        const int c = lane & 3;
#pragma unroll
        for (int j = 0; j < 2; ++j) { const int n = (lane >> 2) + 16 * j; const LAS float* s = scr + (16 * c) * 33 + n;
            v4u o; o.x = pg8::pack4_fp8(s[0 * 33], s[1 * 33], s[2 * 33], s[3 * 33]); o.y = pg8::pack4_fp8(s[4 * 33], s[5 * 33], s[6 * 33], s[7 * 33]);
            o.z = pg8::pack4_fp8(s[8 * 33], s[9 * 33], s[10 * 33], s[11 * 33]); o.w = pg8::pack4_fp8(s[12 * 33], s[13 * 33], s[14 * 33], s[15 * 33]);
            *(GAS v4u*)(dst + (size_t)(n0 + n) * K + k0 + 16 * c) = o; }
    } else {
        const int c = lane & 7;
#pragma unroll
        for (int j = 0; j < 4; ++j) { const int n = (lane >> 3) + 8 * j; const LAS float* s = scr + (8 * c) * 33 + n;
            v4u o; o.x = pk2(s[0 * 33], s[1 * 33]); o.y = pk2(s[2 * 33], s[3 * 33]); o.z = pk2(s[4 * 33], s[5 * 33]); o.w = pk2(s[6 * 33], s[7 * 33]);
            *(GAS v4u*)(dst + ((size_t)(n0 + n) * K + k0 + 8 * c) * 2) = o; }
    }
    LDS_WAIT(); asm volatile("" ::: "memory");
}

#ifndef PH_MASK
#define PH_MASK 0x7ff
#endif
template <class T_> __device__ __forceinline__ T_* as_global(T_* p) { return (T_*)(GAS T_*)p; }


namespace att {
typedef float f32x16 __attribute__((ext_vector_type(16)));
typedef short s16x4 __attribute__((ext_vector_type(4)));
typedef unsigned long long u64;
constexpr float LOG2E = 1.4426950408889634f;
__device__ __forceinline__ int crow(int r, int hi) { return (r & 3) + 8 * (r >> 2) + 4 * hi; }
__device__ __forceinline__ unsigned cvtpk(float lo, float hi) { unsigned r; asm volatile("v_cvt_pk_bf16_f32 %0, %1, %2" : "=v"(r) : "v"(lo), "v"(hi)); return r; }

constexpr int SWA_K = 0, SWA_V = 32768, SWA_VROW = 520;
__device__ __forceinline__ void swa_unit(int b, int n, int g, unsigned char* wsb, const float* sink, LAS unsigned char* L, int wid, int lane, int tid, size_t dst_off) {
    { GAS unsigned char* wg_ = (GAS unsigned char*)wsb; asm volatile("" : "+s"(wg_)); wsb = (unsigned char*)wg_; } const bf16* AQ = (const bf16*)(wsb + WS_AQ); const bf16* AK = (const bf16*)(wsb + WS_AK); const bf16* AVT = (const bf16*)(wsb + WS_AVT);
    const int hh = wid >> 1, qh = wid & 1, head = 4 * g + hh, r32 = lane & 31, hi = lane >> 5;
    const float slope2 = __builtin_amdgcn_exp2f(-0.5f * (float)(head + 1)) * LOG2E, sink2 = sink[head] * LOG2E;
    const size_t rowb = (size_t)b * T;
    const int kt0 = 128 * n - 128;
#pragma unroll
    for (int i = 0; i < 4; ++i) {
        const int row = (tid >> 3) + 64 * i, ch = tid & 7; int key = kt0 + row; if (key < 0) key = 0;
        const v4u v = *(const v4u*)(AK + (rowb + key) * 128 + g * 64 + ch * 8);
        *(LAS v4u*)(L + SWA_K + row * 128 + ((ch ^ ((row >> 1) & 7)) << 4)) = v;
    }
#pragma unroll
    for (int i = 0; i < 4; ++i) {
        const int d = (tid >> 5) + 16 * i, ch = tid & 31; int key0 = kt0 + 8 * ch; if (key0 < 0) key0 = 0;
        const v4u v = *(const v4u*)(AVT + ((size_t)((b * 2 + g) * 64 + d)) * T + key0);
        LAS u64* dp = (LAS u64*)(L + SWA_V + d * SWA_VROW + ch * 16);
        dp[0] = (u64)v.x | ((u64)v.y << 32); dp[1] = (u64)v.z | ((u64)v.w << 32);
    }
    __syncthreads();
    for (int qs = 0; qs < 2; ++qs) {
        const int qq0 = 128 * n + 64 * qh + 32 * qs, kbase = qq0 - 128, lrow0 = 64 * qh + 32 * qs;
        const bf16* qp = AQ + (rowb + qq0 + r32) * 512 + head * 64;
        bf16x8 qf[4];
#pragma unroll
        for (int ks = 0; ks < 4; ++ks) qf[ks] = *(const bf16x8*)(qp + 8 * hi + 16 * ks);
        float mrun = sink2, lrun = 1.0f;
        f32x16 O0 = {}, O1 = {};
#pragma unroll
        for (int kb = 0; kb < 5; ++kb) {
            const int row = lrow0 + 32 * kb + r32, sw = (row >> 1) & 7;
            f32x16 acc = {};
#pragma unroll
            for (int ks = 0; ks < 4; ++ks) acc = __builtin_amdgcn_mfma_f32_32x32x16_bf16(*(const LAS bf16x8*)(L + SWA_K + row * 128 + (((2 * ks + hi) ^ sw) << 4)), qf[ks], acc, 0, 0, 0);
            float bm = -__builtin_inff();
            int dist0 = r32 + 128 - 32 * kb - 4 * hi; asm volatile("" : "+v"(dist0));
            const bool bvalid = (kbase + 32 * kb) >= 0;
#pragma unroll
            for (int r = 0; r < 16; ++r) {
                const int dist = dist0 - ((r & 3) + 8 * (r >> 2));
                const bool valid = bvalid && ((unsigned)dist < 128u);
                const float l = valid ? (acc[r] - slope2 * (float)dist) : -__builtin_inff();
                acc[r] = l; bm = fmaxf(bm, l);
            }
            bm = fmaxf(bm, __shfl_xor(bm, 32));
            const float mnew = fmaxf(mrun, bm), alpha = __builtin_amdgcn_exp2f(mrun - mnew);
            float bs = 0.f;
#pragma unroll
            for (int r = 0; r < 16; ++r) { const float e = __builtin_amdgcn_exp2f(acc[r] - mnew); acc[r] = e; bs += e; }
            bs += __shfl_xor(bs, 32);
            lrun = lrun * alpha + bs; mrun = mnew;
#pragma unroll
            for (int r = 0; r < 16; ++r) { O0[r] *= alpha; O1[r] *= alpha; }
#pragma unroll
            for (int s2 = 0; s2 < 2; ++s2) {
                v4u pw; pw.x = cvtpk(acc[8 * s2 + 0], acc[8 * s2 + 1]); pw.y = cvtpk(acc[8 * s2 + 2], acc[8 * s2 + 3]);
                pw.z = cvtpk(acc[8 * s2 + 4], acc[8 * s2 + 5]); pw.w = cvtpk(acc[8 * s2 + 6], acc[8 * s2 + 7]);
                const bf16x8 pf = __builtin_bit_cast(bf16x8, pw);
                const int tb = lrow0 + 32 * kb + 16 * s2 + 4 * hi;
                const LAS unsigned char* vp = L + SWA_V + r32 * SWA_VROW + 2 * tb;
                typedef u64 u64x2 __attribute__((ext_vector_type(2)));
                u64x2 v0, v1; v0.x = *(const LAS u64*)vp; v0.y = *(const LAS u64*)(vp + 16); v1.x = *(const LAS u64*)(vp + 32 * SWA_VROW); v1.y = *(const LAS u64*)(vp + 32 * SWA_VROW + 16);
                O0 = __builtin_amdgcn_mfma_f32_32x32x16_bf16(__builtin_bit_cast(bf16x8, v0), pf, O0, 0, 0, 0);
                O1 = __builtin_amdgcn_mfma_f32_32x32x16_bf16(__builtin_bit_cast(bf16x8, v1), pf, O1, 0, 0, 0);
            }
        }
        { const float inv = 1.0f / lrun;
#pragma unroll
          for (int r = 0; r < 16; ++r) { O0[r] *= inv; O1[r] *= inv; } }
#pragma unroll
        for (int rg = 0; rg < 4; ++rg) {
            const int d = 8 * rg + 4 * hi;
            const unsigned w0 = pg8::pack4_fp8(O0[4 * rg], O0[4 * rg + 1], O0[4 * rg + 2], O0[4 * rg + 3]);
            const unsigned w1 = pg8::pack4_fp8(O1[4 * rg], O1[4 * rg + 1], O1[4 * rg + 2], O1[4 * rg + 3]);
            unsigned char* op = (unsigned char*)(wsb + dst_off) + (rowb + qq0 + r32) * 512 + head * 64; *(unsigned*)(op + d) = w0; *(unsigned*)(op + 32 + d) = w1;
        }
    }
    __syncthreads();
}

constexpr int CB = 448;
constexpr int L_KT = 0, L_BUF = 32768, L_HIST = 32768, L_QINFO = L_BUF + 64 * CB * 4, L_WSCR = L_QINFO + 2048, L_END = L_WSCR + 8 * 1024, L_VBUF = 0;
__device__ __forceinline__ float relu_i(float x) { const int b = __builtin_bit_cast(int, x); return __builtin_bit_cast(float, b > 0 ? b : 0); }
template <int PASS, bool DIAG>
__device__ __forceinline__ void idx_post(const f32x16& acc, int rb, int kb, int s, int t0, LAS unsigned char* L, const float (&wq)[2][2][8], const int (&qa)[2][2], const int (&qb)[2][2], int (&eqseen)[2][2], int (&cnt)[2][2], unsigned (&cw)[2][2][2], int wid, int r32, int hi) {
    LAS unsigned* hist = (LAS unsigned*)(L + L_HIST);
    LAS unsigned* buf = (LAS unsigned*)(L + L_BUF);
#pragma unroll
    for (int g2 = 0; g2 < 2; ++g2) {
        float sc = relu_i(acc[8 * g2]) * wq[rb][g2][0];
#pragma unroll
        for (int hd = 1; hd < 8; ++hd) sc = fmaf(relu_i(acc[8 * g2 + hd]), wq[rb][g2][hd], sc);
        const int ql = 8 * wid + 4 * rb + 2 * g2 + hi, tq = t0 + ql;
        const bool valid = DIAG ? (s <= tq) : true;
        const _Float16 hf = (_Float16)sc; const int hb = (int)__builtin_bit_cast(short, hf);
        const unsigned u = (unsigned)(hb ^ ((hb >> 16) | 0x8000));
        if (PASS == 1 || PASS == 4) { if (PASS == 1) __hip_atomic_fetch_add(hist + ql * 256 + (u >> 8), valid ? (1u << ((u >> 3) & 16u)) : 0u, __ATOMIC_RELAXED, __HIP_MEMORY_SCOPE_WORKGROUP);
            if (kb & 1) cw[rb][g2][kb >> 1] |= (valid ? u : 0u) << 16; else cw[rb][g2][kb >> 1] = valid ? u : 0u; }
        else if (PASS == 2) { const bool c = valid && (int)(u >> 7) == qa[rb][g2]; if (__ballot(c) != 0ull) __hip_atomic_fetch_add(hist + ql * 256 + (u & 127u), c ? 1u : 0u, __ATOMIC_RELAXED, __HIP_MEMORY_SCOPE_WORKGROUP); }
        else {
            const bool gt = valid && ((int)u > qa[rb][g2]), eq = valid && ((int)u == qa[rb][g2]);
            const unsigned ltm = (1u << r32) - 1u;
            const u64 em = __ballot(eq);
            const unsigned mh = hi ? (unsigned)(em >> 32) : (unsigned)em;
            const bool keep = gt || (eq && (eqseen[rb][g2] + __popc(mh & ltm)) < qb[rb][g2]);
            eqseen[rb][g2] += __popc(mh);
            const u64 km = __ballot(keep);
            const unsigned kh = hi ? (unsigned)(km >> 32) : (unsigned)km;
            const int pos = cnt[rb][g2] + __popc(kh & ltm);
            if (keep && pos < CB) buf[ql * CB + pos] = (u << 16) | (unsigned)s;
            cnt[rb][g2] += __popc(kh);
        }
    }
}
template <int PASS, bool DIAG>
__device__ __forceinline__ void idx_tile(int t0, int kt, const LAS unsigned char* kbuf, LAS unsigned char* L, const bf16x8 (&af)[2][4], const float (&wq)[2][2][8], const int (&qa)[2][2], const int (&qb)[2][2], int (&eqseen)[2][2], int (&cnt)[2][2], unsigned short* codes, int cstride, int wid, int r32, int hi) {
    unsigned cw[2][2][2];
#pragma unroll
    for (int rb = 0; rb < 2; ++rb)
#pragma unroll
        for (int g2 = 0; g2 < 2; ++g2) { cw[rb][g2][0] = 0u; cw[rb][g2][1] = 0u; }
#pragma unroll
    for (int kb = 0; kb < 4; ++kb) {
        bf16x8 bfr[4];
        const int lrow = 32 * kb + r32;
#pragma unroll
        for (int ks = 0; ks < 4; ++ks) bfr[ks] = *(const LAS bf16x8*)(kbuf + lrow * 128 + (((2 * ks + hi) ^ ((lrow >> 1) & 7)) << 4));
        const int s = 128 * kt + 4 * r32 + kb;
        f32x16 acc0 = {}, acc1 = {};
#pragma unroll
        for (int ks = 0; ks < 4; ++ks) acc0 = __builtin_amdgcn_mfma_f32_32x32x16_bf16(af[0][ks], bfr[ks], acc0, 0, 0, 0);
#pragma unroll
        for (int ks = 0; ks < 4; ++ks) acc1 = __builtin_amdgcn_mfma_f32_32x32x16_bf16(af[1][ks], bfr[ks], acc1, 0, 0, 0);
        idx_post<PASS, DIAG>(acc0, 0, kb, s, t0, L, wq, qa, qb, eqseen, cnt, cw, wid, r32, hi);
        idx_post<PASS, DIAG>(acc1, 1, kb, s, t0, L, wq, qa, qb, eqseen, cnt, cw, wid, r32, hi);
    }
    if (PASS == 1 || PASS == 4) {
#pragma unroll
        for (int rb = 0; rb < 2; ++rb)
#pragma unroll
            for (int g2 = 0; g2 < 2; ++g2) { const int ql = 8 * wid + 4 * rb + 2 * g2 + hi;
                *(u64*)(codes + (size_t)ql * cstride + 128 * kt + 4 * r32) = (u64)cw[rb][g2][0] | ((u64)cw[rb][g2][1] << 32); }
    }
}
template <int PASS>
__device__ __forceinline__ void idx_pass(int b, int t0, int kt0, int nt, unsigned char* wsb, unsigned short* codes, int cstride, LAS unsigned char* L, const bf16x8 (&af)[2][4], const float (&wq)[2][2][8], int wid, int lane, int tid) {
    { GAS unsigned char* wg_ = (GAS unsigned char*)wsb; asm volatile("" : "+s"(wg_)); wsb = (unsigned char*)wg_; } const bf16* IK = (const bf16*)(wsb + WS_IK);
    const int r32 = lane & 31, hi = lane >> 5;
    LAS int* qinfo = (LAS int*)(L + L_QINFO);
    int qa[2][2], qb[2][2], eqseen[2][2], cnt[2][2];
#pragma unroll
    for (int rb = 0; rb < 2; ++rb)
#pragma unroll
        for (int g2 = 0; g2 < 2; ++g2) { const int ql = 8 * wid + 4 * rb + 2 * g2 + hi; eqseen[rb][g2] = 0; cnt[rb][g2] = 0;
            if (PASS == 2) { qa[rb][g2] = qinfo[ql]; qb[rb][g2] = 0; } else if (PASS == 3) { qa[rb][g2] = qinfo[128 + ql]; qb[rb][g2] = qinfo[192 + ql]; cnt[rb][g2] = qinfo[256 + ql]; eqseen[rb][g2] = qinfo[384 + ql]; } else { qa[rb][g2] = 0; qb[rb][g2] = 0; } }
    const int skey = tid >> 2, sc0 = (tid & 3) * 2;
    const bf16* src = IK + ((size_t)b * T + skey) * 64 + sc0 * 8;
    const int srow = (skey & 3) * 32 + (skey >> 2);
    const int sd0 = srow * 128 + ((sc0 ^ ((srow >> 1) & 7)) << 4), sd1 = srow * 128 + (((sc0 + 1) ^ ((srow >> 1) & 7)) << 4);
    v4u A0, A1, B0, B1;
#define IDX_LOAD(R0, R1, tile) do { const bf16* s_ = src + (size_t)(tile) * (128 * 64); R0 = *(const v4u*)s_; R1 = *(const v4u*)(s_ + 8); } while (0)
#define IDX_WRITE(R0, R1, buf) do { *(LAS v4u*)(L + L_KT + (buf) * 16384 + sd0) = R0; *(LAS v4u*)(L + L_KT + (buf) * 16384 + sd1) = R1; } while (0)
    IDX_LOAD(A0, A1, kt0); IDX_LOAD(B0, B1, (kt0 + 1 < nt ? kt0 + 1 : kt0));
    IDX_WRITE(A0, A1, 0);
    __syncthreads();
    for (int kt = kt0; kt < nt; kt += 2) {
        { const int tn = (kt + 2 < nt) ? kt + 2 : nt - 1; IDX_LOAD(A0, A1, tn); }
        if (kt + 1 < nt) idx_tile<PASS, false>(t0, kt, L + L_KT, L, af, wq, qa, qb, eqseen, cnt, codes, cstride, wid, r32, hi);
        else idx_tile<PASS, true>(t0, kt, L + L_KT, L, af, wq, qa, qb, eqseen, cnt, codes, cstride, wid, r32, hi);
        IDX_WRITE(B0, B1, 1);
        __syncthreads();
        if (kt + 1 >= nt) break;
        { const int tn = (kt + 3 < nt) ? kt + 3 : nt - 1; IDX_LOAD(B0, B1, tn); }
        if (kt + 2 < nt) idx_tile<PASS, false>(t0, kt + 1, L + L_KT + 16384, L, af, wq, qa, qb, eqseen, cnt, codes, cstride, wid, r32, hi);
        else idx_tile<PASS, true>(t0, kt + 1, L + L_KT + 16384, L, af, wq, qa, qb, eqseen, cnt, codes, cstride, wid, r32, hi);
        IDX_WRITE(A0, A1, 0);
        __syncthreads();
    }
#undef IDX_LOAD
#undef IDX_WRITE
    if (PASS == 3) {
#pragma unroll
        for (int rb = 0; rb < 2; ++rb)
#pragma unroll
            for (int g2 = 0; g2 < 2; ++g2) if (r32 == 0) qinfo[256 + 8 * wid + 4 * rb + 2 * g2 + hi] = cnt[rb][g2];
    }
}
template <bool NB16>
__device__ __forceinline__ void find_bin(const LAS unsigned* hq, int K, int lane, int& bin, int& above, int& incnt) {
    const v4u w = *(const LAS v4u*)(hq + 4 * lane);
    int c[8];
    if (NB16) { c[0] = w.x & 0xffffu; c[1] = w.x >> 16; c[2] = w.y & 0xffffu; c[3] = w.y >> 16; c[4] = w.z & 0xffffu; c[5] = w.z >> 16; c[6] = w.w & 0xffffu; c[7] = w.w >> 16; }
    else { c[0] = (int)w.x; c[1] = (int)w.y; c[2] = (int)w.z; c[3] = (int)w.w; c[4] = 0; c[5] = 0; c[6] = 0; c[7] = 0; }
    constexpr int NC = NB16 ? 8 : 4;
    int tot = 0;
#pragma unroll
    for (int i = 0; i < NC; ++i) tot += c[i];
    int S = tot;
#pragma unroll
    for (int o = 1; o < 64; o <<= 1) { const int t = __shfl_down(S, o); if (lane + o < 64) S += t; }
    const int ab = S - tot;
    const bool here = (S >= K) && (ab < K);
    const u64 bm = __ballot(here);
    int mybin = NC * lane, myab = ab, myc = c[0]; bool found = false;
#pragma unroll
    for (int i = NC - 1; i >= 0; --i) { if (!found) { if (myab + c[i] >= K || i == 0) { mybin = NC * lane + i; myc = c[i]; found = true; } else myab += c[i]; } }
    const int Ls = (bm == 0ull) ? 0 : (__ffsll((long long)bm) - 1);
    bin = __shfl(mybin, Ls); above = __shfl(myab, Ls); incnt = __shfl(myc, Ls);
}
__device__ __forceinline__ int prune256(LAS unsigned* buf, int n, LAS unsigned* wh, int lane) {
    const unsigned ltm_lo = (lane < 32) ? ((1u << lane) - 1u) : 0xffffffffu, ltm_hi = (lane < 32) ? 0u : ((1u << (lane - 32)) - 1u);
#pragma unroll
    for (int i = 0; i < 4; ++i) wh[i * 64 + lane] = 0u;
    LDS_WAIT();
    for (int i = lane; i < n; i += 64) __hip_atomic_fetch_add(wh + (buf[i] >> 24), 1u, __ATOMIC_RELAXED, __HIP_MEMORY_SCOPE_WORKGROUP);
    LDS_WAIT();
    int b1, ab1, c1; find_bin<false>(wh, 256, lane, b1, ab1, c1);
#pragma unroll
    for (int i = 0; i < 4; ++i) wh[i * 64 + lane] = 0u;
    LDS_WAIT();
    for (int i = lane; i < n; i += 64) { const unsigned e = buf[i]; if ((int)(e >> 24) == b1) __hip_atomic_fetch_add(wh + ((e >> 16) & 255u), 1u, __ATOMIC_RELAXED, __HIP_MEMORY_SCOPE_WORKGROUP); }
    LDS_WAIT();
    int b2, ab2, c2; find_bin<false>(wh, 256 - ab1, lane, b2, ab2, c2);
    const int Tc = (b1 << 8) | b2, need = 256 - ab1 - ab2;
    int eqseen = 0, outc = 0;
    for (int c0 = 0; c0 < n; c0 += 64) {
        const int i = c0 + lane; const unsigned e = (i < n) ? buf[i] : 0u; const int code = (int)(e >> 16);
        const bool gt = (i < n) && code > Tc, eq = (i < n) && code == Tc;
        const u64 em = __ballot(eq);
        const int rank = eqseen + __popc((unsigned)em & ltm_lo) + __popc((unsigned)(em >> 32) & ltm_hi);
        const bool keep = gt || (eq && rank < need);
        eqseen += __popcll(em);
        const u64 km = __ballot(keep);
        const int pos = outc + __popc((unsigned)km & ltm_lo) + __popc((unsigned)(km >> 32) & ltm_hi);
        LDS_WAIT();
        if (keep) buf[pos] = e;
        outc += __popcll(km);
    }
    LDS_WAIT();
    return Tc;
}

__device__ __forceinline__ unsigned scan_hits(const v4u cur, int T) {
    const unsigned c0 = cur.x & 0xffffu, c1 = cur.x >> 16, c2 = cur.y & 0xffffu, c3 = cur.y >> 16, c4 = cur.z & 0xffffu, c5 = cur.z >> 16, c6 = cur.w & 0xffffu, c7 = cur.w >> 16;
    return ((int)c0 > T ? 1u : 0u) | ((int)c1 > T ? 2u : 0u) | ((int)c2 > T ? 4u : 0u) | ((int)c3 > T ? 8u : 0u) | ((int)c4 > T ? 16u : 0u) | ((int)c5 > T ? 32u : 0u) | ((int)c6 > T ? 64u : 0u) | ((int)c7 > T ? 128u : 0u);
}
__device__ __forceinline__ void scan_block(const v4u cur, int kk, int& T, LAS unsigned* buf, int& cnt, LAS unsigned* wh, int lane, u64 ltm) {
    unsigned keep = scan_hits(cur, T);
    int kc = __popc(keep);
    u64 b0 = __ballot(kc & 1), b1 = __ballot(kc & 2), b2 = __ballot(kc & 4), b3 = __ballot(kc & 8);
    int tot = __popcll(b0) + 2 * __popcll(b1) + 4 * __popcll(b2) + 8 * __popcll(b3);
    if (cnt + tot > CB && cnt > 256) {
        LDS_WAIT();
        T = prune256(buf, cnt, wh, lane); cnt = 256;
        keep = scan_hits(cur, T); kc = __popc(keep);
        b0 = __ballot(kc & 1); b1 = __ballot(kc & 2); b2 = __ballot(kc & 4); b3 = __ballot(kc & 8);
        tot = __popcll(b0) + 2 * __popcll(b1) + 4 * __popcll(b2) + 8 * __popcll(b3);
    }
    int pos = cnt + __popcll(b0 & ltm) + 2 * __popcll(b1 & ltm) + 4 * __popcll(b2 & ltm) + 8 * __popcll(b3 & ltm);
    cnt += tot;
    const u64 lo64 = (u64)cur.x | ((u64)cur.y << 32), hi64 = (u64)cur.z | ((u64)cur.w << 32);
    while (keep) {
        const int e = __ffs((int)keep) - 1; keep &= keep - 1u;
        const unsigned code = (unsigned)(((e & 4) ? hi64 : lo64) >> (16 * (e & 3))) & 0xffffu;
        if (pos < CB) buf[pos] = (code << 16) | (unsigned)(kk + e);
        ++pos;
    }
}
__device__ __forceinline__ void scan_codes(const unsigned short* crow, int nkeys, int T, LAS unsigned* buf, int& cnt_io, LAS unsigned* wh, int lane) {
    int cnt = cnt_io;
    const u64 ltm = (lane == 0) ? 0ull : (~0ull >> (64 - lane));
    v4u w0, w1, w2, w3;
#define SC_LOAD(R, kq) do { const int kq_ = (kq) + 8 * lane; R = (kq_ < nkeys) ? *(const v4u*)(crow + kq_) : (v4u){0u, 0u, 0u, 0u}; } while (0)
    SC_LOAD(w0, 0); SC_LOAD(w1, 512); SC_LOAD(w2, 1024); SC_LOAD(w3, 1536);
    for (int k0 = 0; k0 < nkeys; k0 += 2048) {
        { const v4u cur = w0; SC_LOAD(w0, k0 + 2048); scan_block(cur, k0 + 8 * lane, T, buf, cnt, wh, lane, ltm); }
        if (k0 + 512 >= nkeys) break;
        { const v4u cur = w1; SC_LOAD(w1, k0 + 2560); scan_block(cur, k0 + 512 + 8 * lane, T, buf, cnt, wh, lane, ltm); }
        if (k0 + 1024 >= nkeys) break;
        { const v4u cur = w2; SC_LOAD(w2, k0 + 3072); scan_block(cur, k0 + 1024 + 8 * lane, T, buf, cnt, wh, lane, ltm); }
        if (k0 + 1536 >= nkeys) break;
        { const v4u cur = w3; SC_LOAD(w3, k0 + 3584); scan_block(cur, k0 + 1536 + 8 * lane, T, buf, cnt, wh, lane, ltm); }
    }
#undef SC_LOAD
    cnt_io = cnt;
}

__device__ __forceinline__ void sparse_query(int b, int t, const LAS unsigned* idx, unsigned char* wsb, LAS unsigned char* L, int wid, int lane, size_t dst_off) {
    { GAS unsigned char* wg_ = (GAS unsigned char*)wsb; asm volatile("" : "+s"(wg_)); wsb = (unsigned char*)wg_; } bf16* BQ = (bf16*)(wsb + WS_BQ); const bf16* BK = (const bf16*)(wsb + WS_BK); const bf16* BV = (const bf16*)(wsb + WS_BV);
    const int fr = lane & 15, fq = lane >> 4;
    LAS unsigned char* vbuf = L + L_VBUF + wid * 4096;
    const size_t rowb = (size_t)b * T;
    bf16* qrow = BQ + (rowb + t) * 512;
    bf16x8 qf0 = {}, qf1 = {};
    if (fr < 8) { qf0 = *(const bf16x8*)(qrow + fr * 64 + 8 * fq); qf1 = *(const bf16x8*)(qrow + fr * 64 + 32 + 8 * fq); }
    f32x4 S[16];
    {
        v4u kreg[4][4];
#pragma unroll
        for (int c8 = 0; c8 < 4; ++c8)
#pragma unroll
            for (int i = 0; i < 4; ++i) {
                const int row = 8 * i + (lane >> 3), ch = lane & 7;
                unsigned ki = idx[32 * c8 + row] & 0xffffu; if (ki == 0xffffu) ki = 0u;
                kreg[c8][i] = *(const v4u*)(BK + (rowb + ki) * 64 + ch * 8);
            }
#pragma unroll
        for (int c8 = 0; c8 < 8; ++c8) {
#pragma unroll
            for (int i = 0; i < 4; ++i) {
                const int row = 8 * i + (lane >> 3), ch = lane & 7;
                *(LAS v4u*)(vbuf + row * 128 + ((ch ^ (((row >> 1) & 3) << 1)) << 4)) = kreg[c8 & 3][i];
            }
            if (c8 + 4 < 8) {
#pragma unroll
                for (int i = 0; i < 4; ++i) {
                    const int row = 8 * i + (lane >> 3), ch = lane & 7;
                    unsigned ki = idx[32 * (c8 + 4) + row] & 0xffffu; if (ki == 0xffffu) ki = 0u;
                    kreg[c8 & 3][i] = *(const v4u*)(BK + (rowb + ki) * 64 + ch * 8);
                }
            }
            LDS_WAIT();
#pragma unroll
            for (int kbl = 0; kbl < 2; ++kbl) {
                const int row = 16 * kbl + fr, sw = ((row >> 1) & 3) << 1;
                const bf16x8 a0 = *(const LAS bf16x8*)(vbuf + row * 128 + ((fq ^ sw) << 4)), a1 = *(const LAS bf16x8*)(vbuf + row * 128 + (((fq + 4) ^ sw) << 4));
                f32x4 acc = {0.f, 0.f, 0.f, 0.f};
                acc = __builtin_amdgcn_mfma_f32_16x16x32_bf16(a0, qf0, acc, 0, 0, 0);
                acc = __builtin_amdgcn_mfma_f32_16x16x32_bf16(a1, qf1, acc, 0, 0, 0);
                S[2 * c8 + kbl] = acc;
            }
            LDS_WAIT();
        }
    }
    v4u vreg[4][4];
#pragma unroll
    for (int c8 = 0; c8 < 4; ++c8)
#pragma unroll
        for (int i = 0; i < 4; ++i) {
            const int row = 8 * i + (lane >> 3), ch = lane & 7;
            unsigned ki = idx[32 * c8 + row] & 0xffffu; if (ki == 0xffffu) ki = 0u;
            vreg[c8][i] = *(const v4u*)(BV + (rowb + ki) * 64 + ch * 8);
        }
    const float slope2 = __builtin_amdgcn_exp2f(-0.5f * (float)((fr & 7) + 9)) * LOG2E;
    float mx = -__builtin_inff();
#pragma unroll
    for (int kb = 0; kb < 16; ++kb) {
        const v4u i4 = *(const LAS v4u*)(idx + 16 * kb + 4 * fq);
        const unsigned k0 = i4.x & 0xffffu, k1 = i4.y & 0xffffu, k2 = i4.z & 0xffffu, k3 = i4.w & 0xffffu;
        { const float l = (k0 != 0xffffu) ? (S[kb][0] - slope2 * (float)(t - (int)k0)) : -__builtin_inff(); S[kb][0] = l; mx = fmaxf(mx, l); }
        { const float l = (k1 != 0xffffu) ? (S[kb][1] - slope2 * (float)(t - (int)k1)) : -__builtin_inff(); S[kb][1] = l; mx = fmaxf(mx, l); }
        { const float l = (k2 != 0xffffu) ? (S[kb][2] - slope2 * (float)(t - (int)k2)) : -__builtin_inff(); S[kb][2] = l; mx = fmaxf(mx, l); }
        { const float l = (k3 != 0xffffu) ? (S[kb][3] - slope2 * (float)(t - (int)k3)) : -__builtin_inff(); S[kb][3] = l; mx = fmaxf(mx, l); }
    }
    mx = fmaxf(mx, __shfl_xor(mx, 16)); mx = fmaxf(mx, __shfl_xor(mx, 32));
    float sum = 0.f;
#pragma unroll
    for (int kb = 0; kb < 16; ++kb)
#pragma unroll
        for (int r = 0; r < 4; ++r) { const float e = __builtin_amdgcn_exp2f(S[kb][r] - mx); S[kb][r] = e; sum += e; }
    sum += __shfl_xor(sum, 16); sum += __shfl_xor(sum, 32);
    const float inv = 1.0f / sum;
    f32x4 O[4];
#pragma unroll
    for (int db = 0; db < 4; ++db) O[db] = (f32x4){0.f, 0.f, 0.f, 0.f};
#pragma unroll
    for (int c8 = 0; c8 < 8; ++c8) {
#pragma unroll
        for (int i = 0; i < 4; ++i) {
            const int row = 8 * i + (lane >> 3), ch = lane & 7;
            *(LAS v4u*)(vbuf + row * 128 + ((ch ^ (((row >> 1) & 3) << 1)) << 4)) = vreg[c8 & 3][i];
        }
        if (c8 + 4 < 8) {
#pragma unroll
            for (int i = 0; i < 4; ++i) {
                const int row = 8 * i + (lane >> 3), ch = lane & 7;
                unsigned ki = idx[32 * (c8 + 4) + row] & 0xffffu; if (ki == 0xffffu) ki = 0u;
                vreg[c8 & 3][i] = *(const v4u*)(BV + (rowb + ki) * 64 + ch * 8);
            }
        }
        LDS_WAIT();
        v4u pw; pw.x = cvtpk(S[2 * c8][0] * inv, S[2 * c8][1] * inv); pw.y = cvtpk(S[2 * c8][2] * inv, S[2 * c8][3] * inv);
        pw.z = cvtpk(S[2 * c8 + 1][0] * inv, S[2 * c8 + 1][1] * inv); pw.w = cvtpk(S[2 * c8 + 1][2] * inv, S[2 * c8 + 1][3] * inv);
        const bf16x8 pa = __builtin_bit_cast(bf16x8, pw);
        const int row0 = 4 * fq + (fr >> 2), row1 = row0 + 16;
#pragma unroll
        for (int db = 0; db < 4; ++db) {
            const int chunk = 2 * db + ((fr & 3) >> 1), sub = (fr & 1) * 8;
            const s16x4 lo = __builtin_bit_cast(s16x4, __builtin_amdgcn_ds_read_tr16_b64_v4i16((LAS s16x4*)(vbuf + row0 * 128 + ((chunk ^ (((row0 >> 1) & 3) << 1)) << 4) + sub)));
            const s16x4 hi4 = __builtin_bit_cast(s16x4, __builtin_amdgcn_ds_read_tr16_b64_v4i16((LAS s16x4*)(vbuf + row1 * 128 + ((chunk ^ (((row1 >> 1) & 3) << 1)) << 4) + sub)));
            const bf16x8 vb = (bf16x8){lo[0], lo[1], lo[2], lo[3], hi4[0], hi4[1], hi4[2], hi4[3]};
            O[db] = __builtin_amdgcn_mfma_f32_16x16x32_bf16(pa, vb, O[db], 0, 0, 0);
        }
    }
    if (fq < 2) {
#pragma unroll
        for (int db = 0; db < 4; ++db)
#pragma unroll
            for (int r = 0; r < 4; ++r) ((unsigned char*)(wsb + dst_off))[(rowb + t) * 512 + (4 * fq + r) * 64 + 16 * db + fr] = (unsigned char)(pg8::pack4_fp8(O[db][r], 0.f, 0.f, 0.f) & 0xffu);
    }
}

__device__ __forceinline__ void sparse_unit(int b, int j, unsigned short* codes, int cstride, unsigned char* wsb, LAS unsigned char* L, int wid, int lane, int tid) {
    { GAS unsigned char* wg_ = (GAS unsigned char*)wsb; asm volatile("" : "+s"(wg_)); wsb = (unsigned char*)wg_; } const bf16* IQ = (const bf16*)(wsb + WS_IQ); const float* IW = (const float*)(wsb + WS_IW);
    asm volatile("" : "+v"(lane)); tid = wid * 64 + lane;
    const int t0 = 64 * j, ntiles = (j >> 1) + 1, r32 = lane & 31, hi = lane >> 5;
    const size_t rowb = (size_t)b * T;
    LAS unsigned* hist = (LAS unsigned*)(L + L_HIST);
    LAS unsigned* cbuf = (LAS unsigned*)(L + L_BUF);
    LAS int* qinfo = (LAS int*)(L + L_QINFO);
    bf16x8 af[2][4];
    { const int a = r32 >> 3, hp = (r32 >> 2) & 1, bb = r32 & 3, qi = 2 * (a >> 1) + hp, hd = 4 * (a & 1) + bb;
#pragma unroll
      for (int rb = 0; rb < 2; ++rb) { const bf16* ap = IQ + (rowb + t0 + 8 * wid + 4 * rb + qi) * 512 + hd * 64 + 8 * hi;
#pragma unroll
          for (int ks = 0; ks < 4; ++ks) af[rb][ks] = *(const bf16x8*)(ap + 16 * ks); } }
    float wq[2][2][8];
#pragma unroll
    for (int rb = 0; rb < 2; ++rb)
#pragma unroll
        for (int g2 = 0; g2 < 2; ++g2) { const float* wp = IW + (rowb + t0 + 8 * wid + 4 * rb + 2 * g2 + hi) * 8; const f32x4 w0 = *(const f32x4*)wp, w1 = *(const f32x4*)(wp + 4);
            wq[rb][g2][0] = w0[0]; wq[rb][g2][1] = w0[1]; wq[rb][g2][2] = w0[2]; wq[rb][g2][3] = w0[3]; wq[rb][g2][4] = w1[0]; wq[rb][g2][5] = w1[1]; wq[rb][g2][6] = w1[2]; wq[rb][g2][7] = w1[3]; }
#ifndef REP_P1
#define REP_P1 1
#endif
    for (int rp1_ = 0; rp1_ < REP_P1; ++rp1_) {
#pragma unroll
    for (int i = 0; i < 32; ++i) hist[(8 * wid) * 256 + i * 64 + lane] = 0u;
    __syncthreads();
    idx_pass<1>(b, t0, 0, ntiles, wsb, codes, cstride, L, af, wq, wid, lane, tid);
    }
    for (int i = 0; i < 8; ++i) {
        const int ql = 8 * wid + i, t = t0 + ql; int bin = 0, above = 0, inc = 0;
        if (t + 1 > 256) find_bin<true>(hist + ql * 256, 256, lane, bin, above, inc);
        if (lane == 0) qinfo[128 + ql] = (t + 1 > 256) ? ((bin << 7) - 1) : 0;
    }
    LDS_WAIT();
    __syncthreads();
    VM_WAIT();
    __builtin_amdgcn_fence(__ATOMIC_ACQUIRE, "agent"); VM_WAIT();
#ifndef REP_SCAN
#define REP_SCAN 1
#endif
#ifndef REP_SCPR
#define REP_SCPR 1
#endif
    LAS unsigned* wh = (LAS unsigned*)(L + L_WSCR + wid * 1024);
    for (int rsp_ = 0; rsp_ < REP_SCPR; ++rsp_) {
    for (int rsc_ = 0; rsc_ < REP_SCAN; ++rsc_)
    { const int nstored = ntiles * 128;
      for (int i = 0; i < 8; ++i) {
        const int ql = 8 * wid + i; int c = 0;
        scan_codes(codes + (size_t)ql * cstride, nstored, qinfo[128 + ql], cbuf + ql * CB, c, wh, lane);
        if (lane == 0) qinfo[256 + ql] = c;
      } }
    LDS_WAIT();
    for (int i = 0; i < 8; ++i) {
        const int ql = 8 * wid + i; int n = qinfo[256 + ql]; if (n > CB) n = CB;
        LAS unsigned* qb_ = cbuf + ql * CB;
        if (n > 256) (void)prune256(qb_, n, wh, lane);
        else { for (int p = n + lane; p < 256; p += 64) qb_[p] = 0xffffffffu; LDS_WAIT(); }
    }
    }
    __syncthreads();
#ifndef REP_ATT
#define REP_ATT 1
#endif
    for (int ra_ = 0; ra_ < REP_ATT; ++ra_)
    for (int i = 0; i < 8; ++i) sparse_query(b, t0 + 8 * wid + i, cbuf + (8 * wid + i) * CB, wsb, L, wid, lane, WS_YB8);
    __syncthreads();
}
}

struct Args { const float* in[18]; float* out; unsigned char* ws; int ph_lo, ph_hi, use_bar, pad; };

__global__ void __launch_bounds__(NWAVES * 64, 2) mega(Args args) {
    extern __shared__ __attribute__((aligned(16))) unsigned char lds[];
    LAS unsigned char* L = (LAS unsigned char*)lds;
    volatile LAS unsigned* MISC = (volatile LAS unsigned*)(L + MISC_OFF);
    const int wave = __builtin_amdgcn_readfirstlane((int)threadIdx.x >> 6);
#define LANE_TID int lane; asm volatile("v_mbcnt_lo_u32_b32 %0, -1, 0\n\tv_mbcnt_hi_u32_b32 %0, -1, %0" : "=v"(lane)); const int tid = wave * 64 + lane; (void)tid;
    const int G = gridDim.x; const int bx = blockIdx.x; const int vcu = (G % 8 == 0) ? (bx % 8) * (G / 8) + bx / 8 : bx;
    { LANE_TID for (int u = tid; u < (LDS_BYTES - LDSCTL_OFF) / 4; u += NWAVES * 64) ((LAS unsigned*)(L + LDSCTL_OFF))[u] = 0u; }
    __syncthreads();
    if (args.use_bar) (void)xcd_barrier_post((unsigned*)((gu32*)(args.ws + WS_CTL) + CW_BAR), MISC + 8);
    if (args.use_bar && threadIdx.x == 0) {
        unsigned* bar_ = (unsigned*)((gu32*)(args.ws + WS_CTL) + CW_BAR); const unsigned x_ = xb_xcc_id() + 1u; unsigned exp_ = 0u;
        const bool first_ = __hip_atomic_compare_exchange_strong(&bar_[9216 + 64 * (bx & 7)], &exp_, x_, __ATOMIC_RELAXED, __ATOMIC_RELAXED, __HIP_MEMORY_SCOPE_AGENT);
        if ((!first_ && exp_ != x_) || (G & 7) != 0) (void)__hip_atomic_fetch_or(&bar_[10240], 1u, __ATOMIC_RELAXED, __HIP_MEMORY_SCOPE_AGENT);
    }
    const int lo = args.ph_lo, hi = args.ph_hi;
#define IN(k) (lo <= (k) && (k) < hi)
#define WSP(off) ((bf16*)(wsl + (off)))
#define WSF(off) ((float*)(wsl + (off)))
#define PHASE_WS GAS unsigned char* wsg_ = (GAS unsigned char*)args.ws; asm volatile("" : "+s"(wsg_)); unsigned char* wsl = (unsigned char*)wsg_;
#define PHASE_PTRS LANE_TID GAS unsigned char* wsg_ = (GAS unsigned char*)args.ws; asm volatile("" : "+s"(wsg_)); unsigned char* wsl = (unsigned char*)wsg_;
#define GRID_BAR(k) do { if (IN(k) && IN((k) + 1)) { XcdBarrier bb_; bb_.bar = (unsigned*)((gu32*)(args.ws + WS_CTL) + CW_BAR); bb_.x = xb_xcc_id(); bb_.st = (volatile LAS unsigned*)(L + MISC_OFF) + 8; xcd_barrier(bb_); } } while (0)
#define GROUP_MODE_INIT() do { if (args.use_bar && IN(0) && IN(1)) { if (threadIdx.x == 0) ((volatile LAS unsigned*)(L + MISC_OFF))[10] = (xb_ld((unsigned*)((gu32*)(args.ws + WS_CTL) + CW_BAR) + 10240) == 0u) ? 1u : 0u; __syncthreads(); } } while (0)
#define GROUP_BAR(k) do { if (IN(k) && IN((k) + 1)) { \
    if (((volatile LAS unsigned*)(L + MISC_OFF))[10] != 0u) { \
        asm volatile("s_waitcnt vmcnt(0)" ::: "memory"); __syncthreads();                         \
        if (threadIdx.x == 0) { unsigned* bar_ = (unsigned*)((gu32*)(args.ws + WS_CTL) + CW_BAR); const unsigned n_ = (unsigned)G >> 3; \
            __builtin_amdgcn_s_waitcnt(0); const unsigned old_ = xb_add(&bar_[8192 + 64 * (bx & 7)], 1u); const unsigned tgt_ = (old_ / n_ + 1u) * n_; \
            XB_SPIN(xb_ld(&bar_[8192 + 64 * (bx & 7)]) < tgt_, bar_); \
            __builtin_amdgcn_fence(__ATOMIC_ACQUIRE, "agent"); asm volatile("s_waitcnt vmcnt(0)" ::: "memory"); }     \
        __syncthreads(); \
    } else { XcdBarrier bb_; bb_.bar = (unsigned*)((gu32*)(args.ws + WS_CTL) + CW_BAR); bb_.x = xb_xcc_id(); bb_.st = (volatile LAS unsigned*)(L + MISC_OFF) + 8; xcd_barrier(bb_); } } } while (0)
    const int gw = vcu * NWAVES + wave, NGW = G * NWAVES;

#if (PH_MASK >> 0) & 1
    if (IN(0)) {
        PHASE_PTRS
        const float* x = as_global(args.in[0]); const float* pin = as_global(args.in[1]); const float* ln_ffn1 = as_global(args.in[2]); const float* w_ffn1_in = as_global(args.in[3]); const float* w_ffn1_out = as_global(args.in[4]); const float* ln_mix = as_global(args.in[5]); const float* w_in = as_global(args.in[6]);
        const float* w_br_a = as_global(args.in[8]); const float* w_br_b = as_global(args.in[9]); const float* w_out = as_global(args.in[10]); const float* ln_ffn2 = as_global(args.in[11]); const float* w_ffn2_in = as_global(args.in[12]); const float* w_ffn2_out = as_global(args.in[13]); const float* ln_ple = as_global(args.in[14]); const float* w_ple_gate = as_global(args.in[15]); const float* w_ple_proj = as_global(args.in[16]);
        bf16 *W1 = WSP(WS_W1), *W2 = WSP(WS_W2), *WIN = WSP(WS_WIN), *WA = WSP(WS_WA), *WB = WSP(WS_WB), *WO = WSP(WS_WO), *W3 = WSP(WS_W3), *W4 = WSP(WS_W4), *WG = WSP(WS_WG), *WP = WSP(WS_WP), *HB = WSP(WS_HB), *PB = WSP(WS_PB);
        LAS float* scr = (LAS float*)(L + RING_OFF + wave * 16384);
        constexpr int I_W1 = 16 * 176, I_W2 = 44 * 32, I_WIN = 16 * 64, I_WA = 8 * 32, I_WO = 16 * 32, I_WP = 4 * 32;
        constexpr int NITEMS = 2 * I_W1 + 2 * I_W2 + 2 * I_WIN + 2 * I_WA + 2 * I_WO + I_WP;
        const int n_it = (NITEMS - gw + NGW - 1) / NGW, n_x = (M / 2 - gw + NGW - 1) / NGW;
        for (int st = 0; st < (n_it > n_x ? n_it : n_x); ++st) {
            const int m0 = (gw + st * NGW) * 2; const bool has_x = st < n_x;
            f32x4 v[2][4];
            if (has_x) {
#pragma unroll
                for (int r = 0; r < 2; ++r) { const GAS f32x4* xr = (const GAS f32x4*)(x + (size_t)(m0 + r) * D) + lane;
#pragma unroll
                    for (int j = 0; j < 4; ++j) v[r][j] = xr[64 * j]; }
            }
            const int it = gw + st * NGW;
            if (it < NITEMS) {
                int r = it; const float* Wp_ = w_ffn1_in; int Ns = 2 * FF, Kk = D, nblk = 176, mapid = 1, f8 = 1; unsigned char* dst = (unsigned char*)W1; const float* gn = ln_ffn1;
                if (r >= I_W1) { r -= I_W1; Wp_ = w_ffn2_in; dst = (unsigned char*)W3; gn = ln_ffn2; f8 = 1;
                  if (r >= I_W1) { r -= I_W1; Wp_ = w_ffn1_out; Ns = D; Kk = FF; nblk = 32; mapid = 0; f8 = 1; dst = (unsigned char*)W2; gn = nullptr;
                    if (r >= I_W2) { r -= I_W2; Wp_ = w_ffn2_out; dst = (unsigned char*)W4; f8 = 1;
                      if (r >= I_W2) { r -= I_W2; Wp_ = w_in; Ns = DIN; Kk = D; nblk = 64; mapid = 2; f8 = 0; dst = (unsigned char*)WIN; gn = ln_mix;
                        if (r >= I_WIN) { r -= I_WIN; mapid = 3; f8 = 1; dst = (unsigned char*)WIN + 4 * MiB;
                          if (r >= I_WIN) { r -= I_WIN; Wp_ = w_br_a; Ns = D; Kk = 512; nblk = 32; mapid = 0; dst = (unsigned char*)WA; gn = nullptr;
                            if (r >= I_WA) { r -= I_WA; Wp_ = w_br_b; dst = (unsigned char*)WB;
                              if (r >= I_WA) { r -= I_WA; Wp_ = w_out; Kk = D; dst = (unsigned char*)WO;
                                if (r >= I_WO) { r -= I_WO; Wp_ = w_ple_gate; dst = (unsigned char*)WG; gn = ln_ple;
                                  if (r >= I_WO) { r -= I_WO; Wp_ = w_ple_proj; Kk = DPLE; dst = (unsigned char*)WP; gn = nullptr; } } } } } } } } } }
                tr_generic(Wp_, Ns, Kk, dst, gn, mapid, f8, scr, r, nblk, lane);
            }
            if (has_x) {
#pragma unroll
                for (int r = 0; r < 2; ++r) { float s = 0.f;
#pragma unroll
                    for (int j = 0; j < 4; ++j) s += (v[r][j].x * v[r][j].x + v[r][j].y * v[r][j].y) + (v[r][j].z * v[r][j].z + v[r][j].w * v[r][j].w);
                    const float rs = __builtin_amdgcn_rsqf(wave_sum(s) * (1.f / D) + 1e-6f);
                    GAS unsigned* o8 = (GAS unsigned*)(wsl + WS_X8 + (size_t)(m0 + r) * D) + lane;
#pragma unroll
                    for (int j = 0; j < 4; ++j) o8[64 * j] = pg8::pack4_fp8(v[r][j].x * rs, v[r][j].y * rs, v[r][j].z * rs, v[r][j].w * rs); }
            }
        }
        { const size_t NV = (size_t)M * DPLE / 4, stride = (size_t)G * 512;
          for (size_t i = (size_t)(bx * 512 + tid); i < NV; i += 4 * stride) {
            f32x4 v[4];
#pragma unroll
            for (int u = 0; u < 4; ++u) { const size_t ii = i + u * stride; v[u] = (ii < NV) ? ((const GAS f32x4*)pin)[ii] : (f32x4){0.f, 0.f, 0.f, 0.f}; }
#pragma unroll
            for (int u = 0; u < 4; ++u) { const size_t ii = i + u * stride; if (ii < NV) ((GAS unsigned*)PB)[ii] = pg8::pack4_fp8(v[u].x, v[u].y, v[u].z, v[u].w); }
          } }
    }
#endif
    GRID_BAR(0);
    GROUP_MODE_INIT();
#if (PH_MASK >> 1) & 1
    if (IN(1)) {
        PHASE_WS bf16 *HB = WSP(WS_HB), *W1 = WSP(WS_W1), *ACT = WSP(WS_ACT);
        pg8::Gemm g{WSP(WS_X8), W1, M, 2 * FF, D / 2}; pg8::StaticOrder S; S.init(M, 2 * FF, G, bx);
        pg8::EpiSwiglu<false, true, true> E{ACT, L};
        pg8::gemm_phase<pg8::EpiSwiglu<false, true, true>, pg8::StaticOrder, true, true, true>(L + RING_OFF, g, S, E, wave);
    }
#endif
    GROUP_BAR(1);
#if (PH_MASK >> 2) & 1
    if (IN(2)) {
        PHASE_WS bf16 *HB = WSP(WS_HB), *W2 = WSP(WS_W2), *ACT = WSP(WS_ACT); float* RSQ1 = WSF(WS_RSQ1); const float* x = as_global(args.in[0]);
        pg8::Gemm g{ACT, W2, M, D, FF / 2}; pg8::StaticOrder S; S.init(M, D, G, bx);
        pg8::EpiResid<true, true, true, true> E{x, HB, RSQ1, (unsigned char*)(wsl + WS_X8)};
        pg8::gemm_phase<pg8::EpiResid<true, true, true, true>, pg8::StaticOrder, true, true, true>(L + RING_OFF, g, S, E, wave);
    }
#endif
    GROUP_BAR(2);
#if (PH_MASK >> 3) & 1
    if (IN(3)) {
        PHASE_WS bf16 *HB = WSP(WS_HB), *WIN = WSP(WS_WIN); float *RSQ1 = WSF(WS_RSQ1); bf16* SG = (bf16*)as_global(args.out);
        { pg8::Gemm g{HB, WIN, M, 2048, D}; pg8::StaticOrder S; S.init(M, 2048, G, bx);
          { LANE_TID pg8::stage_rs(L, S, RSQ1, tid, 1.0f); }
          pg8::EpiProj E{L, wsl, SG};
          pg8::gemm_phase<pg8::EpiProj, pg8::StaticOrder, true, true>(L + RING_OFF, g, S, E, wave); }
        { pg8::Gemm g{WSP(WS_X8), (bf16*)((unsigned char*)WIN + 4 * MiB), M, 2048, D / 2}; pg8::StaticOrder S; S.init(M, 2048, G, bx);
          { LANE_TID pg8::stage_rs(L, S, RSQ1, tid, 1.0f); }
          pg8::EpiSig E{L, SG};
          pg8::gemm_phase<pg8::EpiSig, pg8::StaticOrder, true, true, true>(L + RING_OFF, g, S, E, wave); }
    }
#endif
    GRID_BAR(3);
#if (PH_MASK >> 4) & 1
    if (IN(4)) {
                LANE_TID unsigned char* wsl = as_global(args.ws); const float* a_sink = as_global(args.in[7]);
#ifndef NO_SWA
#ifndef REP_SWA
#define REP_SWA 1
#endif
        for (int rs_ = 0; rs_ < REP_SWA; ++rs_)
        for (int i = 0; i < 2; ++i) { const int su = vcu + 256 * i; if (su < 512) att::swa_unit(su >> 7, (su >> 1) & 63, su & 1, wsl, a_sink, L, wave, lane, tid, (rs_ + 1 < REP_SWA) ? WS_ACT : WS_YA8); }
#endif
#ifndef NO_SP
        if (vcu < 256) { const int sb = vcu >> 6, sj = vcu & 63, mh = sj >> 1;
            const int pre = 64 * sj - (mh * (mh - 1) + ((sj & 1) ? mh : 0)) + sb * 3104, cstride = (64 - mh) * 128;
            unsigned short* codes = (unsigned short*)(wsl + WS_ACT + (size_t)pre * 16384);
            att::sparse_unit(sb, sj, codes, cstride, wsl, L, wave, lane, tid);
            att::sparse_unit(sb, 127 - sj, codes, cstride, wsl, L, wave, lane, tid); }
#endif


    }
#endif
    GRID_BAR(4);
#if (PH_MASK >> 5) & 1
    if (IN(5)) {
        PHASE_WS bf16 *AQ = WSP(WS_AQ), *BQ = WSP(WS_BQ), *WA = WSP(WS_WA), *WB = WSP(WS_WB), *TA = WSP(WS_TA), *MIX = WSP(WS_MIX); bf16* SG = (bf16*)as_global(args.out);
        { pg8::Gemm g{WSP(WS_YA8), WA, M, D, 256}; pg8::StaticOrder S; S.init(M, D, G, bx);
          pg8::EpiGate<1, true, true> E{TA, SG, 0, nullptr};
          pg8::gemm_phase<pg8::EpiGate<1, true, true>, pg8::StaticOrder, true, true, true>(L + RING_OFF, g, S, E, wave); }
        VM_WAIT(); __syncthreads();
        { pg8::Gemm g{WSP(WS_YB8), WB, M, D, 256}; pg8::StaticOrder S; S.init(M, D, G, bx);
          pg8::EpiGate<2, true, true> E{MIX, SG, 1024, TA};
          pg8::gemm_phase<pg8::EpiGate<2, true, true>, pg8::StaticOrder, true, true, true>(L + RING_OFF, g, S, E, wave); }
    }
#endif
    GRID_BAR(5);
#if (PH_MASK >> 6) & 1
    if (IN(6)) {
        PHASE_WS bf16 *HB = WSP(WS_HB), *WO = WSP(WS_WO), *MIX = WSP(WS_MIX); float* RSQ2 = WSF(WS_RSQ2);
        pg8::Gemm g{MIX, WO, M, D, D / 2}; pg8::StaticOrder S; S.init(M, D, G, bx);
        pg8::EpiResid<false, false, true, true> E{nullptr, HB, RSQ2, (unsigned char*)(wsl + WS_X8)};
        pg8::gemm_phase<pg8::EpiResid<false, false, true, true>, pg8::StaticOrder, true, true, true>(L + RING_OFF, g, S, E, wave);
    }
#endif
    GROUP_BAR(6);
#if (PH_MASK >> 7) & 1
    if (IN(7)) {
        PHASE_WS bf16 *HB = WSP(WS_HB), *W3 = WSP(WS_W3), *ACT = WSP(WS_ACT); float* RSQ2 = WSF(WS_RSQ2);
        pg8::Gemm g{WSP(WS_X8), W3, M, 2 * FF, D / 2}; pg8::StaticOrder S; S.init(M, 2 * FF, G, bx);
        { LANE_TID pg8::stage_rs(L, S, RSQ2, tid, 1.0f); }
        pg8::EpiSwiglu<true, true> E{ACT, L};
        pg8::gemm_phase<pg8::EpiSwiglu<true, true>, pg8::StaticOrder, true, true, true>(L + RING_OFF, g, S, E, wave);
    }
#endif
    GROUP_BAR(7);
#if (PH_MASK >> 8) & 1
    if (IN(8)) {
        PHASE_WS bf16 *HB = WSP(WS_HB), *W4 = WSP(WS_W4), *ACT = WSP(WS_ACT); float* RSQ3 = WSF(WS_RSQ3);
        pg8::Gemm g{ACT, W4, M, D, FF / 2}; pg8::StaticOrder S; S.init(M, D, G, bx);
        pg8::EpiResid<false, true, true, true> E{nullptr, HB, RSQ3, (unsigned char*)(wsl + WS_X8)};
        pg8::gemm_phase<pg8::EpiResid<false, true, true, true>, pg8::StaticOrder, true, true, true>(L + RING_OFF, g, S, E, wave);
    }
#endif
    GROUP_BAR(8);
#if (PH_MASK >> 9) & 1
    if (IN(9)) {
        PHASE_WS bf16 *HB = WSP(WS_HB), *PB = WSP(WS_PB), *WP = WSP(WS_WP), *WG = WSP(WS_WG), *PP = WSP(WS_PP); float *RSQ3 = WSF(WS_RSQ3), *RSQ4 = WSF(WS_RSQ4); float* out = as_global(args.out);
        { pg8::Gemm g{PB, WP, M, D, DPLE / 2}; pg8::StaticOrder S; S.init(M, D, G, bx);
          pg8::EpiGate<0, true, true> E{PP, nullptr, 0, nullptr};
          pg8::gemm_phase<pg8::EpiGate<0, true, true>, pg8::StaticOrder, true, true, true>(L + RING_OFF, g, S, E, wave); }
        VM_WAIT(); __syncthreads();
        { pg8::Gemm g{WSP(WS_X8), WG, M, D, D / 2}; pg8::StaticOrder S; S.init(M, D, G, bx);
          { LANE_TID pg8::stage_rs(L, S, RSQ3, tid, 1.0f); }
          pg8::EpiPle<true> E{L, HB, PP, out, RSQ4, (unsigned*)(wsl + WS_CTL) + 32768, as_global(args.in[17])};
          pg8::gemm_phase<pg8::EpiPle<true>, pg8::StaticOrder, true, true, true>(L + RING_OFF, g, S, E, wave); }
    }
#endif
#undef IN
#undef GRID_BAR
}


#ifndef MK_SINGLE
#define MK_SINGLE 1
#endif
extern "C" void kernel_launch(void* const* d_in, const int* in_sizes, int n_in, void* d_out, int out_size, void* d_ws, size_t ws_size, hipStream_t stream) {
    static int grid = 0;
    if (grid == 0) {
        int dev = 0, cus = 0;
        if (ws_size < WS_END || hipGetDevice(&dev) != hipSuccess || hipDeviceGetAttribute(&cus, hipDeviceAttributeMultiprocessorCount, dev) != hipSuccess) { fprintf(stderr, "kernel_launch: setup failed (ws %zu)\n", ws_size); grid = -1; return; }
        if (hipFuncSetAttribute((const void*)mega, hipFuncAttributeMaxDynamicSharedMemorySize, LDS_BYTES) != hipSuccess) { fprintf(stderr, "kernel_launch: hipFuncSetAttribute failed\n"); grid = -1; return; }
        grid = cus;
    }
    if (grid < 0) return;
    (void)hipMemsetAsync((char*)d_ws + WS_CTL, 0, CTL_ZERO_BYTES, stream);
    Args a{};
    for (int i = 0; i < 18; ++i) a.in[i] = (const float*)d_in[i];
    a.out = (float*)d_out; a.ws = (unsigned char*)d_ws;
    if (MK_SINGLE) { a.use_bar = 1; a.ph_lo = 0; a.ph_hi = 10; hipLaunchKernelGGL(mega, dim3(grid), dim3(NWAVES * 64), LDS_BYTES, stream, a); }
    else { a.use_bar = 0;
#ifndef REP_MASK
#define REP_MASK 0
#endif
        for (int ph = 0; ph < 10; ++ph) { const int reps = 1 + ((REP_MASK >> ph) & 1); for (int r = 0; r < reps; ++r) { a.ph_lo = ph; a.ph_hi = ph + 1; hipLaunchKernelGGL(mega, dim3(grid), dim3(NWAVES * 64), LDS_BYTES, stream, a); } } }
}
```

```cpp
#include <hip/hip_runtime.h>
#include <cstdio>
#include <cstdint>

namespace pg8 {
#define PG8_LAS __attribute__((address_space(3)))
typedef unsigned short bf16_t;
typedef short bf16x8 __attribute__((ext_vector_type(8)));
typedef float f32x4 __attribute__((ext_vector_type(4)));
typedef unsigned u32x4 __attribute__((ext_vector_type(4)));
typedef unsigned u32x2 __attribute__((ext_vector_type(2)));
constexpr int BM = 256, BK = 64, HALF = 128, HTB = HALF * BK * 2, STAGE_BYTES = 8 * HTB, NXCD = 8, WGM = 8;

__host__ __device__ __forceinline__ int lds_byte(int r, int c) { const int st = (r >> 4) * 2 + (c >> 5), rr = r & 15, cc = c & 31, ob = rr * 64 + cc * 2; return st * 1024 + (ob ^ (((ob >> 9) & 1) << 5)); }
__host__ __device__ __forceinline__ void stage_rc(int b, int& R, int& C) { const int st = b / 1024, sb = b % 1024, swz = sb ^ (((sb >> 9) & 1) << 5); R = (st >> 1) * 16 + swz / 64; C = (st & 1) * 32 + (swz % 64) / 2; }
__host__ __device__ __forceinline__ int perm32(int rho) { const int n = rho >> 4, i = rho & 15; return 8 * (i >> 2) + 4 * n + (i & 3); }

struct Unit { int pm, pn, ord; };
struct Gemm { const bf16_t* A; const bf16_t* Bt; int M, N, K; };

struct StaticOrder {
    int nM, nN, nwg, G, c;
    __host__ __device__ void init(int M, int N, int G_, int c_) { nM = M / BM; nN = N / BM; nwg = nM * nN; G = G_; c = c_; }
    __host__ __device__ bool next(int i, Unit& u) const {
        const long L = (long)i * G + c; if (L >= nwg) return false;
        int wgid = (int)L; { const int q = nwg / NXCD, r = nwg % NXCD, xcd = wgid % NXCD, off = wgid / NXCD; wgid = (xcd < r ? xcd * (q + 1) : r * (q + 1) + (xcd - r) * q) + off; }
        const int nig = WGM * nN, gid = wgid / nig, fm = gid * WGM, gsz = (nM - fm) < WGM ? (nM - fm) : WGM;
        u.pm = fm + ((wgid % nig) % gsz); u.pn = (wgid % nig) / gsz; return true;
    }
    __device__ __forceinline__ void a_ready(const Unit&) const {}
    __device__ __forceinline__ void done(const Unit&) const {}
};

__device__ __forceinline__ unsigned cvt_pk_bf16(float lo, float hi) { unsigned r; asm volatile("v_cvt_pk_bf16_f32 %0, %1, %2" : "=v"(r) : "v"(lo), "v"(hi)); return r; }
__device__ __forceinline__ float bf_lo(unsigned w) { return __uint_as_float(w << 16); }
__device__ __forceinline__ float bf_hi(unsigned w) { return __uint_as_float(w & 0xffff0000u); }
typedef unsigned u32x2s_ __attribute__((ext_vector_type(2)));
__device__ __forceinline__ float xrow_sum(float v) {
    const u32x2s_ a = __builtin_amdgcn_permlane16_swap(__float_as_uint(v), __float_as_uint(v), false, false); const float s = __uint_as_float(a[0]) + __uint_as_float(a[1]);
    const u32x2s_ b = __builtin_amdgcn_permlane32_swap(__float_as_uint(s), __float_as_uint(s), false, false); return __uint_as_float(b[0]) + __uint_as_float(b[1]);
}
__device__ __forceinline__ float fsigmoid(float x) { return __builtin_amdgcn_rcpf(1.0f + __builtin_amdgcn_exp2f(-1.4426950408889634f * x)); }
__device__ __forceinline__ float rs_of(const float* rsq, int row) {
    const f32x4* p = (const f32x4*)(rsq + (size_t)row * 16);
    const f32x4 a = p[0], b = p[1], c = p[2], d = p[3];
    const float s = ((a[0] + a[1]) + (a[2] + a[3])) + ((b[0] + b[1]) + (b[2] + b[3])) + ((c[0] + c[1]) + (c[2] + c[3])) + ((d[0] + d[1]) + (d[2] + d[3]));
    return __builtin_amdgcn_rsqf(s * (1.0f / 1024.0f) + 1e-6f);
}
__device__ __forceinline__ void rs8_of(const float* rsq, int row0, int fq, float (&rs)[2][4]) {
    f32x4 p[2][4];
#pragma unroll
    for (int ai = 0; ai < 2; ++ai)
#pragma unroll
        for (int m = 0; m < 4; ++m) p[ai][m] = *(const f32x4*)(rsq + (size_t)(row0 + ai * HALF + m * 16) * 16 + 4 * fq);
#pragma unroll
    for (int ai = 0; ai < 2; ++ai)
#pragma unroll
        for (int m = 0; m < 4; ++m) { float s = (p[ai][m][0] + p[ai][m][1]) + (p[ai][m][2] + p[ai][m][3]); s = xrow_sum(s); rs[ai][m] = __builtin_amdgcn_rsqf(s * (1.0f / 1024.0f) + 1e-6f); }
}
constexpr int RS_LDS_OFF = 131072, RS_LDS_MAXU = 12;
template <class Sched> __device__ __forceinline__ void stage_rs(PG8_LAS unsigned char* lds0, const Sched& S, const float* rsq, int tid, float mul) {
    PG8_LAS float* tab = (PG8_LAS float*)(lds0 + RS_LDS_OFF);
    Unit u;
    for (int i = 0; i < RS_LDS_MAXU && S.next(i, u); ++i) if (tid < 256) tab[i * 256 + tid] = rs_of(rsq, u.pm * BM + tid) * mul;
    asm volatile("s_waitcnt lgkmcnt(0)" ::: "memory"); __builtin_amdgcn_s_barrier(); asm volatile("" ::: "memory");
}
__device__ __forceinline__ void rs8_lds(PG8_LAS unsigned char* lds0, int ord, int wr, int fr, float (&rs)[2][4]) {
    const PG8_LAS float* tab = (const PG8_LAS float*)(lds0 + RS_LDS_OFF) + ord * 256 + wr * 64 + fr;
#pragma unroll
    for (int ai = 0; ai < 2; ++ai)
#pragma unroll
        for (int m = 0; m < 4; ++m) rs[ai][m] = tab[ai * HALF + m * 16];
}
__device__ __forceinline__ u32x4 pack8(const f32x4 v0, const f32x4 v1) { u32x4 w; w.x = cvt_pk_bf16(v0[0], v0[1]); w.y = cvt_pk_bf16(v0[2], v0[3]); w.z = cvt_pk_bf16(v1[0], v1[1]); w.w = cvt_pk_bf16(v1[2], v1[3]); return w; }
__device__ __forceinline__ void unpack8(const u32x4 w, f32x4& v0, f32x4& v1) { v0 = (f32x4){bf_lo(w.x), bf_hi(w.x), bf_lo(w.y), bf_hi(w.y)}; v1 = (f32x4){bf_lo(w.z), bf_hi(w.z), bf_lo(w.w), bf_hi(w.w)}; }
__device__ __forceinline__ float sq8(const f32x4 a, const f32x4 b) { return ((a[0] * a[0] + a[1] * a[1]) + (a[2] * a[2] + a[3] * a[3])) + ((b[0] * b[0] + b[1] * b[1]) + (b[2] * b[2] + b[3] * b[3])); }

typedef float f32x2_ __attribute__((ext_vector_type(2)));
__device__ __forceinline__ void unpack8_f8(const u32x2 w, f32x4& v0, f32x4& v1) {
    const f32x2_ a = __builtin_amdgcn_cvt_pk_f32_fp8((int)w.x, false), b = __builtin_amdgcn_cvt_pk_f32_fp8((int)w.x, true), c = __builtin_amdgcn_cvt_pk_f32_fp8((int)w.y, false), d = __builtin_amdgcn_cvt_pk_f32_fp8((int)w.y, true);
    v0 = (f32x4){a[0], a[1], b[0], b[1]}; v1 = (f32x4){c[0], c[1], d[0], d[1]};
}
constexpr float F8_WSCALE = 64.0f;
__device__ __forceinline__ unsigned pack4_fp8(float a, float b, float c, float d) { int p = __builtin_amdgcn_cvt_pk_fp8_f32(a, b, 0, false); p = __builtin_amdgcn_cvt_pk_fp8_f32(c, d, p, true); return (unsigned)p; }
template <bool HAS_RS, bool F8, bool F8OUT = F8> struct EpiSwiglu {
    static constexpr bool PERM = true, AFTER_DRAIN = false;
    bf16_t* O; PG8_LAS unsigned char* lds0;
    __device__ __forceinline__ void operator()(const f32x4 (&acc)[2][2][4][2], const Unit& u, int wr, int wc, int fr, int fq) const {
        const int row0 = u.pm * BM + wr * 64 + fr, oc = u.pn * 128 + wc * 32 + 8 * fq;
        float rs8[2][4]; if (HAS_RS) rs8_lds(lds0, u.ord, wr, fr, rs8);
#pragma unroll
        for (int ai = 0; ai < 2; ++ai)
#pragma unroll
            for (int m = 0; m < 4; ++m) {
                const int row = row0 + ai * HALF + m * 16;
                float rs = F8 ? (1.0f / F8_WSCALE) : 1.f; if (HAS_RS) rs *= rs8[ai][m];
                const float rsl = -1.4426950408889634f * rs, rs2 = rs * rs;
                f32x4 o0, o1;
#pragma unroll
                for (int j = 0; j < 4; ++j) {
                    const float A0 = acc[ai][0][m][0][j], A1 = acc[ai][0][m][1][j];
                    const float r0 = __builtin_amdgcn_rcpf(1.0f + __builtin_amdgcn_exp2f(A0 * rsl)), r1 = __builtin_amdgcn_rcpf(1.0f + __builtin_amdgcn_exp2f(A1 * rsl));
                    o0[j] = (A0 * acc[ai][1][m][0][j]) * (r0 * rs2); o1[j] = (A1 * acc[ai][1][m][1][j]) * (r1 * rs2);
                }
                if (F8OUT) { u32x2 w; w.x = pack4_fp8(o0[0], o0[1], o0[2], o0[3]); w.y = pack4_fp8(o1[0], o1[1], o1[2], o1[3]); *(u32x2*)((unsigned char*)O + (size_t)row * 2816 + oc) = w; }
                else *(u32x4*)(O + (size_t)row * 2816 + oc) = pack8(o0, o1);
            }
    }
};
template <bool SRC_F32, bool HALF_ALPHA, bool F8IN, bool F8COPY> struct EpiResid {
    static constexpr bool PERM = true, AFTER_DRAIN = false;
    const float* X; bf16_t* H; float* rsq_out; unsigned char* H8;
    __device__ __forceinline__ void operator()(const f32x4 (&acc)[2][2][4][2], const Unit& u, int wr, int wc, int fr, int fq) const {
        const int row0 = u.pm * BM + wr * 64 + fr, c0 = u.pn * BM + wc * 32 + 8 * fq;
        const float alpha = (HALF_ALPHA ? 0.5f : 1.0f) * (F8IN ? (1.0f / F8_WSCALE) : 1.0f);
#pragma unroll
        for (int ai = 0; ai < 2; ++ai) {
            u32x4 rb[4][2]; f32x4 rf[SRC_F32 ? 4 : 1][2][2];
            if (!SRC_F32) {
#pragma unroll
                for (int m = 0; m < 4; ++m)
#pragma unroll
                    for (int bj = 0; bj < 2; ++bj) rb[m][bj] = *(const u32x4*)(H + (size_t)(row0 + ai * HALF + m * 16) * 1024 + c0 + bj * HALF);
            }
#pragma unroll
            for (int mh = 0; mh < 2; ++mh) {
                if (SRC_F32) {
#pragma unroll
                    for (int m2 = 0; m2 < 2; ++m2)
#pragma unroll
                        for (int bj = 0; bj < 2; ++bj) { const float* xp = X + (size_t)(row0 + ai * HALF + (2 * mh + m2) * 16) * 1024 + c0 + bj * HALF; rf[2 * mh + m2][bj][0] = *(const f32x4*)xp; rf[2 * mh + m2][bj][1] = *(const f32x4*)(xp + 4); }
                }
#pragma unroll
                for (int m2 = 0; m2 < 2; ++m2) {
                    const int m = 2 * mh + m2, row = row0 + ai * HALF + m * 16; float sq = 0.f;
#pragma unroll
                    for (int bj = 0; bj < 2; ++bj) {
                        const size_t off = (size_t)row * 1024 + c0 + bj * HALF; f32x4 r0, r1;
                        if (SRC_F32) { r0 = rf[m][bj][0]; r1 = rf[m][bj][1]; } else unpack8(rb[m][bj], r0, r1);
                        const f32x4 v0 = r0 + alpha * acc[ai][bj][m][0], v1 = r1 + alpha * acc[ai][bj][m][1];
                        sq += sq8(v0, v1);
                        *(u32x4*)(H + off) = pack8(v0, v1);
                        if (F8COPY) { u32x2 w8; w8.x = pack4_fp8(v0[0], v0[1], v0[2], v0[3]); w8.y = pack4_fp8(v1[0], v1[1], v1[2], v1[3]); *(u32x2*)(H8 + off) = w8; }
                    }
                    sq = xrow_sum(sq);
                    if (fq == 0) rsq_out[(size_t)row * 16 + u.pn * 4 + wc] = sq;
                }
                asm volatile("" ::: "memory");
            }
        }
    }
};
constexpr size_t PJ_MiB = 1u << 20, PJ_AQ = 336 * PJ_MiB, PJ_BQ = 368 * PJ_MiB, PJ_IQ = 400 * PJ_MiB, PJ_AK = 432 * PJ_MiB, PJ_AVT = 440 * PJ_MiB, PJ_BK = 448 * PJ_MiB, PJ_BV = 452 * PJ_MiB, PJ_IK = 456 * PJ_MiB, PJ_IW = 9 * PJ_MiB;
struct EpiProj {
    static constexpr bool PERM = true, AFTER_DRAIN = false;
    PG8_LAS unsigned char* lds0; unsigned char* wsb; bf16_t* SG;
    __device__ __forceinline__ void dest(int pn, int cw, bf16_t*& base, int& stride, int& col0, int& kind) const {
        kind = 0; base = SG; stride = 2048; col0 = 0;
        if (pn < 2) { base = (bf16_t*)(wsb + PJ_AQ); stride = 512; col0 = pn * 256 + cw; }
        else if (pn == 2) { if (cw < 128) { base = (bf16_t*)(wsb + PJ_AK); stride = 128; col0 = cw; } else { kind = 2; base = (bf16_t*)(wsb + PJ_AVT); col0 = cw - 128; } }
        else if (pn < 5) { kind = 5; base = (bf16_t*)(wsb + PJ_BQ); stride = 512; col0 = (pn - 3) * 256 + cw; }
        else if (pn == 5) { stride = 64;
            if (cw < 64) { kind = 5; base = (bf16_t*)(wsb + PJ_BK); col0 = cw; } else if (cw < 128) { kind = 5; base = (bf16_t*)(wsb + PJ_BV); col0 = cw - 64; } else if (cw < 192) { base = (bf16_t*)(wsb + PJ_IK); col0 = cw - 128; }
            else if (cw == 192) { kind = 3; base = (bf16_t*)(wsb + PJ_IW); } else kind = 4; }
        else if (pn < 8) { base = (bf16_t*)(wsb + PJ_IQ); stride = 512; col0 = (pn - 6) * 256 + cw; }
        else { kind = 1; col0 = (pn - 8) * 256 + cw; }
    }
    __device__ __forceinline__ void operator()(const f32x4 (&acc)[2][2][4][2], const Unit& u, int wr, int wc, int fr, int fq) const {
        const int row0 = u.pm * BM + wr * 64 + fr;
        bf16_t *base0, *base1; int st0, st1, c00, c01, k0, k1;
        dest(u.pn, wc * 32, base0, st0, c00, k0); dest(u.pn, HALF + wc * 32, base1, st1, c01, k1);
        float rs8[2][4]; rs8_lds(lds0, u.ord, wr, fr, rs8);
#pragma unroll
        for (int ai = 0; ai < 2; ++ai)
#pragma unroll
            for (int m = 0; m < 4; ++m) {
                const int row = row0 + ai * HALF + m * 16; const float rs = rs8[ai][m];
#pragma unroll
                for (int bj = 0; bj < 2; ++bj) {
                    bf16_t* base = bj ? base1 : base0; const int stride = bj ? st1 : st0, col0 = bj ? c01 : c00, kind = bj ? k1 : k0;
                    f32x4 v0 = acc[ai][bj][m][0] * rs, v1 = acc[ai][bj][m][1] * rs;
                    if (kind == 1) {
#pragma unroll
                        for (int j = 0; j < 4; ++j) { v0[j] = fsigmoid(v0[j]); v1[j] = fsigmoid(v1[j]); }
                    }
                    if (kind <= 1) { *(u32x4*)(base + (size_t)row * stride + col0 + 8 * fq) = pack8(v0, v1); }
                    else if (kind == 2) { const int i = col0 + 8 * fq, g = i >> 6, d = i & 63, b = row >> 13, t = row & 8191; bf16_t* p = base + ((size_t)((b * 2 + g) * 64 + d)) * 8192 + t; const u32x4 w = pack8(v0, v1);
                        p[0] = (bf16_t)(w.x & 0xffffu); p[8192] = (bf16_t)(w.x >> 16); p[2 * 8192] = (bf16_t)(w.y & 0xffffu); p[3 * 8192] = (bf16_t)(w.y >> 16);
                        p[4 * 8192] = (bf16_t)(w.z & 0xffffu); p[5 * 8192] = (bf16_t)(w.z >> 16); p[6 * 8192] = (bf16_t)(w.w & 0xffffu); p[7 * 8192] = (bf16_t)(w.w >> 16); }
                    else if (kind == 5) { u32x2 w8; w8.x = pack4_fp8(v0[0], v0[1], v0[2], v0[3]); w8.y = pack4_fp8(v1[0], v1[1], v1[2], v1[3]); *(u32x2*)((unsigned char*)base + (size_t)row * stride + col0 + 8 * fq) = w8; }
                    else if (kind == 3) { if (fq == 0) { float* iw = (float*)base + (size_t)row * 8; *(f32x4*)iw = v0; *(f32x4*)(iw + 4) = v1; } }
                }
                asm volatile("" ::: "memory");
            }
    }
};
struct EpiSig {
    static constexpr bool PERM = true, AFTER_DRAIN = false;
    PG8_LAS unsigned char* lds0; bf16_t* SG;
    __device__ __forceinline__ void operator()(const f32x4 (&acc)[2][2][4][2], const Unit& u, int wr, int wc, int fr, int fq) const {
        const int row0 = u.pm * BM + wr * 64 + fr, c0 = u.pn * BM + wc * 32 + 8 * fq;
        float rs8[2][4]; rs8_lds(lds0, u.ord, wr, fr, rs8);
#pragma unroll
        for (int ai = 0; ai < 2; ++ai)
#pragma unroll
            for (int m = 0; m < 4; ++m) {
                const int row = row0 + ai * HALF + m * 16; const float rs = rs8[ai][m] * (1.0f / F8_WSCALE);
#pragma unroll
                for (int bj = 0; bj < 2; ++bj) {
                    f32x4 v0 = acc[ai][bj][m][0] * rs, v1 = acc[ai][bj][m][1] * rs;
#pragma unroll
                    for (int j = 0; j < 4; ++j) { v0[j] = fsigmoid(v0[j]); v1[j] = fsigmoid(v1[j]); }
                    { u32x2 w8; w8.x = pack4_fp8(v0[0], v0[1], v0[2], v0[3]); w8.y = pack4_fp8(v1[0], v1[1], v1[2], v1[3]); *(u32x2*)((unsigned char*)SG + ((size_t)(u.pm >> 4) << 23) + (size_t)row * 2048 + c0 + bj * HALF) = w8; }
                }
            }
    }
};
template <int MODE, bool F8OUT = false, bool F8IN = false> struct EpiGate {
    static constexpr bool PERM = true, AFTER_DRAIN = false;
    bf16_t* O; const bf16_t* G; int gofs; const bf16_t* P;
    __device__ __forceinline__ void operator()(const f32x4 (&acc)[2][2][4][2], const Unit& u, int wr, int wc, int fr, int fq) const {
        const int row0 = u.pm * BM + wr * 64 + fr, c0 = u.pn * BM + wc * 32 + 8 * fq;
#pragma unroll
        for (int ai = 0; ai < 2; ++ai) {
            u32x2 gv[4][2], pv[4][2];
            if (MODE >= 1) {
#pragma unroll
                for (int m = 0; m < 4; ++m)
#pragma unroll
                    for (int bj = 0; bj < 2; ++bj) gv[m][bj] = *(const u32x2*)((const unsigned char*)G + ((size_t)(u.pm >> 4) << 23) + (size_t)(row0 + ai * HALF + m * 16) * 2048 + gofs + c0 + bj * HALF);
            }
            if (MODE == 2) {
#pragma unroll
                for (int m = 0; m < 4; ++m)
#pragma unroll
                    for (int bj = 0; bj < 2; ++bj) pv[m][bj] = *(const u32x2*)((const unsigned char*)P + (size_t)(row0 + ai * HALF + m * 16) * 1024 + c0 + bj * HALF);
            }
#pragma unroll
            for (int m = 0; m < 4; ++m) {
                const int row = row0 + ai * HALF + m * 16;
#pragma unroll
                for (int bj = 0; bj < 2; ++bj) {
                    const int col = c0 + bj * HALF; f32x4 v0 = acc[ai][bj][m][0], v1 = acc[ai][bj][m][1];
                    if (F8IN) { v0 = v0 * (1.0f / F8_WSCALE); v1 = v1 * (1.0f / F8_WSCALE); }
                    if (MODE >= 1) { f32x4 g0, g1; unpack8_f8(gv[m][bj], g0, g1); v0 = v0 * g0; v1 = v1 * g1; }
                    if (MODE == 2) { f32x4 p0, p1; unpack8_f8(pv[m][bj], p0, p1); v0 = v0 + p0; v1 = v1 + p1; }
                    if (F8OUT) { u32x2 w8; w8.x = pack4_fp8(v0[0], v0[1], v0[2], v0[3]); w8.y = pack4_fp8(v1[0], v1[1], v1[2], v1[3]); *(u32x2*)((unsigned char*)O + (size_t)row * 1024 + col) = w8; }
                    else *(u32x4*)(O + (size_t)row * 1024 + col) = pack8(v0, v1);
                }
            }
            asm volatile("" ::: "memory");
        }
    }
};
template <bool F8IN> struct EpiPle {
    static constexpr bool PERM = true, AFTER_DRAIN = false;
    PG8_LAS unsigned char* lds0; const bf16_t* H; const bf16_t* PP; float* out; float* rsq_out; unsigned* cnt; const float* gfin;
    __device__ __forceinline__ void operator()(f32x4 (&acc)[2][2][4][2], const Unit& u, int wr, int wc, int fr, int fq) const {
        const int row0 = u.pm * BM + wr * 64 + fr, c0 = u.pn * BM + wc * 32 + 8 * fq;
        float rs8[2][4]; rs8_lds(lds0, u.ord, wr, fr, rs8);
#pragma unroll
        for (int aim = 0; aim < 4; ++aim) {
            const int ai = aim >> 1;
            u32x4 hv[2][2]; u32x2 qv[2][2];
#pragma unroll
            for (int m2 = 0; m2 < 2; ++m2)
#pragma unroll
                for (int bj = 0; bj < 2; ++bj) { const size_t off = (size_t)(row0 + ai * HALF + (2 * (aim & 1) + m2) * 16) * 1024 + c0 + bj * HALF; hv[m2][bj] = *(const u32x4*)(H + off); qv[m2][bj] = *(const u32x2*)((const unsigned char*)PP + off); }
#pragma unroll
            for (int m2 = 0; m2 < 2; ++m2) {
                const int m = 2 * (aim & 1) + m2;
                const int row = row0 + ai * HALF + m * 16; const float rs = rs8[ai][m] * (F8IN ? (1.0f / F8_WSCALE) : 1.0f); float sq = 0.f;
#pragma unroll
                for (int bj = 0; bj < 2; ++bj) {
                    f32x4 h0, h1, p0, p1; unpack8(hv[m2][bj], h0, h1); unpack8_f8(qv[m2][bj], p0, p1);
                    f32x4 v0 = acc[ai][bj][m][0] * rs, v1 = acc[ai][bj][m][1] * rs;
#pragma unroll
                    for (int j = 0; j < 4; ++j) { v0[j] = h0[j] + fsigmoid(v0[j]) * p0[j]; v1[j] = h1[j] + fsigmoid(v1[j]) * p1[j]; }
                    sq += sq8(v0, v1);
                    acc[ai][bj][m][0] = v0; acc[ai][bj][m][1] = v1;
                }
                sq = xrow_sum(sq);
                if (fq == 0) __hip_atomic_store((unsigned*)(rsq_out + (size_t)row * 16 + u.pn * 4 + wc), __float_as_uint(sq), __ATOMIC_RELAXED, __HIP_MEMORY_SCOPE_AGENT);
            }
            asm volatile("" ::: "memory");
        }
        asm volatile("s_waitcnt vmcnt(0)" ::: "memory");
        unsigned* pc = cnt + 64 * u.pm;
        if ((fr | fq) == 0) __hip_atomic_fetch_add(pc, 1u, __ATOMIC_RELAXED, __HIP_MEMORY_SCOPE_AGENT);
        { unsigned spins = 0;
          while ((unsigned)__builtin_amdgcn_readfirstlane(__hip_atomic_load(pc, __ATOMIC_RELAXED, __HIP_MEMORY_SCOPE_AGENT)) < 32u) { __builtin_amdgcn_s_sleep(2); if (++spins > (1u << 22)) break; } }
        __builtin_amdgcn_fence(__ATOMIC_ACQUIRE, "agent");
        asm volatile("s_waitcnt vmcnt(0)" ::: "memory");
        f32x4 g00 = *(const f32x4*)(gfin + c0), g01 = *(const f32x4*)(gfin + c0 + 4), g10 = *(const f32x4*)(gfin + c0 + HALF), g11 = *(const f32x4*)(gfin + c0 + HALF + 4);
        float rf8[2][4]; rs8_of(rsq_out, row0, fq, rf8);
#pragma unroll
        for (int ai = 0; ai < 2; ++ai)
#pragma unroll
            for (int m = 0; m < 4; ++m) {
                const int row = row0 + ai * HALF + m * 16; const float rs = rf8[ai][m];
                const size_t off = (size_t)row * 1024 + c0;
                *(f32x4*)(out + off) = acc[ai][0][m][0] * rs * g00; *(f32x4*)(out + off + 4) = acc[ai][0][m][1] * rs * g01;
                *(f32x4*)(out + off + HALF) = acc[ai][1][m][0] * rs * g10; *(f32x4*)(out + off + HALF + 4) = acc[ai][1][m][1] * rs * g11;
                asm volatile("" ::: "memory");
            }
    }
};

template <class Epi, class Sched, bool ALIGN_EPI = false, bool SP2 = false, bool F8 = false>
__device__ __forceinline__ void gemm_phase(PG8_LAS unsigned char* lds, const Gemm g, const Sched& S, const Epi& E, int wid_s) {
    int lane_o; asm volatile("v_mbcnt_lo_u32_b32 %0, -1, 0\n\tv_mbcnt_hi_u32_b32 %0, -1, %0" : "=v"(lane_o)); const int tid = wid_s * 64 + lane_o;
    const int wid = __builtin_amdgcn_readfirstlane(tid >> 6), lane = tid & 63, wr = wid >> 2, wc = wid & 3, fr = lane & 15, fq = lane >> 4;
    int f8scale_ = 0x7f7f7f7f; if constexpr (F8) asm volatile("" : "+v"(f8scale_));     (void)f8scale_;
    const int K = g.K, nt = K / BK;
    unsigned voffA[2], voffB[2];
#pragma unroll
    for (int i = 0; i < 2; ++i) { int R, C; stage_rc(tid * 16 + i * 8192, R, C); const int Rb = Epi::PERM ? ((R & ~31) + perm32(R & 31)) : R;
        voffA[i] = (unsigned)(R * K + C) * 2u; voffB[i] = (unsigned)(Rb * K + C) * 2u; }
    const size_t kstep = (size_t)(BK * 2);
    const size_t hstep = (size_t)HALF * K * 2;
    const size_t tstep = 2 * hstep;
    const unsigned ldsw = (unsigned)wid * 1024u;
    const int aoff = lds_byte(wr * 64 + fr, fq * 8), boff = lds_byte(wc * 32 + fr, fq * 8);
#define PG8_SA(b, h) (((b) * 2 + (h)) * HTB)
#define PG8_SB(b, h) ((4 + (b) * 2 + (h)) * HTB)
#define PG8_STAGE(bufoff, gbase, voff) do { _Pragma("unroll") for (int _i = 0; _i < 2; ++_i) \
        __builtin_amdgcn_global_load_lds((const unsigned*)((const char*)(gbase) + (voff)[_i]), (PG8_LAS unsigned*)(lds + (bufoff) + ldsw + _i * 8192), 16, 0, 0); } while (0)
#define PG8_LDA(dst, b, h) do { _Pragma("unroll") for (int m = 0; m < 4; ++m) _Pragma("unroll") for (int k = 0; k < 2; ++k) dst[m][k] = *(const PG8_LAS bf16x8*)(lds + PG8_SA(b, h) + aoff + m * 2048 + k * 1024); } while (0)
#define PG8_LDB(dst, b, h) do { _Pragma("unroll") for (int n = 0; n < 2; ++n) _Pragma("unroll") for (int k = 0; k < 2; ++k) dst[n][k] = *(const PG8_LAS bf16x8*)(lds + PG8_SB(b, h) + boff + n * 2048 + k * 1024); } while (0)
#define PG8_MMA(ai, bj, At, Bt) do { __builtin_amdgcn_s_setprio(1); \
        if constexpr (F8) { typedef int v8i_ __attribute__((ext_vector_type(8))); typedef int v4i_ __attribute__((ext_vector_type(4))); \
            _Pragma("unroll") for (int m = 0; m < 4; ++m) _Pragma("unroll") for (int n = 0; n < 2; ++n) { \
                const v4i_ b0_ = __builtin_bit_cast(v4i_, Bt[n][0]), b1_ = __builtin_bit_cast(v4i_, Bt[n][1]), a0_ = __builtin_bit_cast(v4i_, At[m][0]), a1_ = __builtin_bit_cast(v4i_, At[m][1]); \
                const v8i_ bb_ = {b0_[0], b0_[1], b0_[2], b0_[3], b1_[0], b1_[1], b1_[2], b1_[3]}, aa_ = {a0_[0], a0_[1], a0_[2], a0_[3], a1_[0], a1_[1], a1_[2], a1_[3]}; \
                asm volatile("v_mfma_scale_f32_16x16x128_f8f6f4 %0, %1, %2, %0, %3, %3 op_sel_hi:[0,0,0]" : "+v"(acc[ai][bj][m][n]) : "v"(bb_), "v"(aa_), "v"(f8scale_)); } } \
        else { _Pragma("unroll") for (int m = 0; m < 4; ++m) _Pragma("unroll") for (int n = 0; n < 2; ++n) _Pragma("unroll") for (int k = 0; k < 2; ++k) \
            acc[ai][bj][m][n] = __builtin_amdgcn_mfma_f32_16x16x32_bf16(Bt[n][k], At[m][k], acc[ai][bj][m][n], 0, 0, 0); } \
        __builtin_amdgcn_s_setprio(0); } while (0)
#define PG8_WAIT_V(n) asm volatile("s_waitcnt vmcnt(" #n ")" ::: "memory")
#define PG8_WAIT_L(n) asm volatile("s_waitcnt lgkmcnt(" #n ")" ::: "memory")
#define PG8_BAR __builtin_amdgcn_s_barrier()
#define PG8_SCHED __builtin_amdgcn_sched_barrier(0)
    Unit cur, nxt; int ui = 0;
    if (!S.next(0, cur)) return;
    cur.ord = 0;
    f32x4 acc[2][2][4][2];
#pragma unroll
    for (int a = 0; a < 2; ++a)
#pragma unroll
        for (int b = 0; b < 2; ++b)
#pragma unroll
            for (int m = 0; m < 4; ++m)
#pragma unroll
                for (int n = 0; n < 2; ++n) acc[a][b][m][n] = (f32x4){0.f, 0.f, 0.f, 0.f};
    bf16x8 At[4][2], B0[2][2], B1[2][2];
    const char* cA = (const char*)g.A + (size_t)cur.pm * tstep; const char* cB = (const char*)g.Bt + (size_t)cur.pn * tstep;
    S.a_ready(cur);
    if constexpr (SP2) {
        PG8_STAGE(PG8_SB(0, 0), cB, voffB); PG8_STAGE(PG8_SB(0, 1), cB + hstep, voffB); PG8_STAGE(PG8_SA(0, 0), cA, voffA); PG8_STAGE(PG8_SA(0, 1), cA + hstep, voffA);
        if (wr == 1) PG8_BAR;
        PG8_WAIT_V(2); PG8_BAR;
        PG8_STAGE(PG8_SB(1, 0), cB + kstep, voffB); PG8_STAGE(PG8_SA(1, 0), cA + kstep, voffA); PG8_STAGE(PG8_SB(1, 1), cB + hstep + kstep, voffB);
        PG8_WAIT_V(6); PG8_BAR;
    } else {
        PG8_STAGE(PG8_SB(0, 0), cB, voffB); PG8_STAGE(PG8_SA(0, 0), cA, voffA); PG8_STAGE(PG8_SB(0, 1), cB + hstep, voffB); PG8_STAGE(PG8_SA(0, 1), cA + hstep, voffA);
        if (wr == 1) PG8_BAR;
        PG8_WAIT_V(4); PG8_BAR;
        PG8_STAGE(PG8_SB(1, 0), cB + kstep, voffB); PG8_STAGE(PG8_SA(1, 0), cA + kstep, voffA); PG8_STAGE(PG8_SB(1, 1), cB + hstep + kstep, voffB);
        PG8_WAIT_V(6); PG8_BAR;
    }
    for (;;) {
        const bool has_next = S.next(ui + 1, nxt); nxt.ord = ui + 1;
        const char* nA = has_next ? (const char*)g.A + (size_t)nxt.pm * tstep : cA; const char* nB = has_next ? (const char*)g.Bt + (size_t)nxt.pn * tstep : cB;
        for (int t = 0; t < nt; t += 2) {
            const bool last = (t == nt - 2);
            const char* a1 = cA + (size_t)(t + 1) * kstep;
            const char* a2 = last ? nA : cA + (size_t)(t + 2) * kstep; const char* b2 = last ? nB : cB + (size_t)(t + 2) * kstep;
            const char* a3 = a2 + kstep; const char* b3 = b2 + kstep;
            if (last && has_next) S.a_ready(nxt);
            if constexpr (SP2) {
            PG8_LDB(B0, 0, 0); PG8_LDB(B1, 0, 1); PG8_SCHED; PG8_LDA(At, 0, 0); PG8_STAGE(PG8_SA(1, 1), a1 + hstep, voffA);
            PG8_WAIT_V(8); PG8_WAIT_L(0); PG8_BAR; PG8_MMA(0, 0, At, B0); PG8_MMA(0, 1, At, B1); PG8_BAR; PG8_SCHED;
            PG8_LDA(At, 0, 1); PG8_STAGE(PG8_SB(0, 0), b2, voffB); PG8_STAGE(PG8_SB(0, 1), b2 + hstep, voffB); PG8_STAGE(PG8_SA(0, 0), a2, voffA);
            PG8_WAIT_V(8); PG8_WAIT_L(0); PG8_BAR; PG8_MMA(1, 0, At, B0); PG8_MMA(1, 1, At, B1); PG8_BAR; PG8_SCHED;
            PG8_LDB(B0, 1, 0); PG8_LDB(B1, 1, 1); PG8_SCHED; PG8_LDA(At, 1, 0); PG8_STAGE(PG8_SA(0, 1), a2 + hstep, voffA);
            PG8_WAIT_V(8); PG8_WAIT_L(0); PG8_BAR; PG8_MMA(0, 0, At, B0); PG8_MMA(0, 1, At, B1); PG8_BAR; PG8_SCHED;
            PG8_LDA(At, 1, 1); PG8_STAGE(PG8_SB(1, 0), b3, voffB); PG8_STAGE(PG8_SB(1, 1), b3 + hstep, voffB); PG8_STAGE(PG8_SA(1, 0), a3, voffA);
            PG8_WAIT_V(8); PG8_WAIT_L(0); PG8_BAR; PG8_MMA(1, 0, At, B0); PG8_MMA(1, 1, At, B1); PG8_BAR; PG8_SCHED;
            } else {
            PG8_LDB(B0, 0, 0); PG8_SCHED; PG8_LDA(At, 0, 0); PG8_STAGE(PG8_SA(1, 1), a1 + hstep, voffA);
            PG8_WAIT_L(8); PG8_BAR; PG8_WAIT_L(0); PG8_MMA(0, 0, At, B0); PG8_BAR; PG8_SCHED;
            PG8_LDB(B1, 0, 1); PG8_STAGE(PG8_SB(0, 0), b2, voffB);
            PG8_BAR; PG8_WAIT_L(0); PG8_MMA(0, 1, At, B1); PG8_BAR;
            PG8_LDA(At, 0, 1); PG8_STAGE(PG8_SA(0, 0), a2, voffA);
            PG8_BAR; PG8_WAIT_L(0); PG8_MMA(1, 0, At, B0); PG8_BAR; PG8_SCHED;
            PG8_STAGE(PG8_SB(0, 1), b2 + hstep, voffB);
            PG8_WAIT_V(6); PG8_BAR; PG8_MMA(1, 1, At, B1); PG8_BAR;
            PG8_LDB(B0, 1, 0); PG8_SCHED; PG8_LDA(At, 1, 0); PG8_STAGE(PG8_SA(0, 1), a2 + hstep, voffA);
            PG8_WAIT_L(8); PG8_BAR; PG8_WAIT_L(0); PG8_MMA(0, 0, At, B0); PG8_BAR; PG8_SCHED;
            PG8_LDB(B1, 1, 1); PG8_STAGE(PG8_SB(1, 0), b3, voffB);
            PG8_BAR; PG8_WAIT_L(0); PG8_MMA(0, 1, At, B1); PG8_BAR;
            PG8_LDA(At, 1, 1); PG8_STAGE(PG8_SA(1, 0), a3, voffA);
            PG8_BAR; PG8_WAIT_L(0); PG8_MMA(1, 0, At, B0); PG8_BAR; PG8_SCHED;
            PG8_STAGE(PG8_SB(1, 1), b3 + hstep, voffB);
            PG8_WAIT_V(6); PG8_BAR; PG8_MMA(1, 1, At, B1); PG8_BAR;
            }
        }
        if constexpr (F8) asm volatile("s_nop 15\n\ts_nop 15" ::: "memory");
        if constexpr (ALIGN_EPI) { if (wr == 0) PG8_BAR; }
        if constexpr (!Epi::AFTER_DRAIN) { E(acc, cur, wr, wc, fr, fq); S.done(cur); }
        if (!has_next) break;
#pragma unroll
        for (int a = 0; a < 2; ++a)
#pragma unroll
            for (int b = 0; b < 2; ++b)
#pragma unroll
                for (int m = 0; m < 4; ++m)
#pragma unroll
                    for (int n = 0; n < 2; ++n) acc[a][b][m][n] = (f32x4){0.f, 0.f, 0.f, 0.f};
        cur = nxt; cA = nA; cB = nB; ++ui;
        if constexpr (ALIGN_EPI) { if (wr == 1) PG8_BAR; }
    }
    PG8_WAIT_V(0);
    if constexpr (!ALIGN_EPI) { if (wr == 0) PG8_BAR; }
    PG8_BAR;
    if constexpr (Epi::AFTER_DRAIN) { E.fused(acc, cur, wr, wc, fr, fq, lds, wid, lane); S.done(cur); }
#undef PG8_SA
#undef PG8_SB
#undef PG8_STAGE
#undef PG8_LDA
#undef PG8_LDB
#undef PG8_MMA
#undef PG8_WAIT_V
#undef PG8_WAIT_L
#undef PG8_BAR
#undef PG8_SCHED
}
}

#define GAS __attribute__((address_space(1)))
#define LAS __attribute__((address_space(3)))
typedef unsigned short bf16;
typedef unsigned v4u __attribute__((ext_vector_type(4)));
typedef float f32x4 __attribute__((ext_vector_type(4)));
typedef short bf16x8 __attribute__((ext_vector_type(8)));
typedef GAS unsigned gu32;
typedef GAS unsigned long long gu64;
#define RLX_AGENT __ATOMIC_RELAXED, __HIP_MEMORY_SCOPE_AGENT

#define XB_TMO      128
#define XB_XCNT(j)  (256  + 64 * (j))
#define XB_XSUB(j)  (1280 + 64 * (j))
#define XB_XGEN(j)  (2304 + 64 * (j))
#define XB_TOP      3328
#define XB_TOPGEN   3392
#define XCD_BAR_WORDS 3456
#define XB_SPIN_CAP (1u << 18)

__device__ __forceinline__ unsigned xb_ld(unsigned* p)              { return __hip_atomic_load(p, __ATOMIC_RELAXED, __HIP_MEMORY_SCOPE_AGENT); }
__device__ __forceinline__ unsigned xb_add(unsigned* p, unsigned v) { return __hip_atomic_fetch_add(p, v, __ATOMIC_RELAXED, __HIP_MEMORY_SCOPE_AGENT); }
__device__ __forceinline__ unsigned xb_xcc_id() { return (unsigned)__builtin_amdgcn_s_getreg((3 << 11) | 20) & 0xFu; }
#define XB_SPIN(cond, bar) do { unsigned _sp = 0; while (cond) { __builtin_amdgcn_s_sleep(1); \
    if ((++_sp & 255u) == 0u) { if (xb_ld(&(bar)[XB_TMO])) break; if (_sp > XB_SPIN_CAP) { atomicAdd(&(bar)[XB_TMO], 1u); break; } } } } while (0)

struct XcdBarrier {
    unsigned* bar; unsigned x;
    volatile LAS unsigned* st;
};

__device__ __forceinline__ XcdBarrier xcd_barrier_post(unsigned* bar, volatile LAS unsigned* st) {
    XcdBarrier b; b.bar = bar; b.x = xb_xcc_id(); b.st = st;
    if (threadIdx.x == 0) (void)xb_add(&bar[XB_XCNT(b.x)], 1u);
    return b;
}
__device__ __forceinline__ void xcd_barrier_complete(unsigned* bar, unsigned x, unsigned& nloc, unsigned& nx) {
    const unsigned G = gridDim.x * gridDim.y * gridDim.z;
    unsigned sum, cnt, mine, sp = 0u;
    for (;;) {
        sum = 0u; cnt = 0u; mine = 0u;
#pragma unroll
        for (unsigned j = 0; j < 16; ++j) { const unsigned c = xb_ld(&bar[XB_XCNT(j)]); sum += c; cnt += (c > 0u) ? 1u : 0u; mine = (j == x) ? c : mine; }
        if (sum == G) break;
        __builtin_amdgcn_s_sleep(1);
        if ((++sp & 255u) == 0u) { if (xb_ld(&bar[XB_TMO])) break; if (sp > XB_SPIN_CAP) { atomicAdd(&bar[XB_TMO], 1u); break; } }
    }
    nloc = mine > 0u ? mine : 1u; nx = cnt > 0u ? cnt : 1u;
}

__device__ __forceinline__ void xcd_barrier(const XcdBarrier& b) {
    asm volatile("s_waitcnt vmcnt(0)" ::: "memory");
    __syncthreads();
    if (threadIdx.x == 0) {
        unsigned* bar = b.bar;
        __builtin_amdgcn_s_waitcnt(0);
        unsigned nloc = b.st[0], nx = b.st[1];
        if (nloc == 0u) { xcd_barrier_complete(bar, b.x, nloc, nx); b.st[0] = nloc; b.st[1] = nx; }
        const unsigned old = xb_add(&bar[XB_XSUB(b.x)], 1u);
        const unsigned gen = old / nloc;
        if (old + 1u == (gen + 1u) * nloc) {
            __builtin_amdgcn_fence(__ATOMIC_RELEASE, "agent");
            asm volatile("s_waitcnt vmcnt(0)" ::: "memory");
            const unsigned og = xb_add(&bar[XB_TOP], 1u);
            const unsigned tg = og / nx;
            if (og + 1u == (tg + 1u) * nx) xb_add(&bar[XB_TOPGEN], 1u);
            else XB_SPIN(xb_ld(&bar[XB_TOPGEN]) == tg, bar);
            __builtin_amdgcn_fence(__ATOMIC_ACQUIRE, "agent");
            xb_add(&bar[XB_XGEN(b.x)], 1u);
            asm volatile("s_waitcnt vmcnt(0)" ::: "memory");
        } else {
            XB_SPIN(xb_ld(&bar[XB_XGEN(b.x)]) == gen, bar);
            __builtin_amdgcn_fence(__ATOMIC_ACQUIRE, "agent");
            asm volatile("s_waitcnt vmcnt(0)" ::: "memory");
        }
    }
    __syncthreads();
}

constexpr int BATCH = 4, T = 8192, D = 1024, M = BATCH * T, FF = 2816, DPLE = 256, DIN = 4040;
constexpr int NWAVES = 8;
constexpr size_t MiB = 1u << 20;
constexpr size_t WS_CTL = 0, CTL_ZERO_BYTES = 1 * MiB;
constexpr size_t WS_RSQ1 = 1 * MiB, WS_RSQ2 = 3 * MiB, WS_RSQ3 = 5 * MiB, WS_RSQ4 = 7 * MiB, WS_IW = 9 * MiB;
constexpr size_t WS_W1 = 10 * MiB, WS_W2 = 21 * MiB, WS_WIN = 27 * MiB, WS_WA = 35 * MiB, WS_WB = 36 * MiB, WS_WO = 37 * MiB, WS_W3 = 39 * MiB, WS_W4 = 50 * MiB, WS_WG = 56 * MiB, WS_WP = 58 * MiB;
constexpr size_t WS_HB = 64 * MiB, WS_ACT = 128 * MiB, WS_TA = 336 * MiB  , WS_MIX = 368 * MiB  , WS_PP = 400 * MiB  ;
constexpr size_t WS_X8 = 304 * MiB, WS_SEL = WS_X8, WS_AQ = 336 * MiB, WS_BQ = 368 * MiB, WS_IQ = 400 * MiB, WS_AK = 432 * MiB, WS_AVT = 440 * MiB, WS_BK = 448 * MiB, WS_BV = 452 * MiB, WS_IK = 456 * MiB, WS_PB = 460 * MiB, WS_YA8 = 476 * MiB, WS_YB8 = 492 * MiB, WS_END = 508 * MiB;
constexpr int CW_BAR = 4096;
static_assert(pg8::PJ_AQ == WS_AQ && pg8::PJ_BQ == WS_BQ && pg8::PJ_IQ == WS_IQ && pg8::PJ_AK == WS_AK && pg8::PJ_AVT == WS_AVT && pg8::PJ_BK == WS_BK && pg8::PJ_BV == WS_BV && pg8::PJ_IK == WS_IK && pg8::PJ_IW == WS_IW, "EpiProj offsets");
constexpr int RING_OFF = 0, RING_BYTES = 131072;
constexpr int LDSCTL_OFF = 159744, MISC_OFF = LDSCTL_OFF + 320;
constexpr int LDS_BYTES = 160256;

#define LDS_WAIT() asm volatile("s_waitcnt lgkmcnt(0)" ::: "memory")
#define VM_WAIT() asm volatile("s_waitcnt vmcnt(0)" ::: "memory")
__device__ __forceinline__ unsigned f2bf(float f) { unsigned u = __builtin_bit_cast(unsigned, f); return (u + 0x7fffu + ((u >> 16) & 1u)) >> 16; }
__device__ __forceinline__ unsigned pk2(float lo, float hi) { return f2bf(lo) | (f2bf(hi) << 16); }
__device__ __forceinline__ float wave_sum(float v) {
    v += __builtin_bit_cast(float, __builtin_amdgcn_update_dpp(0, __builtin_bit_cast(int, v), 0xB1, 0xf, 0xf, true));
    v += __builtin_bit_cast(float, __builtin_amdgcn_update_dpp(0, __builtin_bit_cast(int, v), 0x4E, 0xf, 0xf, true));
    v += __builtin_bit_cast(float, __builtin_amdgcn_update_dpp(0, __builtin_bit_cast(int, v), 0x124, 0xf, 0xf, true));
    v += __builtin_bit_cast(float, __builtin_amdgcn_update_dpp(0, __builtin_bit_cast(int, v), 0x128, 0xf, 0xf, true));
    return pg8::xrow_sum(v);
}

struct MapId { __device__ __forceinline__ void operator()(int n, int& sc, float& cs) const { sc = n; cs = 1.f; } };
struct MapFfnIn { __device__ __forceinline__ void operator()(int n, int& sc, float& cs) const { const int pn = n >> 8, bj = (n >> 7) & 1, i = n & 127; sc = bj * FF + 128 * pn + i; cs = 1.f; } };
struct MapWin { __device__ __forceinline__ void operator()(int n, int& sc, float& cs) const {
    const float CQ = 0.125f * 1.4426950408889634f; cs = 1.f;
    if (n < 1280) { sc = n; if (n < 512 || n >= 768) cs = CQ; }
    else if (n < 1536) { const int i = n - 1280; if (i < 128) sc = 1280 + i; else if (i < 192) sc = 1920 + (i - 128); else if (i < 200) { sc = 1984 + (i - 192); cs = 0.35355339059327373f; } else sc = -1; }
    else if (n < 2048) { sc = 1408 + (n - 1536); cs = 0.125f; }
    else if (n < 3072) sc = 1992 + (n - 2048);
    else sc = 3016 + (n - 3072);
} };
struct MapGate { __device__ __forceinline__ void operator()(int n, int& sc, float& cs) const { sc = 1992 + n; cs = 1.f; } };
template <class MAP>
__device__ __forceinline__ void tr_item(const float* W, int Nsrc, int K, bf16* WT, const float* gain, LAS float* scr, int item, int nblk, int lane, MAP map) {
    const int kb = item / nblk, nb = item % nblk, k0 = 64 * kb, n0 = 32 * nb;
    int sc; float cs; map(n0 + (lane & 7) * 4, sc, cs);
    {
        f32x4 ld[8];
#pragma unroll
        for (int i = 0; i < 8; ++i) { const int kk = 8 * i + (lane >> 3); ld[i] = (f32x4){0.f, 0.f, 0.f, 0.f}; if (sc >= 0) ld[i] = *(const GAS f32x4*)(W + (size_t)(k0 + kk) * Nsrc + sc); }
#pragma unroll
        for (int i = 0; i < 8; ++i) { const int kk = 8 * i + (lane >> 3); float gk = cs; if (gain) gk *= gain[k0 + kk]; LAS float* d = scr + kk * 33 + (lane & 7) * 4; d[0] = ld[i][0] * gk; d[1] = ld[i][1] * gk; d[2] = ld[i][2] * gk; d[3] = ld[i][3] * gk; }
    }
    LDS_WAIT(); asm volatile("" ::: "memory");
    const int c = lane & 7;
#pragma unroll
    for (int j = 0; j < 4; ++j) { const int n = (lane >> 3) + 8 * j; const LAS float* s = scr + (8 * c) * 33 + n;
        v4u o; o.x = pk2(s[0 * 33], s[1 * 33]); o.y = pk2(s[2 * 33], s[3 * 33]); o.z = pk2(s[4 * 33], s[5 * 33]); o.w = pk2(s[6 * 33], s[7 * 33]);
        *(GAS v4u*)(WT + (size_t)(n0 + n) * K + k0 + 8 * c) = o; }
    LDS_WAIT(); asm volatile("" ::: "memory");
}

template <class MAP>
__device__ __forceinline__ void tr_item8(const float* W, int Nsrc, int K, unsigned char* WT, const float* gain, LAS float* scr, int item, int nblk, int lane, MAP map, float scale) {
    const int kb = item / nblk, nb = item % nblk, k0 = 64 * kb, n0 = 32 * nb;
    int sc; float cs; map(n0 + (lane & 7) * 4, sc, cs); cs *= scale;
    {
        f32x4 ld[8];
#pragma unroll
        for (int i = 0; i < 8; ++i) { const int kk = 8 * i + (lane >> 3); ld[i] = (f32x4){0.f, 0.f, 0.f, 0.f}; if (sc >= 0) ld[i] = *(const GAS f32x4*)(W + (size_t)(k0 + kk) * Nsrc + sc); }
#pragma unroll
        for (int i = 0; i < 8; ++i) { const int kk = 8 * i + (lane >> 3); float gk = cs; if (gain) gk *= gain[k0 + kk]; LAS float* d = scr + kk * 33 + (lane & 7) * 4; d[0] = ld[i][0] * gk; d[1] = ld[i][1] * gk; d[2] = ld[i][2] * gk; d[3] = ld[i][3] * gk; }
    }
    LDS_WAIT(); asm volatile("" ::: "memory");
    const int c = lane & 3;
#pragma unroll
    for (int j = 0; j < 2; ++j) { const int n = (lane >> 2) + 16 * j; const LAS float* s = scr + (16 * c) * 33 + n;
        v4u o; o.x = pg8::pack4_fp8(s[0 * 33], s[1 * 33], s[2 * 33], s[3 * 33]); o.y = pg8::pack4_fp8(s[4 * 33], s[5 * 33], s[6 * 33], s[7 * 33]);
        o.z = pg8::pack4_fp8(s[8 * 33], s[9 * 33], s[10 * 33], s[11 * 33]); o.w = pg8::pack4_fp8(s[12 * 33], s[13 * 33], s[14 * 33], s[15 * 33]);
        *(GAS v4u*)(WT + (size_t)(n0 + n) * K + k0 + 16 * c) = o; }
    LDS_WAIT(); asm volatile("" ::: "memory");
}

__device__ __forceinline__ void tr_generic(const float* W, int Nsrc, int K, unsigned char* dst, const float* gain, int mapid, int f8, LAS float* scr, int item, int nblk, int lane) {
    const int kb = item / nblk, nb = item % nblk, k0 = 64 * kb, n0 = 32 * nb;
    int sc; float cs; { const int n = n0 + (lane & 7) * 4;
        if (mapid == 0) MapId()(n, sc, cs); else if (mapid == 1) MapFfnIn()(n, sc, cs); else if (mapid == 2) MapWin()(n, sc, cs); else MapGate()(n, sc, cs); }
    if (f8) cs *= pg8::F8_WSCALE;
    {
        f32x4 ld[8];
#pragma unroll
        for (int i = 0; i < 8; ++i) { const int kk = 8 * i + (lane >> 3); ld[i] = (f32x4){0.f, 0.f, 0.f, 0.f}; if (sc >= 0) ld[i] = *(const GAS f32x4*)(W + (size_t)(k0 + kk) * Nsrc + sc); }
#pragma unroll
        for (int i = 0; i < 8; ++i) { const int kk = 8 * i + (lane >> 3); float gk = cs; if (gain) gk *= gain[k0 + kk]; LAS float* d = scr + kk * 33 + (lane & 7) * 4; d[0] = ld[i][0] * gk; d[1] = ld[i][1] * gk; d[2] = ld[i][2] * gk; d[3] = ld[i][3] * gk; }
    }
    LDS_WAIT(); asm volatile("" ::: "memory");
    if (f8) {
        const int c = lane & 3;
#pragma unroll
        for (int j = 0; j < 2; ++j) { const int n = (lane >> 2) + 16 * j; const LAS float* s = scr + (16 * c) * 33 + n;
            v4u o; o.x = pg8::pack4_fp8(s[0 * 33], s[1 * 33], s[2 * 33], s[3 * 33]); o.y = pg8::pack4_fp8(s[4 * 33], s[5 * 33], s[6 * 33], s[7 * 33]);
            o.z = pg8::pack4_fp8(s[8 * 33], s[9 * 33], s[10 * 33], s[11 * 33]); o.w = pg8::pack4_fp8(s[12 * 33], s[13 * 33], s[14 * 33], s[15 * 33]);
            *(GAS v4u*)(dst + (size_t)(n0 + n) * K + k0 + 16 * c) = o; }
    } else {
        const int c = lane & 7;
#pragma unroll
        for (int j = 0; j < 4; ++j) { const int n = (lane >> 3) + 8 * j; const LAS float* s = scr + (8 * c) * 33 + n;
            v4u o; o.x = pk2(s[0 * 33], s[1 * 33]); o.y = pk2(s[2 * 33], s[3 * 33]); o.z = pk2(s[4 * 33], s[5 * 33]); o.w = pk2(s[6 * 33], s[7 * 33]);
            *(GAS v4u*)(dst + ((size_t)(n0 + n) * K + k0 + 8 * c) * 2) = o; }
    }
    LDS_WAIT(); asm volatile("" ::: "memory");
}

#ifndef PH_MASK
#define PH_MASK 0x7ff
#endif
template <class T_> __device__ __forceinline__ T_* as_global(T_* p) { return (T_*)(GAS T_*)p; }


namespace att {
typedef int v2i __attribute__((ext_vector_type(2)));
typedef float f32x16 __attribute__((ext_vector_type(16)));
typedef short s16x4 __attribute__((ext_vector_type(4)));
typedef unsigned long long u64;
constexpr float LOG2E = 1.4426950408889634f;
__device__ __forceinline__ int crow(int r, int hi) { return (r & 3) + 8 * (r >> 2) + 4 * hi; }
typedef unsigned u32x2_ __attribute__((ext_vector_type(2)));
__device__ __forceinline__ float xmax16(float v) { const u32x2_ r = __builtin_amdgcn_permlane16_swap(__float_as_uint(v), __float_as_uint(v), false, false); return fmaxf(__uint_as_float(r[0]), __uint_as_float(r[1])); }
__device__ __forceinline__ float xmax32(float v) { const u32x2_ r = __builtin_amdgcn_permlane32_swap(__float_as_uint(v), __float_as_uint(v), false, false); return fmaxf(__uint_as_float(r[0]), __uint_as_float(r[1])); }
__device__ __forceinline__ float xsum16(float v) { const u32x2_ r = __builtin_amdgcn_permlane16_swap(__float_as_uint(v), __float_as_uint(v), false, false); return __uint_as_float(r[0]) + __uint_as_float(r[1]); }
__device__ __forceinline__ float xsum32(float v) { const u32x2_ r = __builtin_amdgcn_permlane32_swap(__float_as_uint(v), __float_as_uint(v), false, false); return __uint_as_float(r[0]) + __uint_as_float(r[1]); }
__device__ __forceinline__ unsigned cvtpk(float lo, float hi) { unsigned r; asm volatile("v_cvt_pk_bf16_f32 %0, %1, %2" : "=v"(r) : "v"(lo), "v"(hi)); return r; }

constexpr int SWA_K = 0, SWA_V = 32768, SWA_VROW = 520;
__device__ __forceinline__ void swa_unit(int b, int n, int g, unsigned char* wsb, const float* sink, LAS unsigned char* L, int wid, int lane, int tid, size_t dst_off) {
    { GAS unsigned char* wg_ = (GAS unsigned char*)wsb; asm volatile("" : "+s"(wg_)); wsb = (unsigned char*)wg_; } const bf16* AQ = (const bf16*)(wsb + WS_AQ); const bf16* AK = (const bf16*)(wsb + WS_AK); const bf16* AVT = (const bf16*)(wsb + WS_AVT);
    const int hh = wid >> 1, qh = wid & 1, head = 4 * g + hh, r32 = lane & 31, hi = lane >> 5;
    const float slope2 = __builtin_amdgcn_exp2f(-0.5f * (float)(head + 1)) * LOG2E, sink2 = sink[head] * LOG2E;
    const size_t rowb = (size_t)b * T;
    const int kt0 = 128 * n - 128;
#pragma unroll
    for (int i = 0; i < 4; ++i) {
        const int row = (tid >> 3) + 64 * i, ch = tid & 7; int key = kt0 + row; if (key < 0) key = 0;
        const v4u v = *(const v4u*)(AK + (rowb + key) * 128 + g * 64 + ch * 8);
        *(LAS v4u*)(L + SWA_K + row * 128 + ((ch ^ ((row >> 1) & 7)) << 4)) = v;
    }
#pragma unroll
    for (int i = 0; i < 4; ++i) {
        const int d = (tid >> 5) + 16 * i, ch = tid & 31; int key0 = kt0 + 8 * ch; if (key0 < 0) key0 = 0;
        const v4u v = *(const v4u*)(AVT + ((size_t)((b * 2 + g) * 64 + d)) * T + key0);
        LAS u64* dp = (LAS u64*)(L + SWA_V + d * SWA_VROW + ch * 16);
        dp[0] = (u64)v.x | ((u64)v.y << 32); dp[1] = (u64)v.z | ((u64)v.w << 32);
    }
    __syncthreads();
    for (int qs = 0; qs < 2; ++qs) {
        const int qq0 = 128 * n + 64 * qh + 32 * qs, kbase = qq0 - 128, lrow0 = 64 * qh + 32 * qs;
        const bf16* qp = AQ + (rowb + qq0 + r32) * 512 + head * 64;
        bf16x8 qf[4];
#pragma unroll
        for (int ks = 0; ks < 4; ++ks) qf[ks] = *(const bf16x8*)(qp + 8 * hi + 16 * ks);
        float mrun = sink2, lrun = 1.0f;
        f32x16 O0 = {}, O1 = {};
#pragma unroll
        for (int kb = 0; kb < 5; ++kb) {
            if ((kbase + 32 * kb) < 0) continue;
            const int row = lrow0 + 32 * kb + r32, sw = (row >> 1) & 7;
            f32x16 acc = {};
            __builtin_amdgcn_s_setprio(1);
#pragma unroll
            for (int ks = 0; ks < 4; ++ks) acc = __builtin_amdgcn_mfma_f32_32x32x16_bf16(*(const LAS bf16x8*)(L + SWA_K + row * 128 + (((2 * ks + hi) ^ sw) << 4)), qf[ks], acc, 0, 0, 0);
            __builtin_amdgcn_s_setprio(0);
            int dist0 = r32 + 128 - 32 * kb - 4 * hi; asm volatile("" : "+v"(dist0));
            const float b0 = slope2 * (float)dist0;
            float bm = -__builtin_inff();
#pragma unroll
            for (int r = 0; r < 16; ++r) {
                const int c = (r & 3) + 8 * (r >> 2);
                float l = __builtin_fmaf(slope2, (float)c, acc[r]);
                if (kb == 0) l = (dist0 < 128 + c) ? l : -__builtin_inff();
                if (kb == 4) l = (dist0 >= c) ? l : -__builtin_inff();
                acc[r] = l; bm = fmaxf(bm, l);
            }
            bm = xmax32(bm - b0);
            if (__ballot(bm > mrun + 8.0f) != 0ull) {
                const float mnew = fmaxf(mrun, bm), alpha = __builtin_amdgcn_exp2f(mrun - mnew);
                lrun *= alpha; mrun = mnew;
#pragma unroll
                for (int r = 0; r < 16; ++r) { O0[r] *= alpha; O1[r] *= alpha; }
            }
            const float ref = b0 + mrun;
            float bs = 0.f;
#pragma unroll
            for (int r = 0; r < 16; ++r) { const float e = __builtin_amdgcn_exp2f(acc[r] - ref); acc[r] = e; bs += e; }
            bs = xsum32(bs);
            lrun += bs;
            __builtin_amdgcn_s_setprio(1);
#pragma unroll
            for (int s2 = 0; s2 < 2; ++s2) {
                v4u pw; pw.x = cvtpk(acc[8 * s2 + 0], acc[8 * s2 + 1]); pw.y = cvtpk(acc[8 * s2 + 2], acc[8 * s2 + 3]);
                pw.z = cvtpk(acc[8 * s2 + 4], acc[8 * s2 + 5]); pw.w = cvtpk(acc[8 * s2 + 6], acc[8 * s2 + 7]);
                const bf16x8 pf = __builtin_bit_cast(bf16x8, pw);
                const int tb = lrow0 + 32 * kb + 16 * s2 + 4 * hi;
                const LAS unsigned char* vp = L + SWA_V + r32 * SWA_VROW + 2 * tb;
                typedef u64 u64x2 __attribute__((ext_vector_type(2)));
                u64x2 v0, v1; v0.x = *(const LAS u64*)vp; v0.y = *(const LAS u64*)(vp + 16); v1.x = *(const LAS u64*)(vp + 32 * SWA_VROW); v1.y = *(const LAS u64*)(vp + 32 * SWA_VROW + 16);
                O0 = __builtin_amdgcn_mfma_f32_32x32x16_bf16(__builtin_bit_cast(bf16x8, v0), pf, O0, 0, 0, 0);
                O1 = __builtin_amdgcn_mfma_f32_32x32x16_bf16(__builtin_bit_cast(bf16x8, v1), pf, O1, 0, 0, 0);
            }
            __builtin_amdgcn_s_setprio(0);
        }
        { const float inv = 1.0f / lrun;
#pragma unroll
          for (int r = 0; r < 16; ++r) { O0[r] *= inv; O1[r] *= inv; } }
#pragma unroll
        for (int rg = 0; rg < 4; ++rg) {
            const int d = 8 * rg + 4 * hi;
            const unsigned w0 = pg8::pack4_fp8(O0[4 * rg], O0[4 * rg + 1], O0[4 * rg + 2], O0[4 * rg + 3]);
            const unsigned w1 = pg8::pack4_fp8(O1[4 * rg], O1[4 * rg + 1], O1[4 * rg + 2], O1[4 * rg + 3]);
            unsigned char* op = (unsigned char*)(wsb + dst_off) + (rowb + qq0 + r32) * 512 + head * 64; *(unsigned*)(op + d) = w0; *(unsigned*)(op + 32 + d) = w1;
        }
    }
    __syncthreads();
}

constexpr int CB = 448;
constexpr int L_KT = 0, L_BUF = 32768, L_HIST = 32768, L_QINFO = L_BUF + 64 * CB * 4, L_WSCR = L_QINFO + 2048, L_END = L_WSCR + 8 * 1024, L_VBUF = 0;
__device__ __forceinline__ float relu_i(float x) { const int b = __builtin_bit_cast(int, x); return __builtin_bit_cast(float, b > 0 ? b : 0); }
template <int PASS, bool DIAG>
__device__ __forceinline__ void idx_post(const f32x16& acc, int rb, int kb, int s, int t0, LAS unsigned char* L, const float (&wq)[2][2][8], const int (&qa)[2][2], const int (&qb)[2][2], int (&eqseen)[2][2], int (&cnt)[2][2], unsigned (&cw)[2][2][2], int wid, int r32, int hi) {
    LAS unsigned* hist = (LAS unsigned*)(L + L_HIST);
    LAS unsigned* buf = (LAS unsigned*)(L + L_BUF);
#pragma unroll
    for (int g2 = 0; g2 < 2; ++g2) {
        float sc = relu_i(acc[8 * g2]) * wq[rb][g2][0];
#pragma unroll
        for (int hd = 1; hd < 8; ++hd) sc = fmaf(relu_i(acc[8 * g2 + hd]), wq[rb][g2][hd], sc);
        const int ql = 8 * wid + 4 * rb + 2 * g2 + hi, tq = t0 + ql;
        const bool valid = DIAG ? (s <= tq) : true;
        const _Float16 hf = (_Float16)sc; const int hb = (int)__builtin_bit_cast(short, hf);
        const unsigned u = (unsigned)(hb ^ ((hb >> 16) | 0x8000));
        if (PASS == 1 || PASS == 4) { if (PASS == 1) __hip_atomic_fetch_add(hist + ql * 256 + (u >> 8), valid ? (1u << ((u >> 3) & 16u)) : 0u, __ATOMIC_RELAXED, __HIP_MEMORY_SCOPE_WORKGROUP);
            if (kb & 1) cw[rb][g2][kb >> 1] |= (valid ? u : 0u) << 16; else cw[rb][g2][kb >> 1] = valid ? u : 0u; }
        else if (PASS == 2) { const bool c = valid && (int)(u >> 7) == qa[rb][g2]; if (__ballot(c) != 0ull) __hip_atomic_fetch_add(hist + ql * 256 + (u & 127u), c ? 1u : 0u, __ATOMIC_RELAXED, __HIP_MEMORY_SCOPE_WORKGROUP); }
        else {
            const bool gt = valid && ((int)u > qa[rb][g2]), eq = valid && ((int)u == qa[rb][g2]);
            const unsigned ltm = (1u << r32) - 1u;
            const u64 em = __ballot(eq);
            const unsigned mh = hi ? (unsigned)(em >> 32) : (unsigned)em;
            const bool keep = gt || (eq && (eqseen[rb][g2] + __popc(mh & ltm)) < qb[rb][g2]);
            eqseen[rb][g2] += __popc(mh);
            const u64 km = __ballot(keep);
            const unsigned kh = hi ? (unsigned)(km >> 32) : (unsigned)km;
            const int pos = cnt[rb][g2] + __popc(kh & ltm);
            if (keep && pos < CB) buf[ql * CB + pos] = (u << 16) | (unsigned)s;
            cnt[rb][g2] += __popc(kh);
        }
    }
}
template <int PASS, bool DIAG>
__device__ __forceinline__ void idx_tile(int t0, int kt, const LAS unsigned char* kbuf, LAS unsigned char* L, const bf16x8 (&af)[2][4], const float (&wq)[2][2][8], const int (&qa)[2][2], const int (&qb)[2][2], int (&eqseen)[2][2], int (&cnt)[2][2], unsigned short* codes, int cstride, int wid, int r32, int hi) {
    unsigned cw[2][2][2];
#pragma unroll
    for (int rb = 0; rb < 2; ++rb)
#pragma unroll
        for (int g2 = 0; g2 < 2; ++g2) { cw[rb][g2][0] = 0u; cw[rb][g2][1] = 0u; }
#pragma unroll
    for (int kb = 0; kb < 4; ++kb) {
        bf16x8 bfr[4];
        __builtin_amdgcn_s_setprio(1);
        const int lrow = 32 * kb + r32;
#pragma unroll
        for (int ks = 0; ks < 4; ++ks) bfr[ks] = *(const LAS bf16x8*)(kbuf + lrow * 128 + (((2 * ks + hi) ^ ((lrow >> 1) & 7)) << 4));
        const int s = 128 * kt + 4 * r32 + kb;
        f32x16 acc0 = {}, acc1 = {};
#pragma unroll
        for (int ks = 0; ks < 4; ++ks) acc0 = __builtin_amdgcn_mfma_f32_32x32x16_bf16(af[0][ks], bfr[ks], acc0, 0, 0, 0);
#pragma unroll
        for (int ks = 0; ks < 4; ++ks) acc1 = __builtin_amdgcn_mfma_f32_32x32x16_bf16(af[1][ks], bfr[ks], acc1, 0, 0, 0);
        __builtin_amdgcn_s_setprio(0);
        idx_post<PASS, DIAG>(acc0, 0, kb, s, t0, L, wq, qa, qb, eqseen, cnt, cw, wid, r32, hi);
        idx_post<PASS, DIAG>(acc1, 1, kb, s, t0, L, wq, qa, qb, eqseen, cnt, cw, wid, r32, hi);
    }
    if (PASS == 1 || PASS == 4) {
#pragma unroll
        for (int rb = 0; rb < 2; ++rb)
#pragma unroll
            for (int g2 = 0; g2 < 2; ++g2) { const int ql = 8 * wid + 4 * rb + 2 * g2 + hi;
                *(u64*)(codes + (size_t)ql * cstride + 128 * kt + 4 * r32) = (u64)cw[rb][g2][0] | ((u64)cw[rb][g2][1] << 32); }
    }
}
template <int PASS>
__device__ __forceinline__ void idx_pass(int b, int t0, int kt0, int nt, unsigned char* wsb, unsigned short* codes, int cstride, LAS unsigned char* L, const bf16x8 (&af)[2][4], const float (&wq)[2][2][8], int wid, int lane, int tid) {
    { GAS unsigned char* wg_ = (GAS unsigned char*)wsb; asm volatile("" : "+s"(wg_)); wsb = (unsigned char*)wg_; } const bf16* IK = (const bf16*)(wsb + WS_IK);
    const int r32 = lane & 31, hi = lane >> 5;
    LAS int* qinfo = (LAS int*)(L + L_QINFO);
    int qa[2][2], qb[2][2], eqseen[2][2], cnt[2][2];
#pragma unroll
    for (int rb = 0; rb < 2; ++rb)
#pragma unroll
        for (int g2 = 0; g2 < 2; ++g2) { const int ql = 8 * wid + 4 * rb + 2 * g2 + hi; eqseen[rb][g2] = 0; cnt[rb][g2] = 0;
            if (PASS == 2) { qa[rb][g2] = qinfo[ql]; qb[rb][g2] = 0; } else if (PASS == 3) { qa[rb][g2] = qinfo[128 + ql]; qb[rb][g2] = qinfo[192 + ql]; cnt[rb][g2] = qinfo[256 + ql]; eqseen[rb][g2] = qinfo[384 + ql]; } else { qa[rb][g2] = 0; qb[rb][g2] = 0; } }
    const int skey = tid >> 2, sc0 = (tid & 3) * 2;
    const bf16* src = IK + ((size_t)b * T + skey) * 64 + sc0 * 8;
    const int srow = (skey & 3) * 32 + (skey >> 2);
    const int sd0 = srow * 128 + ((sc0 ^ ((srow >> 1) & 7)) << 4), sd1 = srow * 128 + (((sc0 + 1) ^ ((srow >> 1) & 7)) << 4);
    v4u A0, A1, B0, B1;
#define IDX_LOAD(R0, R1, tile) do { const bf16* s_ = src + (size_t)(tile) * (128 * 64); R0 = *(const v4u*)s_; R1 = *(const v4u*)(s_ + 8); } while (0)
#define IDX_WRITE(R0, R1, buf) do { *(LAS v4u*)(L + L_KT + (buf) * 16384 + sd0) = R0; *(LAS v4u*)(L + L_KT + (buf) * 16384 + sd1) = R1; } while (0)
    IDX_LOAD(A0, A1, kt0); IDX_LOAD(B0, B1, (kt0 + 1 < nt ? kt0 + 1 : kt0));
    IDX_WRITE(A0, A1, 0);
    __syncthreads();
    for (int kt = kt0; kt < nt; kt += 2) {
        { const int tn = (kt + 2 < nt) ? kt + 2 : nt - 1; IDX_LOAD(A0, A1, tn); }
        if (kt + 1 < nt) idx_tile<PASS, false>(t0, kt, L + L_KT, L, af, wq, qa, qb, eqseen, cnt, codes, cstride, wid, r32, hi);
        else idx_tile<PASS, true>(t0, kt, L + L_KT, L, af, wq, qa, qb, eqseen, cnt, codes, cstride, wid, r32, hi);
        IDX_WRITE(B0, B1, 1);
        __syncthreads();
        if (kt + 1 >= nt) break;
        { const int tn = (kt + 3 < nt) ? kt + 3 : nt - 1; IDX_LOAD(B0, B1, tn); }
        if (kt + 2 < nt) idx_tile<PASS, false>(t0, kt + 1, L + L_KT + 16384, L, af, wq, qa, qb, eqseen, cnt, codes, cstride, wid, r32, hi);
        else idx_tile<PASS, true>(t0, kt + 1, L + L_KT + 16384, L, af, wq, qa, qb, eqseen, cnt, codes, cstride, wid, r32, hi);
        IDX_WRITE(A0, A1, 0);
        __syncthreads();
    }
#undef IDX_LOAD
#undef IDX_WRITE
    if (PASS == 3) {
#pragma unroll
        for (int rb = 0; rb < 2; ++rb)
#pragma unroll
            for (int g2 = 0; g2 < 2; ++g2) if (r32 == 0) qinfo[256 + 8 * wid + 4 * rb + 2 * g2 + hi] = cnt[rb][g2];
    }
}
template <bool NB16>
__device__ __forceinline__ void find_bin(const LAS unsigned* hq, int K, int lane, int& bin, int& above, int& incnt) {
    const int L = 63 - lane;
    const v4u w = *(const LAS v4u*)(hq + 4 * L);
    int c[8];
    if (NB16) { c[0] = w.x & 0xffffu; c[1] = w.x >> 16; c[2] = w.y & 0xffffu; c[3] = w.y >> 16; c[4] = w.z & 0xffffu; c[5] = w.z >> 16; c[6] = w.w & 0xffffu; c[7] = w.w >> 16; }
    else { c[0] = (int)w.x; c[1] = (int)w.y; c[2] = (int)w.z; c[3] = (int)w.w; c[4] = 0; c[5] = 0; c[6] = 0; c[7] = 0; }
    constexpr int NC = NB16 ? 8 : 4;
    int tot = 0;
#pragma unroll
    for (int i = 0; i < NC; ++i) tot += c[i];
    int S = tot;
    S += __builtin_amdgcn_update_dpp(0, S, 0x111, 0xf, 0xf, false);
    S += __builtin_amdgcn_update_dpp(0, S, 0x112, 0xf, 0xf, false);
    S += __builtin_amdgcn_update_dpp(0, S, 0x114, 0xf, 0xf, false);
    S += __builtin_amdgcn_update_dpp(0, S, 0x118, 0xf, 0xf, false);
    S += __builtin_amdgcn_update_dpp(0, S, 0x142, 0xa, 0xf, false);
    S += __builtin_amdgcn_update_dpp(0, S, 0x143, 0xc, 0xf, false);
    const int ab = S - tot;
    const bool here = (S >= K) && (ab < K);
    const u64 bm = __ballot(here);
    int mybin = NC * L, myab = ab, myc = c[0]; bool found = false;
#pragma unroll
    for (int i = NC - 1; i >= 0; --i) { if (!found) { if (myab + c[i] >= K || i == 0) { mybin = NC * L + i; myc = c[i]; found = true; } else myab += c[i]; } }
    const int Ls = (bm == 0ull) ? 0 : (__ffsll((long long)bm) - 1);
    bin = __builtin_amdgcn_readlane(mybin, Ls); above = __builtin_amdgcn_readlane(myab, Ls); incnt = __builtin_amdgcn_readlane(myc, Ls);
}
__device__ __forceinline__ int prune256(LAS unsigned* buf, int n, LAS unsigned* wh, int lane) {
    const unsigned ltm_lo = (lane < 32) ? ((1u << lane) - 1u) : 0xffffffffu, ltm_hi = (lane < 32) ? 0u : ((1u << (lane - 32)) - 1u);
#pragma unroll
    for (int i = 0; i < 4; ++i) wh[i * 64 + lane] = 0u;
    LDS_WAIT();
    for (int i = lane; i < n; i += 64) __hip_atomic_fetch_add(wh + (buf[i] >> 24), 1u, __ATOMIC_RELAXED, __HIP_MEMORY_SCOPE_WORKGROUP);
    LDS_WAIT();
    int b1, ab1, c1; find_bin<false>(wh, 256, lane, b1, ab1, c1);
#pragma unroll
    for (int i = 0; i < 4; ++i) wh[i * 64 + lane] = 0u;
    LDS_WAIT();
    for (int i = lane; i < n; i += 64) { const unsigned e = buf[i]; if ((int)(e >> 24) == b1) __hip_atomic_fetch_add(wh + ((e >> 16) & 255u), 1u, __ATOMIC_RELAXED, __HIP_MEMORY_SCOPE_WORKGROUP); }
    LDS_WAIT();
    int b2, ab2, c2; find_bin<false>(wh, 256 - ab1, lane, b2, ab2, c2);
    const int Tc = (b1 << 8) | b2, need = 256 - ab1 - ab2;
    int eqseen = 0, outc = 0;
    for (int c0 = 0; c0 < n; c0 += 64) {
        const int i = c0 + lane; const unsigned e = (i < n) ? buf[i] : 0u; const int code = (int)(e >> 16);
        const bool gt = (i < n) && code > Tc, eq = (i < n) && code == Tc;
        const u64 em = __ballot(eq);
        const int rank = eqseen + __popc((unsigned)em & ltm_lo) + __popc((unsigned)(em >> 32) & ltm_hi);
        const bool keep = gt || (eq && rank < need);
        eqseen += __popcll(em);
        const u64 km = __ballot(keep);
        const int pos = outc + __popc((unsigned)km & ltm_lo) + __popc((unsigned)(km >> 32) & ltm_hi);
        LDS_WAIT();
        if (keep) buf[pos] = e;
        outc += __popcll(km);
    }
    LDS_WAIT();
    return Tc;
}

__device__ __forceinline__ void prune256_known(LAS unsigned* buf, int n, LAS unsigned* wh, int lane, int bin, int above, int tq) {
    unsigned e[7];
#pragma unroll
    for (int k = 0; k < 7; ++k) e[k] = buf[64 * k + lane];
#pragma unroll
    for (int i = 0; i < 4; ++i) wh[i * 64 + lane] = 0u;
#pragma unroll
    for (int k = 0; k < 7; ++k) { if (64 * k + lane < n && (int)(e[k] >> 23) == bin) __hip_atomic_fetch_add(wh + ((e[k] >> 16) & 127u), 1u, __ATOMIC_RELAXED, __HIP_MEMORY_SCOPE_WORKGROUP); }
    int b2, ab2, c2; find_bin<false>(wh, 256 - above, lane, b2, ab2, c2);
    const int Tc = (bin << 7) | b2, need = 256 - above - ab2;
    int eqseen = 0, outc = 0;
#pragma unroll
    for (int k = 0; k < 7; ++k) {
        const bool in = 64 * k + lane < n; const int code = (int)(e[k] >> 16);
        const bool gt = in && code > Tc, eq = in && code == Tc;
        const u64 em = __ballot(eq);
        const int rank = (int)__builtin_amdgcn_mbcnt_hi((unsigned)(em >> 32), __builtin_amdgcn_mbcnt_lo((unsigned)em, (unsigned)eqseen));
        const bool keep = gt || (eq && rank < need);
        eqseen += __popcll(em);
        const u64 km = __ballot(keep);
        const int pos = (int)__builtin_amdgcn_mbcnt_hi((unsigned)(km >> 32), __builtin_amdgcn_mbcnt_lo((unsigned)km, (unsigned)outc));
        unsigned w = e[k];
        if (tq >= 0) { const unsigned key = w & 0xffffu; const _Float16 hd = (_Float16)(float)(tq - (int)key); w = ((unsigned)__builtin_bit_cast(unsigned short, hd) << 16) | key; }
        if (keep) buf[pos] = w;
        outc += __popcll(km);
    }
    LDS_WAIT();
}
__device__ __forceinline__ unsigned scan_hits(const v4u cur, int T) {
    const unsigned c0 = cur.x & 0xffffu, c1 = cur.x >> 16, c2 = cur.y & 0xffffu, c3 = cur.y >> 16, c4 = cur.z & 0xffffu, c5 = cur.z >> 16, c6 = cur.w & 0xffffu, c7 = cur.w >> 16;
    return ((int)c0 > T ? 1u : 0u) | ((int)c1 > T ? 2u : 0u) | ((int)c2 > T ? 4u : 0u) | ((int)c3 > T ? 8u : 0u) | ((int)c4 > T ? 16u : 0u) | ((int)c5 > T ? 32u : 0u) | ((int)c6 > T ? 64u : 0u) | ((int)c7 > T ? 128u : 0u);
}
template <bool GUARD>
__device__ __forceinline__ void scan_emit(const v4u cur, int kk, int T, LAS unsigned* buf, int& cnt, u64 m0, u64 m1, u64 m2, u64 m3, u64 m4, u64 m5, u64 m6, u64 m7, int tot) {
    unsigned base = (unsigned)cnt;
#define SC_PUT(M, W, HI, J) { const unsigned code = (HI) ? ((W) >> 16) : ((W) & 0xffffu); const unsigned p = __builtin_amdgcn_mbcnt_hi((unsigned)((M) >> 32), __builtin_amdgcn_mbcnt_lo((unsigned)(M), base)); \
        if ((int)code > T && (!GUARD || p < (unsigned)CB)) buf[p] = ((HI) ? ((W) & 0xffff0000u) : ((W) << 16)) | (unsigned)(kk + (J)); base += (unsigned)__popcll(M); }
    SC_PUT(m0, cur.x, 0, 0) SC_PUT(m1, cur.x, 1, 1) SC_PUT(m2, cur.y, 0, 2) SC_PUT(m3, cur.y, 1, 3) SC_PUT(m4, cur.z, 0, 4) SC_PUT(m5, cur.z, 1, 5) SC_PUT(m6, cur.w, 0, 6) SC_PUT(m7, cur.w, 1, 7)
#undef SC_PUT
    cnt += tot;
}
#define SCAN_MASKS(P, T_) const u64 P##0 = __ballot((int)(cur.x & 0xffffu) > (T_)), P##1 = __ballot((int)(cur.x >> 16) > (T_)), P##2 = __ballot((int)(cur.y & 0xffffu) > (T_)), P##3 = __ballot((int)(cur.y >> 16) > (T_)), \
                                  P##4 = __ballot((int)(cur.z & 0xffffu) > (T_)), P##5 = __ballot((int)(cur.z >> 16) > (T_)), P##6 = __ballot((int)(cur.w & 0xffffu) > (T_)), P##7 = __ballot((int)(cur.w >> 16) > (T_)); \
                        const int P##t = __popcll(P##0) + __popcll(P##1) + __popcll(P##2) + __popcll(P##3) + __popcll(P##4) + __popcll(P##5) + __popcll(P##6) + __popcll(P##7)
__device__ __forceinline__ void scan_block(const v4u cur, int kk, int& T, LAS unsigned* buf, int& cnt, LAS unsigned* wh, int lane, u64 ltm) {
    (void)ltm;
    SCAN_MASKS(m, T);
    if (cnt + mt > CB && cnt > 256) {
        LDS_WAIT();
        T = prune256(buf, cnt, wh, lane); cnt = 256;
        const int T2 = T;
        SCAN_MASKS(n, T2);
        if (cnt + nt <= CB) scan_emit<false>(cur, kk, T2, buf, cnt, n0, n1, n2, n3, n4, n5, n6, n7, nt); else scan_emit<true>(cur, kk, T2, buf, cnt, n0, n1, n2, n3, n4, n5, n6, n7, nt);
    } else if (cnt + mt <= CB) scan_emit<false>(cur, kk, T, buf, cnt, m0, m1, m2, m3, m4, m5, m6, m7, mt); else scan_emit<true>(cur, kk, T, buf, cnt, m0, m1, m2, m3, m4, m5, m6, m7, mt);
}
__device__ __forceinline__ void scan_codes(const unsigned short* crow, const unsigned short* zrow, int nkeys, int& T, LAS unsigned* buf, int& cnt_io, LAS unsigned* wh, int lane) {
    int cnt = cnt_io;
    const u64 ltm = (lane == 0) ? 0ull : (~0ull >> (64 - lane));
    v4u w0, w1, w2, w3;
#define SC_LOAD(R, kq) do { const int kq_ = (kq) + 8 * lane; R = *(const v4u*)((kq_ < nkeys) ? (crow + kq_) : (zrow + 8 * lane)); } while (0)
    SC_LOAD(w0, 0); SC_LOAD(w1, 512); SC_LOAD(w2, 1024); SC_LOAD(w3, 1536);
    for (int k0 = 0; k0 < nkeys; k0 += 2048) {
        { const v4u cur = w0; SC_LOAD(w0, k0 + 2048); scan_block(cur, k0 + 8 * lane, T, buf, cnt, wh, lane, ltm); }
        if (k0 + 512 >= nkeys) break;
        { const v4u cur = w1; SC_LOAD(w1, k0 + 2560); scan_block(cur, k0 + 512 + 8 * lane, T, buf, cnt, wh, lane, ltm); }
        if (k0 + 1024 >= nkeys) break;
        { const v4u cur = w2; SC_LOAD(w2, k0 + 3072); scan_block(cur, k0 + 1024 + 8 * lane, T, buf, cnt, wh, lane, ltm); }
        if (k0 + 1536 >= nkeys) break;
        { const v4u cur = w3; SC_LOAD(w3, k0 + 3584); scan_block(cur, k0 + 1536 + 8 * lane, T, buf, cnt, wh, lane, ltm); }
    }
#undef SC_LOAD
    cnt_io = cnt;
}

__device__ __forceinline__ void sparse_query(int b, int t, const LAS unsigned* idx, unsigned char* wsb, LAS unsigned char* L, int wid, int lane, size_t dst_off) {
    { GAS unsigned char* wg_ = (GAS unsigned char*)wsb; asm volatile("" : "+s"(wg_)); wsb = (unsigned char*)wg_; } bf16* BQ = (bf16*)(wsb + WS_BQ); const bf16* BK = (const bf16*)(wsb + WS_BK); const bf16* BV = (const bf16*)(wsb + WS_BV);
    const int fr = lane & 15, fq = lane >> 4;
    LAS unsigned char* vbuf = L + L_VBUF + wid * 4096;
    const size_t rowb = (size_t)b * T;
    const unsigned char* qrow = (const unsigned char*)BQ + (rowb + t) * 512;
    long q0 = 0, q1 = 0;
    if (fr < 8) { q0 = *(const long*)(qrow + fr * 64 + 8 * fq); q1 = *(const long*)(qrow + fr * 64 + 32 + 8 * fq); }
    f32x4 S[16];
    unsigned koff[4][4];
    v4u vreg[4][4];
    __builtin_amdgcn_s_setprio(1);
    {
        const unsigned char* BK8 = (const unsigned char*)BK;
        v4u kreg[4][4];
#pragma unroll
        for (int c4 = 0; c4 < 4; ++c4) {
            const v4u iv = *(const LAS v4u*)(idx + 64 * c4 + 4 * (lane >> 2));
#pragma unroll
            for (int i = 0; i < 4; ++i) {
                unsigned ki = (i == 0 ? iv.x : i == 1 ? iv.y : i == 2 ? iv.z : iv.w) & 0xffffu;
                koff[c4][i] = (unsigned)(rowb + ki) * 64u + (unsigned)(lane & 3) * 16u;
                kreg[c4][i] = *(const v4u*)(BK8 + koff[c4][i]);
            }
        }
        { const unsigned char* BV8 = (const unsigned char*)BV;
#pragma unroll
          for (int c4 = 0; c4 < 4; ++c4)
#pragma unroll
            for (int i = 0; i < 4; ++i) vreg[c4][i] = *(const v4u*)(BV8 + koff[c4][i]); }
#pragma unroll
        for (int c4 = 0; c4 < 4; ++c4) {
#pragma unroll
            for (int i = 0; i < 4; ++i) {
                const int row = 4 * (lane >> 2) + i, ch = lane & 3;
                *(LAS v4u*)(vbuf + row * 64 + ((ch ^ ((row >> 2) & 3)) << 4)) = kreg[c4][i];
            }
#pragma unroll
            for (int kbl = 0; kbl < 4; ++kbl) {
                const int row = 16 * kbl + fr, sw = ((row >> 2) & 3) << 1;
                const long a0 = *(const LAS long*)(vbuf + row * 64 + ((fq ^ sw) << 3)), a1 = *(const LAS long*)(vbuf + row * 64 + (((fq + 4) ^ sw) << 3));
                f32x4 acc = {0.f, 0.f, 0.f, 0.f};
                acc = __builtin_amdgcn_mfma_f32_16x16x32_fp8_fp8(a0, q0, acc, 0, 0, 0);
                acc = __builtin_amdgcn_mfma_f32_16x16x32_fp8_fp8(a1, q1, acc, 0, 0, 0);
                S[4 * c4 + kbl] = acc;
            }
        }
    }
    __builtin_amdgcn_s_setprio(0);
    const float slope2 = __builtin_amdgcn_exp2f(-0.5f * (float)((fr & 7) + 9)) * LOG2E;
    float mx = -__builtin_inff();
    const float nslope2 = -slope2;
    if (t >= 255) {
#pragma unroll
        for (int kb = 0; kb < 16; ++kb) {
            const v4u i4 = *(const LAS v4u*)(idx + 16 * kb + 4 * fq);
#define SQ_HD(W) ((float)__builtin_bit_cast(_Float16, (unsigned short)((W) >> 16)))
            { const float l = __builtin_fmaf(nslope2, SQ_HD(i4.x), S[kb][0]); S[kb][0] = l; mx = fmaxf(mx, l); }
            { const float l = __builtin_fmaf(nslope2, SQ_HD(i4.y), S[kb][1]); S[kb][1] = l; mx = fmaxf(mx, l); }
            { const float l = __builtin_fmaf(nslope2, SQ_HD(i4.z), S[kb][2]); S[kb][2] = l; mx = fmaxf(mx, l); }
            { const float l = __builtin_fmaf(nslope2, SQ_HD(i4.w), S[kb][3]); S[kb][3] = l; mx = fmaxf(mx, l); }
#undef SQ_HD
        }
    } else {
#pragma unroll
        for (int kb = 0; kb < 16; ++kb) {
            const v4u i4 = *(const LAS v4u*)(idx + 16 * kb + 4 * fq);
            const unsigned k0 = i4.x & 0xffffu, k1 = i4.y & 0xffffu, k2 = i4.z & 0xffffu, k3 = i4.w & 0xffffu;
            { const float l = (i4.x < 0xffff0000u) ? (S[kb][0] - slope2 * (float)(t - (int)k0)) : -__builtin_inff(); S[kb][0] = l; mx = fmaxf(mx, l); }
            { const float l = (i4.y < 0xffff0000u) ? (S[kb][1] - slope2 * (float)(t - (int)k1)) : -__builtin_inff(); S[kb][1] = l; mx = fmaxf(mx, l); }
            { const float l = (i4.z < 0xffff0000u) ? (S[kb][2] - slope2 * (float)(t - (int)k2)) : -__builtin_inff(); S[kb][2] = l; mx = fmaxf(mx, l); }
            { const float l = (i4.w < 0xffff0000u) ? (S[kb][3] - slope2 * (float)(t - (int)k3)) : -__builtin_inff(); S[kb][3] = l; mx = fmaxf(mx, l); }
        }
    }
    mx = xmax32(xmax16(mx));
    const float mx8 = mx - 8.0f;
    float sum = 0.f;
#pragma unroll
    for (int kb = 0; kb < 16; ++kb)
#pragma unroll
        for (int r = 0; r < 4; ++r) { const float e = __builtin_amdgcn_exp2f(S[kb][r] - mx8); S[kb][r] = e; sum += e; }
    sum = xsum32(xsum16(sum));
    const float inv = 1.0f;
    f32x4 O[4];
#pragma unroll
    for (int db = 0; db < 4; ++db) O[db] = (f32x4){0.f, 0.f, 0.f, 0.f};
    __builtin_amdgcn_s_setprio(1);
#pragma unroll
    for (int c4 = 0; c4 < 4; ++c4) {
#pragma unroll
        for (int i = 0; i < 4; ++i) {
            const int row = 4 * (lane >> 2) + i, ch = lane & 3;
            *(LAS v4u*)(vbuf + row * 64 + ((ch ^ ((row >> 2) & 3)) << 4)) = vreg[c4][i];
        }
#pragma unroll
        for (int kh = 0; kh < 2; ++kh) {
            const int kb0 = 4 * c4 + 2 * kh;
            const unsigned plo = pg8::pack4_fp8(S[kb0][0] * inv, S[kb0][1] * inv, S[kb0][2] * inv, S[kb0][3] * inv), phi = pg8::pack4_fp8(S[kb0 + 1][0] * inv, S[kb0 + 1][1] * inv, S[kb0 + 1][2] * inv, S[kb0 + 1][3] * inv);
            const long pa = (long)(((u64)phi << 32) | plo);
            const int e = fr >> 1, row = 32 * kh + (e < 4 ? 4 * fq + e : 12 + 4 * fq + e), sw = (row >> 2) & 3;
#pragma unroll
            for (int db = 0; db < 4; ++db) {
                const v2i t8 = __builtin_amdgcn_ds_read_tr8_b64_v2i32((LAS v2i*)(vbuf + row * 64 + ((db ^ sw) << 4) + 8 * (fr & 1)));
                const long vb = (long)(((u64)(unsigned)t8[1] << 32) | (unsigned)t8[0]);
                O[db] = __builtin_amdgcn_mfma_f32_16x16x32_fp8_fp8(vb, pa, O[db], 0, 0, 0);
            }
        }
    }
    __builtin_amdgcn_s_setprio(0);
    { const float rsum = 1.0f / sum;
#pragma unroll
      for (int db = 0; db < 4; ++db) O[db] = O[db] * rsum; }
    if (fr < 8) {
#pragma unroll
        for (int db = 0; db < 4; ++db) *(unsigned*)((unsigned char*)(wsb + dst_off) + (rowb + t) * 512 + fr * 64 + 16 * db + 4 * fq) = pg8::pack4_fp8(O[db][0], O[db][1], O[db][2], O[db][3]);
    }
}

__device__ __forceinline__ void sparse_unit(int b, int j, unsigned short* codes, int cstride, unsigned char* wsb, LAS unsigned char* L, int wid, int lane, int tid) {
    { GAS unsigned char* wg_ = (GAS unsigned char*)wsb; asm volatile("" : "+s"(wg_)); wsb = (unsigned char*)wg_; } const bf16* IQ = (const bf16*)(wsb + WS_IQ); const float* IW = (const float*)(wsb + WS_IW);
    asm volatile("" : "+v"(lane)); tid = wid * 64 + lane;
    const int t0 = 64 * j, ntiles = (j >> 1) + 1, r32 = lane & 31, hi = lane >> 5;
    const size_t rowb = (size_t)b * T;
    LAS unsigned* hist = (LAS unsigned*)(L + L_HIST);
    LAS unsigned* cbuf = (LAS unsigned*)(L + L_BUF);
    LAS int* qinfo = (LAS int*)(L + L_QINFO);
    bf16x8 af[2][4];
    { const int a = r32 >> 3, hp = (r32 >> 2) & 1, bb = r32 & 3, qi = 2 * (a >> 1) + hp, hd = 4 * (a & 1) + bb;
#pragma unroll
      for (int rb = 0; rb < 2; ++rb) { const bf16* ap = IQ + (rowb + t0 + 8 * wid + 4 * rb + qi) * 512 + hd * 64 + 8 * hi;
#pragma unroll
          for (int ks = 0; ks < 4; ++ks) af[rb][ks] = *(const bf16x8*)(ap + 16 * ks); } }
    float wq[2][2][8];
#pragma unroll
    for (int rb = 0; rb < 2; ++rb)
#pragma unroll
        for (int g2 = 0; g2 < 2; ++g2) { const float* wp = IW + (rowb + t0 + 8 * wid + 4 * rb + 2 * g2 + hi) * 8; const f32x4 w0 = *(const f32x4*)wp, w1 = *(const f32x4*)(wp + 4);
            wq[rb][g2][0] = w0[0]; wq[rb][g2][1] = w0[1]; wq[rb][g2][2] = w0[2]; wq[rb][g2][3] = w0[3]; wq[rb][g2][4] = w1[0]; wq[rb][g2][5] = w1[1]; wq[rb][g2][6] = w1[2]; wq[rb][g2][7] = w1[3]; }
#ifndef REP_P1
#define REP_P1 1
#endif
    for (int rp1_ = 0; rp1_ < REP_P1; ++rp1_) {
#pragma unroll
    for (int i = 0; i < 32; ++i) hist[(8 * wid) * 256 + i * 64 + lane] = 0u;
    __syncthreads();
    idx_pass<1>(b, t0, 0, ntiles, wsb, codes, cstride, L, af, wq, wid, lane, tid);
    }
    for (int i = 0; i < 8; ++i) {
        const int ql = 8 * wid + i, t = t0 + ql; int bin = 0, above = 0, inc = 0;
        if (t + 1 > 256) find_bin<true>(hist + ql * 256, 256, lane, bin, above, inc);
        if (lane == 0) { qinfo[128 + ql] = (t + 1 > 256) ? ((bin << 7) - 1) : 0; qinfo[192 + ql] = above; }
    }
    LDS_WAIT();
    __syncthreads();
    VM_WAIT();
    __builtin_amdgcn_fence(__ATOMIC_ACQUIRE, "agent"); VM_WAIT();
#ifndef REP_SCAN
#define REP_SCAN 1
#endif
#ifndef REP_SCPR
#define REP_SCPR 1
#endif
    LAS unsigned* wh = (LAS unsigned*)(L + L_WSCR + wid * 1024);
    for (int rsp_ = 0; rsp_ < REP_SCPR; ++rsp_) {
    for (int rsc_ = 0; rsc_ < REP_SCAN; ++rsc_)
    { const int nstored = ntiles * 128;
      for (int i = 0; i < 8; ++i) {
        const int ql = 8 * wid + i; int c = 0;
        int Tq = qinfo[128 + ql];
        scan_codes(codes + (size_t)ql * cstride, (const unsigned short*)wsb, nstored, Tq, cbuf + ql * CB, c, wh, lane);
        if (lane == 0) { qinfo[256 + ql] = c; qinfo[320 + ql] = Tq; }
      } }
    LDS_WAIT();
    for (int i = 0; i < 8; ++i) {
        const int ql = 8 * wid + i; int n = qinfo[256 + ql]; if (n > CB) n = CB;
        LAS unsigned* qb_ = cbuf + ql * CB;
        bool rewritten = false;
        if (n > 256) { const int T0 = qinfo[128 + ql]; if (qinfo[320 + ql] == T0) { prune256_known(qb_, n, wh, lane, (T0 + 1) >> 7, qinfo[192 + ql], (t0 + ql >= 255) ? t0 + ql : -1); rewritten = true; } else (void)prune256(qb_, n, wh, lane); }
        else { for (int p = n + lane; p < 256; p += 64) qb_[p] = 0xffff0000u; LDS_WAIT(); }
        if (t0 + ql >= 255 && !rewritten) {
#pragma unroll
            for (int p4 = 0; p4 < 4; ++p4) { const unsigned e = qb_[64 * p4 + lane]; const unsigned k = e & 0xffffu; const _Float16 hd = (_Float16)(float)(t0 + ql - (int)k);
                qb_[64 * p4 + lane] = ((unsigned)__builtin_bit_cast(unsigned short, hd) << 16) | k; }
            LDS_WAIT();
        }
    }
    }
    __syncthreads();
#ifndef REP_ATT
#define REP_ATT 1
#endif
    for (int ra_ = 0; ra_ < REP_ATT; ++ra_)
    for (int i = 0; i < 8; ++i) sparse_query(b, t0 + 8 * wid + i, cbuf + (8 * wid + i) * CB, wsb, L, wid, lane, WS_YB8);
    __syncthreads();
}
}

struct Args { const float* in[18]; float* out; unsigned char* ws; int ph_lo, ph_hi, use_bar, pad; };

__global__ void __launch_bounds__(NWAVES * 64, 2) mega(Args args) {
    extern __shared__ __attribute__((aligned(16))) unsigned char lds[];
    LAS unsigned char* L = (LAS unsigned char*)lds;
    volatile LAS unsigned* MISC = (volatile LAS unsigned*)(L + MISC_OFF);
    const int wave = __builtin_amdgcn_readfirstlane((int)threadIdx.x >> 6);
#define LANE_TID int lane; asm volatile("v_mbcnt_lo_u32_b32 %0, -1, 0\n\tv_mbcnt_hi_u32_b32 %0, -1, %0" : "=v"(lane)); const int tid = wave * 64 + lane; (void)tid;
    const int G = gridDim.x; const int bx = blockIdx.x; const int vcu = (G % 8 == 0) ? (bx % 8) * (G / 8) + bx / 8 : bx;
    { LANE_TID for (int u = tid; u < (LDS_BYTES - LDSCTL_OFF) / 4; u += NWAVES * 64) ((LAS unsigned*)(L + LDSCTL_OFF))[u] = 0u; }
    __syncthreads();
    if (args.use_bar) (void)xcd_barrier_post((unsigned*)((gu32*)(args.ws + WS_CTL) + CW_BAR), MISC + 8);
    if (args.use_bar && threadIdx.x == 0) {
        unsigned* bar_ = (unsigned*)((gu32*)(args.ws + WS_CTL) + CW_BAR); const unsigned x_ = xb_xcc_id() + 1u; unsigned exp_ = 0u;
        const bool first_ = __hip_atomic_compare_exchange_strong(&bar_[9216 + 64 * (bx & 7)], &exp_, x_, __ATOMIC_RELAXED, __ATOMIC_RELAXED, __HIP_MEMORY_SCOPE_AGENT);
        if ((!first_ && exp_ != x_) || (G & 7) != 0) (void)__hip_atomic_fetch_or(&bar_[10240], 1u, __ATOMIC_RELAXED, __HIP_MEMORY_SCOPE_AGENT);
    }
    const int lo = args.ph_lo, hi = args.ph_hi;
#define IN(k) (lo <= (k) && (k) < hi)
#define WSP(off) ((bf16*)(wsl + (off)))
#define WSF(off) ((float*)(wsl + (off)))
#define PHASE_WS GAS unsigned char* wsg_ = (GAS unsigned char*)args.ws; asm volatile("" : "+s"(wsg_)); unsigned char* wsl = (unsigned char*)wsg_;
#define PHASE_PTRS LANE_TID GAS unsigned char* wsg_ = (GAS unsigned char*)args.ws; asm volatile("" : "+s"(wsg_)); unsigned char* wsl = (unsigned char*)wsg_;
#define GRID_BAR(k) do { if (IN(k) && IN((k) + 1)) { XcdBarrier bb_; bb_.bar = (unsigned*)((gu32*)(args.ws + WS_CTL) + CW_BAR); bb_.x = xb_xcc_id(); bb_.st = (volatile LAS unsigned*)(L + MISC_OFF) + 8; xcd_barrier(bb_); } } while (0)
#define GROUP_MODE_INIT() do { if (args.use_bar && IN(0) && IN(1)) { if (threadIdx.x == 0) ((volatile LAS unsigned*)(L + MISC_OFF))[10] = (xb_ld((unsigned*)((gu32*)(args.ws + WS_CTL) + CW_BAR) + 10240) == 0u) ? 1u : 0u; __syncthreads(); } } while (0)
#define GROUP_BAR(k) do { if (IN(k) && IN((k) + 1)) { \
    if (((volatile LAS unsigned*)(L + MISC_OFF))[10] != 0u) { \
        asm volatile("s_waitcnt vmcnt(0)" ::: "memory"); __syncthreads();                         \
        if (threadIdx.x == 0) { unsigned* bar_ = (unsigned*)((gu32*)(args.ws + WS_CTL) + CW_BAR); const unsigned n_ = (unsigned)G >> 3; \
            __builtin_amdgcn_s_waitcnt(0); const unsigned old_ = xb_add(&bar_[8192 + 64 * (bx & 7)], 1u); const unsigned tgt_ = (old_ / n_ + 1u) * n_; \
            XB_SPIN(xb_ld(&bar_[8192 + 64 * (bx & 7)]) < tgt_, bar_); \
            __builtin_amdgcn_fence(__ATOMIC_ACQUIRE, "agent"); asm volatile("s_waitcnt vmcnt(0)" ::: "memory"); }     \
        __syncthreads(); \
    } else { XcdBarrier bb_; bb_.bar = (unsigned*)((gu32*)(args.ws + WS_CTL) + CW_BAR); bb_.x = xb_xcc_id(); bb_.st = (volatile LAS unsigned*)(L + MISC_OFF) + 8; xcd_barrier(bb_); } } } while (0)
    const int gw = vcu * NWAVES + wave, NGW = G * NWAVES;

#if (PH_MASK >> 0) & 1
    if (IN(0)) {
        PHASE_PTRS
        const float* x = as_global(args.in[0]); const float* pin = as_global(args.in[1]); const float* ln_ffn1 = as_global(args.in[2]); const float* w_ffn1_in = as_global(args.in[3]); const float* w_ffn1_out = as_global(args.in[4]); const float* ln_mix = as_global(args.in[5]); const float* w_in = as_global(args.in[6]);
        const float* w_br_a = as_global(args.in[8]); const float* w_br_b = as_global(args.in[9]); const float* w_out = as_global(args.in[10]); const float* ln_ffn2 = as_global(args.in[11]); const float* w_ffn2_in = as_global(args.in[12]); const float* w_ffn2_out = as_global(args.in[13]); const float* ln_ple = as_global(args.in[14]); const float* w_ple_gate = as_global(args.in[15]); const float* w_ple_proj = as_global(args.in[16]);
        bf16 *W1 = WSP(WS_W1), *W2 = WSP(WS_W2), *WIN = WSP(WS_WIN), *WA = WSP(WS_WA), *WB = WSP(WS_WB), *WO = WSP(WS_WO), *W3 = WSP(WS_W3), *W4 = WSP(WS_W4), *WG = WSP(WS_WG), *WP = WSP(WS_WP), *HB = WSP(WS_HB), *PB = WSP(WS_PB);
        LAS float* scr = (LAS float*)(L + RING_OFF + wave * 16384);
        constexpr int I_W1 = 16 * 176, I_W2 = 44 * 32, I_WIN = 16 * 64, I_WA = 8 * 32, I_WO = 16 * 32, I_WP = 4 * 32;
        constexpr int NITEMS = 2 * I_W1 + 2 * I_W2 + 2 * I_WIN + 2 * I_WA + 2 * I_WO + I_WP;
        const int n_it = (NITEMS - gw + NGW - 1) / NGW, n_x = (M / 2 - gw + NGW - 1) / NGW;
        for (int st = 0; st < (n_it > n_x ? n_it : n_x); ++st) {
            const int m0 = (gw + st * NGW) * 2; const bool has_x = st < n_x;
            f32x4 v[2][4];
            if (has_x) {
#pragma unroll
                for (int r = 0; r < 2; ++r) { const GAS f32x4* xr = (const GAS f32x4*)(x + (size_t)(m0 + r) * D) + lane;
#pragma unroll
                    for (int j = 0; j < 4; ++j) v[r][j] = xr[64 * j]; }
            }
            const int it = gw + st * NGW;
            if (it < NITEMS) {
                int r = it; const float* Wp_ = w_ffn1_in; int Ns = 2 * FF, Kk = D, nblk = 176, mapid = 1, f8 = 1; unsigned char* dst = (unsigned char*)W1; const float* gn = ln_ffn1;
                if (r >= I_W1) { r -= I_W1; Wp_ = w_ffn2_in; dst = (unsigned char*)W3; gn = ln_ffn2; f8 = 1;
                  if (r >= I_W1) { r -= I_W1; Wp_ = w_ffn1_out; Ns = D; Kk = FF; nblk = 32; mapid = 0; f8 = 1; dst = (unsigned char*)W2; gn = nullptr;
                    if (r >= I_W2) { r -= I_W2; Wp_ = w_ffn2_out; dst = (unsigned char*)W4; f8 = 1;
                      if (r >= I_W2) { r -= I_W2; Wp_ = w_in; Ns = DIN; Kk = D; nblk = 64; mapid = 2; f8 = 0; dst = (unsigned char*)WIN; gn = ln_mix;
                        if (r >= I_WIN) { r -= I_WIN; mapid = 3; f8 = 1; dst = (unsigned char*)WIN + 4 * MiB;
                          if (r >= I_WIN) { r -= I_WIN; Wp_ = w_br_a; Ns = D; Kk = 512; nblk = 32; mapid = 0; dst = (unsigned char*)WA; gn = nullptr;
                            if (r >= I_WA) { r -= I_WA; Wp_ = w_br_b; dst = (unsigned char*)WB;
                              if (r >= I_WA) { r -= I_WA; Wp_ = w_out; Kk = D; dst = (unsigned char*)WO;
                                if (r >= I_WO) { r -= I_WO; Wp_ = w_ple_gate; dst = (unsigned char*)WG; gn = ln_ple;
                                  if (r >= I_WO) { r -= I_WO; Wp_ = w_ple_proj; Kk = DPLE; dst = (unsigned char*)WP; gn = nullptr; } } } } } } } } } }
                tr_generic(Wp_, Ns, Kk, dst, gn, mapid, f8, scr, r, nblk, lane);
            }
            if (has_x) {
#pragma unroll
                for (int r = 0; r < 2; ++r) { float s = 0.f;
#pragma unroll
                    for (int j = 0; j < 4; ++j) s += (v[r][j].x * v[r][j].x + v[r][j].y * v[r][j].y) + (v[r][j].z * v[r][j].z + v[r][j].w * v[r][j].w);
                    const float rs = __builtin_amdgcn_rsqf(wave_sum(s) * (1.f / D) + 1e-6f);
                    GAS unsigned* o8 = (GAS unsigned*)(wsl + WS_X8 + (size_t)(m0 + r) * D) + lane;
#pragma unroll
                    for (int j = 0; j < 4; ++j) o8[64 * j] = pg8::pack4_fp8(v[r][j].x * rs, v[r][j].y * rs, v[r][j].z * rs, v[r][j].w * rs); }
            }
        }
        { const size_t NV = (size_t)M * DPLE / 4, stride = (size_t)G * 512;
          for (size_t i = (size_t)(bx * 512 + tid); i < NV; i += 4 * stride) {
            f32x4 v[4];
#pragma unroll
            for (int u = 0; u < 4; ++u) { const size_t ii = i + u * stride; v[u] = (ii < NV) ? ((const GAS f32x4*)pin)[ii] : (f32x4){0.f, 0.f, 0.f, 0.f}; }
#pragma unroll
            for (int u = 0; u < 4; ++u) { const size_t ii = i + u * stride; if (ii < NV) ((GAS unsigned*)PB)[ii] = pg8::pack4_fp8(v[u].x, v[u].y, v[u].z, v[u].w); }
          } }
    }
#endif
    GRID_BAR(0);
    GROUP_MODE_INIT();
#if (PH_MASK >> 1) & 1
    if (IN(1)) {
        PHASE_WS bf16 *HB = WSP(WS_HB), *W1 = WSP(WS_W1), *ACT = WSP(WS_ACT);
        pg8::Gemm g{WSP(WS_X8), W1, M, 2 * FF, D / 2}; pg8::StaticOrder S; S.init(M, 2 * FF, G, bx);
        pg8::EpiSwiglu<false, true, true> E{ACT, L};
        pg8::gemm_phase<pg8::EpiSwiglu<false, true, true>, pg8::StaticOrder, true, true, true>(L + RING_OFF, g, S, E, wave);
    }
#endif
    GROUP_BAR(1);
#if (PH_MASK >> 2) & 1
    if (IN(2)) {
        PHASE_WS bf16 *HB = WSP(WS_HB), *W2 = WSP(WS_W2), *ACT = WSP(WS_ACT); float* RSQ1 = WSF(WS_RSQ1); const float* x = as_global(args.in[0]);
        pg8::Gemm g{ACT, W2, M, D, FF / 2}; pg8::StaticOrder S; S.init(M, D, G, bx);
        pg8::EpiResid<true, true, true, true> E{x, HB, RSQ1, (unsigned char*)(wsl + WS_X8)};
        pg8::gemm_phase<pg8::EpiResid<true, true, true, true>, pg8::StaticOrder, true, true, true>(L + RING_OFF, g, S, E, wave);
    }
#endif
    GROUP_BAR(2);
#if (PH_MASK >> 3) & 1
    if (IN(3)) {
        PHASE_WS bf16 *HB = WSP(WS_HB), *WIN = WSP(WS_WIN); float *RSQ1 = WSF(WS_RSQ1); bf16* SG = (bf16*)as_global(args.out);
        { pg8::Gemm g{HB, WIN, M, 2048, D}; pg8::StaticOrder S; S.init(M, 2048, G, bx);
          { LANE_TID pg8::stage_rs(L, S, RSQ1, tid, 1.0f); }
          pg8::EpiProj E{L, wsl, SG};
          pg8::gemm_phase<pg8::EpiProj, pg8::StaticOrder, true, true>(L + RING_OFF, g, S, E, wave); }
        { pg8::Gemm g{WSP(WS_X8), (bf16*)((unsigned char*)WIN + 4 * MiB), M, 2048, D / 2}; pg8::StaticOrder S; S.init(M, 2048, G, bx);
          { LANE_TID pg8::stage_rs(L, S, RSQ1, tid, 1.0f); }
          pg8::EpiSig E{L, SG};
          pg8::gemm_phase<pg8::EpiSig, pg8::StaticOrder, true, true, true>(L + RING_OFF, g, S, E, wave); }
    }
#endif
    GRID_BAR(3);
#if (PH_MASK >> 4) & 1
    if (IN(4)) {
                LANE_TID unsigned char* wsl = as_global(args.ws); const float* a_sink = as_global(args.in[7]);
#ifndef NO_SWA
#ifndef REP_SWA
#define REP_SWA 1
#endif
        for (int rs_ = 0; rs_ < REP_SWA; ++rs_)
        for (int i = 0; i < 2; ++i) { const int su = vcu + 256 * i; if (su < 512) att::swa_unit(su >> 7, (su >> 1) & 63, su & 1, wsl, a_sink, L, wave, lane, tid, WS_YA8); }
#endif
#ifndef NO_SP
        if (vcu < 256) { const int sb = vcu >> 6, sj = vcu & 63, mh = sj >> 1;
            const int pre = 64 * sj - (mh * (mh - 1) + ((sj & 1) ? mh : 0)) + sb * 3104, cstride = (64 - mh) * 128;
            unsigned short* codes = (unsigned short*)(wsl + WS_ACT + (size_t)pre * 16384);
            att::sparse_unit(sb, sj, codes, cstride, wsl, L, wave, lane, tid);
            att::sparse_unit(sb, 127 - sj, codes, cstride, wsl, L, wave, lane, tid); }
#endif


    }
#endif
    GRID_BAR(4);
#if (PH_MASK >> 5) & 1
    if (IN(5)) {
        PHASE_WS bf16 *AQ = WSP(WS_AQ), *BQ = WSP(WS_BQ), *WA = WSP(WS_WA), *WB = WSP(WS_WB), *TA = WSP(WS_TA), *MIX = WSP(WS_MIX); bf16* SG = (bf16*)as_global(args.out);
        { pg8::Gemm g{WSP(WS_YA8), WA, M, D, 256}; pg8::StaticOrder S; S.init(M, D, G, bx);
          pg8::EpiGate<1, true, true> E{TA, SG, 0, nullptr};
          pg8::gemm_phase<pg8::EpiGate<1, true, true>, pg8::StaticOrder, true, true, true>(L + RING_OFF, g, S, E, wave); }
        VM_WAIT(); __syncthreads();
        { pg8::Gemm g{WSP(WS_YB8), WB, M, D, 256}; pg8::StaticOrder S; S.init(M, D, G, bx);
          pg8::EpiGate<2, true, true> E{MIX, SG, 1024, TA};
          pg8::gemm_phase<pg8::EpiGate<2, true, true>, pg8::StaticOrder, true, true, true>(L + RING_OFF, g, S, E, wave); }
    }
#endif
    GROUP_BAR(5);
#if (PH_MASK >> 6) & 1
    if (IN(6)) {
        PHASE_WS bf16 *HB = WSP(WS_HB), *WO = WSP(WS_WO), *MIX = WSP(WS_MIX); float* RSQ2 = WSF(WS_RSQ2);
        pg8::Gemm g{MIX, WO, M, D, D / 2}; pg8::StaticOrder S; S.init(M, D, G, bx);
        pg8::EpiResid<false, false, true, true> E{nullptr, HB, RSQ2, (unsigned char*)(wsl + WS_X8)};
        pg8::gemm_phase<pg8::EpiResid<false, false, true, true>, pg8::StaticOrder, true, true, true>(L + RING_OFF, g, S, E, wave);
    }
#endif
    GROUP_BAR(6);
#if (PH_MASK >> 7) & 1
    if (IN(7)) {
        PHASE_WS bf16 *HB = WSP(WS_HB), *W3 = WSP(WS_W3), *ACT = WSP(WS_ACT); float* RSQ2 = WSF(WS_RSQ2);
        pg8::Gemm g{WSP(WS_X8), W3, M, 2 * FF, D / 2}; pg8::StaticOrder S; S.init(M, 2 * FF, G, bx);
        { LANE_TID pg8::stage_rs(L, S, RSQ2, tid, 1.0f); }
        pg8::EpiSwiglu<true, true> E{ACT, L};
        pg8::gemm_phase<pg8::EpiSwiglu<true, true>, pg8::StaticOrder, true, true, true>(L + RING_OFF, g, S, E, wave);
    }
#endif
    GROUP_BAR(7);
#if (PH_MASK >> 8) & 1
    if (IN(8)) {
        PHASE_WS bf16 *HB = WSP(WS_HB), *W4 = WSP(WS_W4), *ACT = WSP(WS_ACT); float* RSQ3 = WSF(WS_RSQ3);
        pg8::Gemm g{ACT, W4, M, D, FF / 2}; pg8::StaticOrder S; S.init(M, D, G, bx);
        pg8::EpiResid<false, true, true, true> E{nullptr, HB, RSQ3, (unsigned char*)(wsl + WS_X8)};
        pg8::gemm_phase<pg8::EpiResid<false, true, true, true>, pg8::StaticOrder, true, true, true>(L + RING_OFF, g, S, E, wave);
    }
#endif
    GROUP_BAR(8);
#if (PH_MASK >> 9) & 1
    if (IN(9)) {
        PHASE_WS bf16 *HB = WSP(WS_HB), *PB = WSP(WS_PB), *WP = WSP(WS_WP), *WG = WSP(WS_WG), *PP = WSP(WS_PP); float *RSQ3 = WSF(WS_RSQ3), *RSQ4 = WSF(WS_RSQ4); float* out = as_global(args.out);
        { pg8::Gemm g{PB, WP, M, D, DPLE / 2}; pg8::StaticOrder S; S.init(M, D, G, bx);
          pg8::EpiGate<0, true, true> E{PP, nullptr, 0, nullptr};
          pg8::gemm_phase<pg8::EpiGate<0, true, true>, pg8::StaticOrder, true, true, true>(L + RING_OFF, g, S, E, wave); }
        VM_WAIT(); __syncthreads();
        { pg8::Gemm g{WSP(WS_X8), WG, M, D, D / 2}; pg8::StaticOrder S; S.init(M, D, G, bx);
          { LANE_TID pg8::stage_rs(L, S, RSQ3, tid, 1.0f); }
          pg8::EpiPle<true> E{L, HB, PP, out, RSQ4, (unsigned*)(wsl + WS_CTL) + 32768, as_global(args.in[17])};
          pg8::gemm_phase<pg8::EpiPle<true>, pg8::StaticOrder, true, true, true>(L + RING_OFF, g, S, E, wave); }
    }
#endif
#undef IN
#undef GRID_BAR
}


#ifndef MK_SINGLE
#define MK_SINGLE 1
#endif
extern "C" void kernel_launch(void* const* d_in, const int* in_sizes, int n_in, void* d_out, int out_size, void* d_ws, size_t ws_size, hipStream_t stream) {
    static int grid = 0;
    if (grid == 0) {
        int dev = 0, cus = 0;
        if (ws_size < WS_END || hipGetDevice(&dev) != hipSuccess || hipDeviceGetAttribute(&cus, hipDeviceAttributeMultiprocessorCount, dev) != hipSuccess) { fprintf(stderr, "kernel_launch: setup failed (ws %zu)\n", ws_size); grid = -1; return; }
        if (hipFuncSetAttribute((const void*)mega, hipFuncAttributeMaxDynamicSharedMemorySize, LDS_BYTES) != hipSuccess) { fprintf(stderr, "kernel_launch: hipFuncSetAttribute failed\n"); grid = -1; return; }
        grid = cus;
    }
    if (grid < 0) return;
    (void)hipMemsetAsync((char*)d_ws + WS_CTL, 0, CTL_ZERO_BYTES, stream);
    Args a{};
    for (int i = 0; i < 18; ++i) a.in[i] = (const float*)d_in[i];
    a.out = (float*)d_out; a.ws = (unsigned char*)d_ws;
    if (MK_SINGLE) { a.use_bar = 1; a.ph_lo = 0; a.ph_hi = 10; hipLaunchKernelGGL(mega, dim3(grid), dim3(NWAVES * 64), LDS_BYTES, stream, a); }
    else { a.use_bar = 0;
#ifndef REP_MASK
#define REP_MASK 0
#endif
        for (int ph = 0; ph < 10; ++ph) { const int reps = 1 + ((REP_MASK >> ph) & 1); for (int r = 0; r < reps; ++r) { a.ph_lo = ph; a.ph_hi = ph + 1; hipLaunchKernelGGL(mega, dim3(grid), dim3(NWAVES * 64), LDS_BYTES, stream, a); } } }
}
```
